# Optimizing an MI355X kernel written in HIP

```python
import jax, jax.numpy as jnp
from jax import lax
import numpy as np

D_MODEL = 1024
BATCH = 16
SEQ = 4096
DEPTH = 1

CHUNK = 64
D_MIX = D_MODEL
ML_WIDTH = D_MIX // 2
ML_HEADS = 4
ML_HEAD_DIM = ML_WIDTH // ML_HEADS
SB_WIDTH = D_MIX - ML_WIDTH
SB_HEADS = 8
SB_HEAD_DIM = SB_WIDTH // SB_HEADS
CONV_K = 4
Q_BLOCK = 128
EPS = 1e-6
IN_SIZES = [2 * ML_WIDTH,
            ML_WIDTH,
            ML_WIDTH,
            ML_WIDTH,
            2 * ML_HEADS,
            SB_WIDTH,
            SB_WIDTH,
            SB_WIDTH,
            SB_WIDTH]
N_IN = sum(IN_SIZES)
IN_SPLITS = [int(s) for s in np.cumsum(IN_SIZES)[:-1]]

kernel_name = "hymba_mlstm_stickbreaking_layer"


def _rmsnorm(x, g):
    xf = x.astype(jnp.float32)
    r = lax.rsqrt(jnp.mean(xf * xf, axis=-1, keepdims=True) + EPS)
    return (xf * r).astype(x.dtype) * g


def _causal_conv(u, w, b):
    C = u.shape[-1]
    out = lax.conv_general_dilated(u, w[:, None, :].astype(u.dtype), window_strides=(1,),
                                   padding=[(CONV_K - 1, 0)],
                                   dimension_numbers=('NWC', 'WIO', 'NWC'),
                                   feature_group_count=C)
    return out + b


def _mlstm(q, k, v, i_pre, f_pre):
    B, S, H, d = q.shape
    nc = S // CHUNK
    L = CHUNK
    f32 = jnp.float32

    def chunked(t):
        t = t.reshape((B, nc, L) + t.shape[2:])
        return jnp.moveaxis(t, 3, 1)

    q = chunked(q).astype(f32)
    k = chunked(k).astype(f32) * (d ** -0.5)
    v = chunked(v).astype(f32)
    ig = chunked(i_pre).astype(f32)
    logf = jax.nn.log_sigmoid(chunked(f_pre).astype(f32))
    b = jnp.cumsum(logf, axis=-1)
    a = b[..., -1]

    g = a[..., None] - b + ig
    m_loc = jnp.max(g, axis=-1)
    w = jnp.exp(g - m_loc[..., None])
    wk = w[..., None] * k
    C_loc = jnp.einsum('bhcsk,bhcsv->bhckv', wk, v)
    n_loc = jnp.sum(wk, axis=-2)

    def step(carry, xs):
        C, n, m = carry
        a_c, m_l, C_l, n_l = xs
        m_new = jnp.maximum(a_c + m, m_l)
        s_old = jnp.exp(a_c + m - m_new)
        s_loc = jnp.exp(m_l - m_new)
        C_new = s_old[..., None, None] * C + s_loc[..., None, None] * C_l
        n_new = s_old[..., None] * n + s_loc[..., None] * n_l
        return (C_new, n_new, m_new), (C, n, m)

    init = (jnp.zeros((B, H, d, d), f32), jnp.zeros((B, H, d), f32), jnp.zeros((B, H), f32))
    xs = (jnp.moveaxis(a, 2, 0), jnp.moveaxis(m_loc, 2, 0),
          jnp.moveaxis(C_loc, 2, 0), jnp.moveaxis(n_loc, 2, 0))
    _, (C_prev, n_prev, m_prev) = lax.scan(step, init, xs)
    C_prev = jnp.moveaxis(C_prev, 0, 2)
    n_prev = jnp.moveaxis(n_prev, 0, 2)
    m_prev = jnp.moveaxis(m_prev, 0, 2)

    causal = jnp.tril(jnp.ones((L, L), dtype=bool))
    Dlog = b[..., :, None] - b[..., None, :] + ig[..., None, :]
    Dlog = jnp.where(causal, Dlog, -jnp.inf)
    inter_log = b + m_prev[..., None]
    m_t = jnp.maximum(inter_log, jnp.max(Dlog, axis=-1))
    Dw = jnp.exp(Dlog - m_t[..., None])
    inter_w = jnp.exp(inter_log - m_t)
    qk = jnp.einsum('bhctd,bhcsd->bhcts', q, k) * Dw
    num = (inter_w[..., None] * jnp.einsum('bhctk,bhckv->bhctv', q, C_prev)
           + jnp.einsum('bhcts,bhcsv->bhctv', qk, v))
    den = inter_w * jnp.einsum('bhctk,bhck->bhct', q, n_prev) + jnp.sum(qk, axis=-1)
    h = num / jnp.maximum(jnp.abs(den), jnp.exp(-m_t))[..., None]
    return jnp.moveaxis(h, 1, 3).reshape(B, S, H, d)


def _stick_breaking(q, k, v):
    B, S, H, d = q.shape
    f32 = jnp.float32
    q = q.astype(f32) * (d ** -0.5)
    k = k.astype(f32)
    v = v.astype(f32)
    outs = []
    for blk in range(S // Q_BLOCK):
        t0 = blk * Q_BLOCK
        t1 = t0 + Q_BLOCK
        qb = q[:, t0:t1]
        kb = k[:, :t1]
        vb = v[:, :t1]
        z = jnp.einsum('bthd,bshd->bhts', qb, kb)
        strict = jnp.arange(t1)[None, :] < jnp.arange(t0, t1)[:, None]
        log_beta = jax.nn.log_sigmoid(z)
        log_keep = jnp.where(strict, jax.nn.log_sigmoid(-z), 0.0)
        after = lax.cumsum(log_keep, axis=3, reverse=True) - log_keep
        A = jnp.where(strict, jnp.exp(log_beta + after), 0.0)
        outs.append(jnp.einsum('bhts,bshd->bthd', A, vb))
    return jnp.concatenate(outs, axis=1)


def setup_inputs(seed: int = 0) -> dict:
    key = jax.random.key(seed)
    ks = jax.random.split(key, 14)
    f32 = jnp.float32
    x = jax.random.normal(ks[0], (BATCH, SEQ, D_MODEL), f32)
    c = jax.random.normal(ks[1], (BATCH, D_MODEL), f32)
    w_ada = jax.random.normal(ks[2], (D_MODEL, 3 * D_MODEL), f32) * (0.5 * D_MODEL ** -0.5)
    b_ada = 0.02 * jax.random.normal(ks[3], (3 * D_MODEL,), f32)
    g_pre = 1.0 + 0.02 * jax.random.normal(ks[4], (D_MODEL,), f32)
    w_in = jax.random.normal(ks[5], (D_MODEL, N_IN), f32) * (D_MODEL ** -0.5)
    b_igate = 0.1 * jax.random.normal(ks[6], (ML_HEADS,), f32)
    b_fgate = jnp.linspace(3.0, 6.0, ML_HEADS, dtype=f32) + 0.02 * jax.random.normal(ks[7], (ML_HEADS,), f32)
    conv_w = jax.random.normal(ks[8], (CONV_K, 2 * ML_WIDTH), f32) * (CONV_K ** -0.5)
    conv_b = 0.02 * jax.random.normal(ks[9], (2 * ML_WIDTH,), f32)
    g_ml_head = 1.0 + 0.02 * jax.random.normal(ks[10], (ML_HEADS, ML_HEAD_DIM), f32)
    w_out = jax.random.normal(ks[11], (D_MIX, D_MODEL), f32) * (D_MIX ** -0.5)
    g_post = 1.0 + 0.02 * jax.random.normal(ks[12], (D_MODEL,), f32)
    return {"x": x, "c": c, "w_ada": w_ada, "b_ada": b_ada, "g_pre": g_pre,
            "w_in": w_in, "b_igate": b_igate, "b_fgate": b_fgate,
            "conv_w": conv_w, "conv_b": conv_b, "g_ml_head": g_ml_head,
            "w_out": w_out, "g_post": g_post}


def reference(x, c, w_ada, b_ada, g_pre, w_in, b_igate, b_fgate, conv_w, conv_b,
              g_ml_head, w_out, g_post):
    B, S, _ = x.shape
    for _layer in range(DEPTH):
        mod = jax.nn.silu(c) @ w_ada + b_ada
        shift, scale, gate = jnp.split(mod, 3, axis=-1)
        h = _rmsnorm(x, g_pre) * (1.0 + scale[:, None, :]) + shift[:, None, :]

        proj = h @ w_in
        (ml_qk, ml_v, ml_o, ml_z, ml_gates,
         sb_q, sb_k, sb_v, sb_z) = jnp.split(proj, IN_SPLITS, axis=-1)

        ml_qk = jax.nn.silu(_causal_conv(ml_qk, conv_w, conv_b))
        ml_q, ml_k = jnp.split(ml_qk, 2, axis=-1)
        i_pre = ml_gates[..., :ML_HEADS] + b_igate
        f_pre = ml_gates[..., ML_HEADS:] + b_fgate
        hs = (B, S, ML_HEADS, ML_HEAD_DIM)
        h_ml = _mlstm(ml_q.reshape(hs), ml_k.reshape(hs), ml_v.reshape(hs), i_pre, f_pre)
        h_ml = jax.nn.sigmoid(ml_o.reshape(hs).astype(jnp.float32)) * h_ml
        h_ml = _rmsnorm(h_ml, g_ml_head).reshape(B, S, ML_WIDTH)
        h_ml = h_ml.astype(x.dtype) * jax.nn.silu(ml_z)

        ss = (B, S, SB_HEADS, SB_HEAD_DIM)
        h_sb = _stick_breaking(sb_q.reshape(ss), sb_k.reshape(ss), sb_v.reshape(ss))
        h_sb = h_sb.reshape(B, S, SB_WIDTH).astype(x.dtype) * jax.nn.silu(sb_z)

        y = jnp.concatenate([h_ml, h_sb], axis=-1) @ w_out
        x = x + gate[:, None, :] * _rmsnorm(y, g_post)
    return x
```

```cpp
#include <hip/hip_runtime.h>
#include <hip/hip_cooperative_groups.h>
#include <cstdio>
#include <cstdint>
namespace cg = cooperative_groups;

typedef unsigned short u16;
typedef short bf16x8 __attribute__((ext_vector_type(8)));
typedef float f32x4 __attribute__((ext_vector_type(4)));
typedef float f32x16 __attribute__((ext_vector_type(16)));
typedef unsigned u32x4 __attribute__((ext_vector_type(4)));
typedef unsigned u32x2 __attribute__((ext_vector_type(2)));
#define DEVI __device__ __forceinline__

constexpr int NTOK = 65536, DM = 1024, NP = 4608;
constexpr size_t WS_WTIN = 0;
constexpr size_t WS_WTOUT = 9437184;
constexpr size_t WS_WG = 11534336;
constexpr size_t WS_MOD = 11567104;
constexpr size_t WS_BAR = 13860864;
constexpr size_t WS_GATES = 11763712;
constexpr size_t WS_H = 16777216;
constexpr size_t WS_P = WS_H + 134217728;
constexpr size_t WS_HMIX = WS_P + 603979776;
constexpr size_t WS_Y = WS_HMIX + 134217728;
constexpr size_t WS_END = WS_Y + 134217728;
constexpr size_t WS_NDNUM = WS_H;
constexpr size_t WS_Q2 = WS_H + 67108864;
constexpr size_t WS_E = WS_Y;
constexpr size_t WS_AUX = WS_Y + 33554432;
constexpr size_t WS_DG = WS_Y + 41943040;
constexpr int LDS_BYTES = 131072;

struct Params {
    const float *x, *c, *w_ada, *b_ada, *g_pre, *w_in, *b_ig, *b_fg, *conv_w, *conv_b, *g_ml, *w_out, *g_post;
    float* out;
    unsigned char* ws;
};

DEVI int opaque_tid() { int t = threadIdx.x; asm volatile("" : "+v"(t)); return t; }
typedef __bf16 bf16x2_t __attribute__((ext_vector_type(2)));
typedef _Float16 f16x2_t __attribute__((ext_vector_type(2)));
typedef _Float16 f16x8 __attribute__((ext_vector_type(8)));
typedef float f32x2_t __attribute__((ext_vector_type(2)));
DEVI unsigned pk2(float lo, float hi) { const f32x2_t v = {lo, hi}; const bf16x2_t b = __builtin_convertvector(v, bf16x2_t); return __builtin_bit_cast(unsigned, b); }
DEVI unsigned pkh2(float lo, float hi) { const f32x2_t v = {lo, hi}; const f16x2_t b = __builtin_convertvector(v, f16x2_t); return __builtin_bit_cast(unsigned, b); }
DEVI float bflo(unsigned w) { return __uint_as_float(w << 16); }
DEVI float bfhi(unsigned w) { return __uint_as_float(w & 0xffff0000u); }
DEVI float wave_sum(float v) {
#pragma unroll
    for (int o = 1; o < 64; o <<= 1) v += __shfl_xor(v, o);
    return v;
}
DEVI float wave_max(float v) {
#pragma unroll
    for (int o = 1; o < 64; o <<= 1) v = fmaxf(v, __shfl_xor(v, o));
    return v;
}
DEVI int perm32(int rho) { const int n = rho >> 4, i = rho & 15; return 8 * (i >> 2) + 4 * n + (i & 3); }
DEVI f32x4 mfma16(bf16x8 a, bf16x8 b, f32x4 c) { return __builtin_amdgcn_mfma_f32_16x16x32_bf16(a, b, c, 0, 0, 0); }
DEVI f32x16 mfma32(bf16x8 a, bf16x8 b, f32x16 c) { return __builtin_amdgcn_mfma_f32_32x32x16_bf16(a, b, c, 0, 0, 0); }

DEVI void p0_transpose_item(const float* __restrict__ W, const int ldw, const int srccol0, u16* __restrict__ dst, const int n0, const int k0, float* scr, const int lane) {
#pragma unroll 8
    for (int i = 0; i < 32; ++i) { const int kk = 2 * i + (lane >> 5); scr[kk * 33 + (lane & 31)] = W[(size_t)(k0 + kk) * ldw + srccol0 + (lane & 31)]; }
    asm volatile("s_waitcnt lgkmcnt(0)" ::: "memory");
    const int c = lane & 7;
#pragma unroll
    for (int j = 0; j < 4; ++j) {
        const int slot = (lane >> 3) + 8 * j, cl = perm32(slot);
        const float* sp = scr + (8 * c) * 33 + cl;
        u32x4 o; o.x = pk2(sp[0], sp[33]); o.y = pk2(sp[2 * 33], sp[3 * 33]); o.z = pk2(sp[4 * 33], sp[5 * 33]); o.w = pk2(sp[6 * 33], sp[7 * 33]);
        *(u32x4*)(dst + (size_t)(n0 + slot) * 1024 + k0 + 8 * c) = o;
    }
    asm volatile("s_waitcnt lgkmcnt(0)" ::: "memory");
}
__device__ __forceinline__ void phase0(const Params& p) {
    extern __shared__ __attribute__((aligned(16))) unsigned char lds[];
    const int tid = opaque_tid(), lane = tid & 63, wave = tid >> 6;
    float* modp = (float*)(p.ws + WS_MOD);
    for (int job = blockIdx.x; job < 96; job += gridDim.x) {
        float* sc = (float*)lds; float* red = (float*)(lds + 65536);
        for (int i = tid; i < 16384; i += 512) { const float v = p.c[i]; sc[i] = v / (1.f + expf(-v)); }
        __syncthreads();
        const int jl = tid & 31, kq = tid >> 5, j0 = job * 32;
        float acc[16];
#pragma unroll
        for (int b = 0; b < 16; ++b) acc[b] = 0.f;
        for (int kk = 0; kk < 64; ++kk) {
            const int k = kq * 64 + kk; const float w = p.w_ada[(size_t)k * 3072 + j0 + jl];
#pragma unroll
            for (int b = 0; b < 16; ++b) acc[b] += sc[b * 1024 + k] * w;
        }
#pragma unroll
        for (int b = 0; b < 16; ++b) red[(kq * 16 + b) * 32 + jl] = acc[b];
        __syncthreads();
        { const int b = tid >> 5; float sacc = p.b_ada[j0 + jl];
          for (int q = 0; q < 16; ++q) sacc += red[(q * 16 + b) * 32 + jl];
          modp[b * 3072 + j0 + jl] = sacc; }
        __syncthreads();
    }
    if (blockIdx.x == (gridDim.x > 100 ? 100 : 0)) {
        float* Wg = (float*)(p.ws + WS_WG);
        for (int i = tid; i < 8192; i += 512) { const int g = i & 7, k = i >> 3; Wg[g * 1024 + k] = p.w_in[(size_t)k * 4616 + 2560 + g]; }
    }
    {
        float* scr = (float*)(lds + wave * 8448);
        const int NW = gridDim.x * 8, gw = NW - 1 - (blockIdx.x * 8 + wave);
        for (int it = gw; it < 2816; it += NW) {
            if (it < 2304) { const int nb = it >> 4, kb = it & 15, n0 = nb * 32;
                p0_transpose_item(p.w_in, 4616, n0 < 2560 ? n0 : n0 + 8, (u16*)(p.ws + WS_WTIN), n0, kb * 64, scr, lane); }
            else { const int r2 = it - 2304, nb = r2 >> 4, kb = r2 & 15, n0 = nb * 32;
                p0_transpose_item(p.w_out, 1024, n0, (u16*)(p.ws + WS_WTOUT), n0, kb * 64, scr, lane); }
        }
    }
}

__device__ __forceinline__ void phase1a(const Params& p) {
    extern __shared__ __attribute__((aligned(16))) unsigned char lds[];
    const int tid = opaque_tid(), lane = tid & 63, wave = tid >> 6;
    float* wg_s = (float*)lds;
    { const float* Wg = (const float*)(p.ws + WS_WG); for (int i = tid; i < 8192; i += 512) wg_s[i] = Wg[i]; }
    __syncthreads();
    const float* modp = (const float*)(p.ws + WS_MOD);
    u16* H = (u16*)(p.ws + WS_H); float* gates = (float*)(p.ws + WS_GATES);
    for (int tb = blockIdx.x * 8 + wave; tb < 2048; tb += gridDim.x * 8) {
        const int tok0 = tb * 32, b = tok0 >> 12;
        f32x4 gs[4], sh[4];
#pragma unroll
        for (int j = 0; j < 4; ++j) { const int k = lane * 4 + 256 * j; const f32x4 g = *(const f32x4*)(p.g_pre + k); const f32x4 s = *(const f32x4*)(modp + b * 3072 + 1024 + k);
            sh[j] = *(const f32x4*)(modp + b * 3072 + k); gs[j] = g * (1.f + s); }
        float bias = 0.f; if (lane < 4) bias = p.b_ig[lane]; else if (lane < 8) bias = p.b_fg[lane - 4];
        f32x4 vn[4];
#pragma unroll
        for (int j = 0; j < 4; ++j) vn[j] = __builtin_nontemporal_load((const f32x4*)(p.x + (size_t)tok0 * 1024 + lane * 4 + 256 * j));
        for (int t = 0; t < 32; ++t) {
            const size_t tok = (size_t)tok0 + t;
            f32x4 v[4]; float ss = 0.f;
#pragma unroll
            for (int j = 0; j < 4; ++j) { v[j] = vn[j]; ss += (v[j].x * v[j].x + v[j].y * v[j].y) + (v[j].z * v[j].z + v[j].w * v[j].w); }
            if (t + 1 < 32) {
#pragma unroll
                for (int j = 0; j < 4; ++j) vn[j] = __builtin_nontemporal_load((const f32x4*)(p.x + (tok + 1) * 1024 + lane * 4 + 256 * j));
            }
            ss = wave_sum(ss); const float r = rsqrtf(ss * (1.f / 1024.f) + 1e-6f);
            float part[8];
#pragma unroll
            for (int g = 0; g < 8; ++g) part[g] = 0.f;
#pragma unroll
            for (int j = 0; j < 4; ++j) {
                const f32x4 hv = v[j] * r * gs[j] + sh[j];
                u32x2 o; o.x = pk2(hv.x, hv.y); o.y = pk2(hv.z, hv.w);
                *(u32x2*)(H + tok * 1024 + lane * 4 + 256 * j) = o;
#pragma unroll
                for (int g = 0; g < 8; ++g) { const f32x4 w = *(const f32x4*)(wg_s + g * 1024 + lane * 4 + 256 * j); part[g] += (hv.x * w.x + hv.y * w.y) + (hv.z * w.z + hv.w * w.w); }
            }
#pragma unroll
            for (int g = 0; g < 8; ++g) part[g] = wave_sum(part[g]);
            float ov = part[0];
#pragma unroll
            for (int g = 1; g < 8; ++g) if (lane == g) ov = part[g];
            if (lane < 8) gates[tok * 8 + lane] = ov + bias;
        }
    }
}

constexpr int BM = 256, BK = 64, HALF = 128, HT = HALF * BK;
DEVI int lds_byte(int r, int c) { const int st = (r >> 4) * 2 + (c >> 5), rr = r & 15, cc = c & 31, ob = rr * 64 + cc * 2; return st * 1024 + (ob ^ (((ob >> 9) & 1) << 5)); }
DEVI void stage_rc(int b, int& R, int& C) { const int st = b / 1024, sb = b % 1024, swz = sb ^ (((sb >> 9) & 1) << 5); R = (st >> 1) * 16 + swz / 64; C = (st & 1) * 32 + (swz % 64) / 2; }

DEVI void gemm_unit(const int L, const int nM, const int nN, const int nwg, int& pm, int& pn) {
    int wgid = L;
    { const int q = nwg / 8, r = nwg % 8, xcd = wgid % 8, off = wgid / 8; wgid = (xcd < r ? xcd * (q + 1) : r * (q + 1) + (xcd - r) * q) + off; }
    const int nig = 8 * nN, gid = wgid / nig, fm = gid * 8, gsz = min(nM - fm, 8);
    pm = fm + ((wgid % nig) % gsz); pn = (wgid % nig) / gsz;
}
__device__ __forceinline__ void gemm_phase(const u16* __restrict__ A, const u16* __restrict__ Bt, u16* __restrict__ Out, const int nN, const int ldo) {
    extern __shared__ __attribute__((aligned(16))) unsigned char lds[];
    constexpr int K = 1024;
    const int tid = opaque_tid();
    u16* shm = (u16*)lds;
#define SA(b, h) (shm + ((b) * 2 + (h)) * HT)
#define SB(b, h) (shm + (4 + (b) * 2 + (h)) * HT)
#define STAGE(Pp, BASE, br, kt) do { const u16* _gb = (BASE) + ((size_t)(br) * K + (size_t)(kt) * BK); \
      __builtin_amdgcn_global_load_lds((const unsigned*)(_gb + so0), (unsigned*)((char*)(Pp) + tid * 16), 16, 0, 0); \
      __builtin_amdgcn_global_load_lds((const unsigned*)(_gb + 64 * K + so0), (unsigned*)((char*)(Pp) + tid * 16 + 8192), 16, 0, 0); } while (0)
#define LDA(dst, b, h) for (int m = 0; m < 4; ++m) for (int k = 0; k < 2; ++k) \
    dst[m][k] = *reinterpret_cast<const bf16x8*>((char*)SA(b, h) + lds_byte(wr * 64 + m * 16 + fr, k * 32 + fq * 8))
#define LDB(dst, b, h) for (int n = 0; n < 2; ++n) for (int k = 0; k < 2; ++k) \
    dst[n][k] = *reinterpret_cast<const bf16x8*>((char*)SB(b, h) + lds_byte(wc * 32 + n * 16 + fr, k * 32 + fq * 8))
#define MMA(ai, bj, At_, Bt_) do { __builtin_amdgcn_s_setprio(1); \
    for (int m = 0; m < 4; ++m) for (int n = 0; n < 2; ++n) for (int k = 0; k < 2; ++k) \
      acc[ai][bj][m][n] = __builtin_amdgcn_mfma_f32_16x16x32_bf16(Bt_[n][k], At_[m][k], acc[ai][bj][m][n], 0, 0, 0); \
    __builtin_amdgcn_s_setprio(0); } while (0)
#define WAIT_V(n) asm volatile("s_waitcnt vmcnt(" #n ")" ::: "memory")
#define WAIT_L(n) asm volatile("s_waitcnt lgkmcnt(" #n ")" ::: "memory")
#define BAR __builtin_amdgcn_s_barrier()
#define SCHED __builtin_amdgcn_sched_barrier(0)
#define EPILOGUE(ROW, COL) do { \
    _Pragma("unroll") for (int ai = 0; ai < 2; ++ai) \
    _Pragma("unroll") for (int m = 0; m < 4; ++m) { \
        u16* rowp = Out + (size_t)((ROW) + ai * HALF + wr * 64 + m * 16 + fr) * ldo + (COL) + wc * 32 + 8 * fq; \
        _Pragma("unroll") for (int bj = 0; bj < 2; ++bj) { \
            const f32x4 v0 = acc[ai][bj][m][0], v1 = acc[ai][bj][m][1]; \
            u32x4 w; w.x = pk2(v0[0], v0[1]); w.y = pk2(v0[2], v0[3]); w.z = pk2(v1[0], v1[1]); w.w = pk2(v1[2], v1[3]); \
            *(u32x4*)(rowp + bj * HALF) = w; \
        } } } while (0)
    const int wid = tid >> 6, lane = tid & 63, wr = wid >> 2, wc = wid & 3, fr = lane & 15, fq = lane >> 4;
    unsigned so0;
    { int r_, c_; stage_rc(tid * 16, r_, c_); so0 = (unsigned)(r_ * K + c_); }
    constexpr int nt = K / BK;
    const int nM = NTOK / BM, nwg = nM * nN, G = gridDim.x;
    int L = blockIdx.x;
    if (L < nwg) {
        int brow, bcol;
        { int pm, pn; gemm_unit(L, nM, nN, nwg, pm, pn); brow = pm * BM; bcol = pn * BM; }
        f32x4 acc[2][2][4][2] = {};
        bf16x8 At[4][2], B0[2][2], B1[2][2];
        STAGE(SB(0, 0), Bt, bcol, 0); STAGE(SA(0, 0), A, brow, 0);
        STAGE(SB(0, 1), Bt, bcol + HALF, 0); STAGE(SA(0, 1), A, brow + HALF, 0);
        if (wr == 1) BAR;
        WAIT_V(4); BAR;
        STAGE(SB(1, 0), Bt, bcol, 1); STAGE(SA(1, 0), A, brow, 1); STAGE(SB(1, 1), Bt, bcol + HALF, 1);
        WAIT_V(6); BAR;
        for (;;) {
            const bool last = (L + G >= nwg);
            int nbrow = brow, nbcol = bcol;
            if (!last) { int qm, qn; gemm_unit(L + G, nM, nN, nwg, qm, qn); nbrow = qm * BM; nbcol = qn * BM; }
            const int tend = last ? nt - 2 : nt;
            for (int t = 0; t < tend; t += 2) {
                const bool bnd = (t == nt - 2);
                const int r2 = bnd ? nbrow : brow, c2 = bnd ? nbcol : bcol, k2 = bnd ? 0 : t + 2, k3 = bnd ? 1 : t + 3;
                LDB(B0, 0, 0); SCHED; LDA(At, 0, 0); STAGE(SA(1, 1), A, brow + HALF, t + 1);
                WAIT_L(8); BAR; WAIT_L(0); MMA(0, 0, At, B0); BAR; SCHED;
                LDB(B1, 0, 1); STAGE(SB(0, 0), Bt, c2, k2);
                BAR; WAIT_L(0); MMA(0, 1, At, B1); BAR;
                LDA(At, 0, 1); STAGE(SA(0, 0), A, r2, k2);
                BAR; WAIT_L(0); MMA(1, 0, At, B0); BAR; SCHED;
                STAGE(SB(0, 1), Bt, c2 + HALF, k2);
                WAIT_V(6); BAR; MMA(1, 1, At, B1); BAR;
                LDB(B0, 1, 0); SCHED; LDA(At, 1, 0); STAGE(SA(0, 1), A, r2 + HALF, k2);
                WAIT_L(8); BAR; WAIT_L(0); MMA(0, 0, At, B0); BAR; SCHED;
                LDB(B1, 1, 1); STAGE(SB(1, 0), Bt, c2, k3);
                BAR; WAIT_L(0); MMA(0, 1, At, B1); BAR;
                LDA(At, 1, 1); STAGE(SA(1, 0), A, r2, k3);
                BAR; WAIT_L(0); MMA(1, 0, At, B0); BAR; SCHED;
                STAGE(SB(1, 1), Bt, c2 + HALF, k3);
                WAIT_V(6); BAR; MMA(1, 1, At, B1); BAR;
            }
            if (last) break;
            EPILOGUE(brow, bcol);
#pragma unroll
            for (int ai = 0; ai < 2; ++ai)
#pragma unroll
                for (int bj = 0; bj < 2; ++bj)
#pragma unroll
                    for (int m = 0; m < 4; ++m)
#pragma unroll
                        for (int n = 0; n < 2; ++n) acc[ai][bj][m][n] = (f32x4){0.f, 0.f, 0.f, 0.f};
            brow = nbrow; bcol = nbcol; L += G;
        }
        { LDB(B0, 0, 0); LDA(At, 0, 0); STAGE(SA(1, 1), A, brow + HALF, nt - 1);
          BAR; WAIT_L(0); MMA(0, 0, At, B0); BAR;
          LDB(B1, 0, 1); BAR; WAIT_L(0); MMA(0, 1, At, B1); BAR;
          LDA(At, 0, 1); WAIT_V(4); BAR; WAIT_L(0); MMA(1, 0, At, B0); MMA(1, 1, At, B1); BAR; }
        { LDB(B0, 1, 0); LDA(At, 1, 0); WAIT_V(2); BAR; WAIT_L(0); MMA(0, 0, At, B0); BAR;
          LDB(B1, 1, 1); WAIT_V(0); BAR; WAIT_L(0); MMA(0, 1, At, B1); BAR;
          LDA(At, 1, 1); BAR; WAIT_L(0); MMA(1, 0, At, B0); MMA(1, 1, At, B1); BAR; }
        if (wr == 0) BAR;
        EPILOGUE(brow, bcol);
    }
    __syncthreads();
#undef SA
#undef SB
#undef STAGE
#undef LDA
#undef LDB
#undef MMA
#undef EPILOGUE
}

__device__ __forceinline__ void mlstm_pass1(const Params& p, const int item, const int grp) {
    extern __shared__ __attribute__((aligned(16))) unsigned char lds[];
    const int tid = opaque_tid(), lane = tid & 63, w = tid >> 6, i16 = lane & 15, g4 = lane >> 4;
    const int b = item >> 2, hh = item & 3;
    u16* q_s = (u16*)(lds + 0); u16* k_s = (u16*)(lds + 17408); float* out_s = (float*)lds;
    u16* wkT_s = (u16*)(lds + 34816); u16* vT_s = (u16*)(lds + 53248); u16* S_s = (u16*)(lds + 73984);
    u16* CT_s = (u16*)(lds + 83200); float* den_s = (float*)(lds + 122368); float* a_s = (float*)(lds + 122368 + 256); float* ml_s = a_s + 64;
    const u16* P = (const u16*)(p.ws + WS_P); const float* gates = (const float*)(p.ws + WS_GATES);
    u16* NDn = (u16*)(p.ws + WS_NDNUM); u16* Q2 = (u16*)(p.ws + WS_Q2); float* AUX = (float*)(p.ws + WS_AUX);
    const int c0 = grp * 16;
    const size_t tokb = (size_t)b * 4096;
    for (int i = tid; i < 144 * 136 / 2; i += 512) ((unsigned*)CT_s)[i] = 0u;
    for (int i = tid; i < 16 * 72; i += 512) vT_s[128 * 72 + i] = (i < 72) ? (u16)0x3F80 : (u16)0;
    const int cp = tid & 63, t0 = 8 * w, ch = 2 * cp;
    float cwq[4][2], cwk[4][2], cbq[2], cbk[2];
#pragma unroll
    for (int j = 0; j < 4; ++j)
#pragma unroll
        for (int e = 0; e < 2; ++e) { cwq[j][e] = p.conv_w[j * 1024 + hh * 128 + ch + e]; cwk[j][e] = p.conv_w[j * 1024 + 512 + hh * 128 + ch + e]; }
#pragma unroll
    for (int e = 0; e < 2; ++e) { cbq[e] = p.conv_b[hh * 128 + ch + e]; cbk[e] = p.conv_b[512 + hh * 128 + ch + e]; }
    f32x4 Cacc[8], Cacc8 = {0.f, 0.f, 0.f, 0.f};
#pragma unroll
    for (int i = 0; i < 8; ++i) Cacc[i] = (f32x4){0.f, 0.f, 0.f, 0.f};
    for (int cc = w; cc < c0; cc += 8) {
        const size_t tk = tokb + (size_t)cc * 64 + lane;
        const float gi = gates[tk * 8 + hh], gf = gates[tk * 8 + 4 + hh];
        const float logf = fminf(gf, 0.f) - log1pf(expf(-fabsf(gf)));
        float bcs = logf;
#pragma unroll
        for (int o = 1; o < 64; o <<= 1) { const float u = __shfl_up(bcs, o); if (lane >= o) bcs += u; }
        const float a_tot = __shfl(bcs, 63);
        const float igb = gi - bcs;
        const float gg = a_tot + igb;
        const float m_loc = wave_max(gg);
        if (lane == 0) { a_s[cc] = a_tot; ml_s[cc] = m_loc; }
    }
    __syncthreads();
    float m_prev = 0.f;
    for (int cc = 0; cc < c0; ++cc) m_prev = fmaxf(a_s[cc] + m_prev, ml_s[cc]);
    float Pc = 1.f;
    const int et = tid >> 3, ec = (tid & 7) * 16;
    unsigned rq[11], rk[11], rv[8]; float gi_n, gf_n;
    {
        const size_t tokc = tokb + (size_t)c0 * 64;
#pragma unroll
        for (int i = 0; i < 11; ++i) { const int row = t0 - 3 + i; const bool ok = (c0 > 0) || (row >= 0); const size_t o = (size_t)((long)tokc + (ok ? row : 0)) * NP + hh * 128 + ch;
            rq[i] = ok ? *(const unsigned*)(P + o) : 0u; rk[i] = ok ? *(const unsigned*)(P + o + 512) : 0u; }
#pragma unroll
        for (int i = 0; i < 8; ++i) rv[i] = *(const unsigned*)(P + (tokc + t0 + i) * NP + 1024 + hh * 128 + ch);
        gi_n = gates[(tokc + lane) * 8 + hh]; gf_n = gates[(tokc + lane) * 8 + 4 + hh];
    }
    for (int c = c0; c < c0 + 16; ++c) {
        const size_t tokc = tokb + (size_t)c * 64;
        const size_t tq = (size_t)item * 4096 + (size_t)c * 64;
        const float gi = gi_n, gf = gf_n;
        const float logf = fminf(gf, 0.f) - log1pf(expf(-fabsf(gf)));
        float bcs = logf;
#pragma unroll
        for (int o = 1; o < 64; o <<= 1) { const float u = __shfl_up(bcs, o); if (lane >= o) bcs += u; }
        const float a_tot = __shfl(bcs, 63);
        const float igb = gi - bcs;
        const float gg = a_tot + igb;
        const float m_loc = wave_max(gg);
        const float m_new = fmaxf(a_tot + m_prev, m_loc);
        const float s_old = expf(a_tot + m_prev - m_new);
        const float wp = expf(gg - m_new);
        float mx = igb;
#pragma unroll
        for (int o = 1; o < 64; o <<= 1) { const float u = __shfl_up(mx, o); if (lane >= o) mx = fmaxf(mx, u); }
        const float m_t = bcs + fmaxf(m_prev, mx);
        const float iw = expf(bcs + m_prev - m_t);
        const float bm = bcs - m_t;
        {
            float kv0[8], kv1[8];
#pragma unroll
            for (int i = 0; i < 8; ++i) {
                float aq0 = cbq[0], aq1 = cbq[1], ak0 = cbk[0], ak1 = cbk[1];
#pragma unroll
                for (int j = 0; j < 4; ++j) { aq0 += cwq[j][0] * bflo(rq[i + j]); aq1 += cwq[j][1] * bfhi(rq[i + j]); ak0 += cwk[j][0] * bflo(rk[i + j]); ak1 += cwk[j][1] * bfhi(rk[i + j]); }
                const float q0 = aq0 * __builtin_amdgcn_rcpf(1.f + __expf(-aq0)), q1 = aq1 * __builtin_amdgcn_rcpf(1.f + __expf(-aq1));
                const float k0 = ak0 * __builtin_amdgcn_rcpf(1.f + __expf(-ak0)) * 0.08838834764831845f, k1 = ak1 * __builtin_amdgcn_rcpf(1.f + __expf(-ak1)) * 0.08838834764831845f;
                *(unsigned*)(q_s + (t0 + i) * 136 + ch) = pk2(q0, q1);
                *(unsigned*)(k_s + (t0 + i) * 136 + ch) = pk2(k0, k1);
                const float wpi = __shfl(wp, t0 + i);
                kv0[i] = k0 * wpi; kv1[i] = k1 * wpi;
            }
            u32x4 o0, o1;
            o0.x = pk2(kv0[0], kv0[1]); o0.y = pk2(kv0[2], kv0[3]); o0.z = pk2(kv0[4], kv0[5]); o0.w = pk2(kv0[6], kv0[7]);
            o1.x = pk2(kv1[0], kv1[1]); o1.y = pk2(kv1[2], kv1[3]); o1.z = pk2(kv1[4], kv1[5]); o1.w = pk2(kv1[6], kv1[7]);
            *(u32x4*)(wkT_s + ch * 72 + t0) = o0; *(u32x4*)(wkT_s + (ch + 1) * 72 + t0) = o1;
            u32x4 v0, v1;
            v0.x = (rv[0] & 0xffffu) | (rv[1] << 16); v0.y = (rv[2] & 0xffffu) | (rv[3] << 16); v0.z = (rv[4] & 0xffffu) | (rv[5] << 16); v0.w = (rv[6] & 0xffffu) | (rv[7] << 16);
            v1.x = (rv[0] >> 16) | (rv[1] & 0xffff0000u); v1.y = (rv[2] >> 16) | (rv[3] & 0xffff0000u); v1.z = (rv[4] >> 16) | (rv[5] & 0xffff0000u); v1.w = (rv[6] >> 16) | (rv[7] & 0xffff0000u);
            *(u32x4*)(vT_s + ch * 72 + t0) = v0; *(u32x4*)(vT_s + (ch + 1) * 72 + t0) = v1;
        }
        if (c + 1 < c0 + 16) {
            const size_t tn = tokc + 64;
#pragma unroll
            for (int i = 0; i < 11; ++i) { const size_t o = (tn + t0 - 3 + i) * NP + hh * 128 + ch; rq[i] = *(const unsigned*)(P + o); rk[i] = *(const unsigned*)(P + o + 512); }
#pragma unroll
            for (int i = 0; i < 8; ++i) rv[i] = *(const unsigned*)(P + (tn + t0 + i) * NP + 1024 + hh * 128 + ch);
            gi_n = gates[(tn + lane) * 8 + hh]; gf_n = gates[(tn + lane) * 8 + 4 + hh];
        }
        __syncthreads();
        {
            const u32x4 qa = *(const u32x4*)(q_s + et * 136 + ec), qb = *(const u32x4*)(q_s + et * 136 + ec + 8);
            u16* qd = Q2 + (tq + et) * 128 + ec; *(u32x4*)qd = qa; *(u32x4*)(qd + 8) = qb;
            if (w == 0) { AUX[(tq + lane) * 4 + 0] = iw * Pc; AUX[(tq + lane) * 4 + 1] = expf(-m_t); }
        }
        {
            const int ti = w >> 1;
#pragma unroll
            for (int sj = 0; sj < 2; ++sj) {
                const int si = 2 * (w & 1) + sj;
                f32x4 acc = {0.f, 0.f, 0.f, 0.f};
                if (si <= ti) {
#pragma unroll
                    for (int ks = 0; ks < 4; ++ks) {
                        const bf16x8 a = *(const bf16x8*)(q_s + (16 * ti + i16) * 136 + 32 * ks + 8 * g4);
                        const bf16x8 bb = *(const bf16x8*)(k_s + (16 * si + i16) * 136 + 32 * ks + 8 * g4);
                        acc = mfma16(a, bb, acc);
                    }
                }
                const int s = 16 * si + i16; const float igb_s = __shfl(igb, s);
#pragma unroll
                for (int r = 0; r < 4; ++r) {
                    const int t = 16 * ti + 4 * g4 + r; const float bm_t = __shfl(bm, t);
                    const float val = (s <= t) ? acc[r] * __expf(bm_t + igb_s) : 0.f;
                    S_s[t * 72 + s] = (u16)(pk2(val, 0.f) & 0xffffu);
                }
            }
        }
        f32x4 accO[4], accO8 = {0.f, 0.f, 0.f, 0.f};
#pragma unroll
        for (int ti = 0; ti < 4; ++ti) {
            f32x4 acc = {0.f, 0.f, 0.f, 0.f};
#pragma unroll
            for (int ks = 0; ks < 4; ++ks) {
                const bf16x8 a = *(const bf16x8*)(q_s + (16 * ti + i16) * 136 + 32 * ks + 8 * g4);
                const bf16x8 bb = *(const bf16x8*)(CT_s + (16 * w + i16) * 136 + 32 * ks + 8 * g4);
                acc = mfma16(a, bb, acc);
            }
#pragma unroll
            for (int r = 0; r < 4; ++r) acc[r] *= __shfl(iw, 16 * ti + 4 * g4 + r);
            accO[ti] = acc;
        }
        if (w < 4) {
            f32x4 acc = {0.f, 0.f, 0.f, 0.f};
#pragma unroll
            for (int ks = 0; ks < 4; ++ks) {
                const bf16x8 a = *(const bf16x8*)(q_s + (16 * w + i16) * 136 + 32 * ks + 8 * g4);
                const bf16x8 bb = *(const bf16x8*)(CT_s + (128 + i16) * 136 + 32 * ks + 8 * g4);
                acc = mfma16(a, bb, acc);
            }
#pragma unroll
            for (int r = 0; r < 4; ++r) acc[r] *= __shfl(iw, 16 * w + 4 * g4 + r);
            accO8 = acc;
        }
        __syncthreads();
#pragma unroll
        for (int ti = 0; ti < 4; ++ti)
#pragma unroll
            for (int ks = 0; ks < 2; ++ks) {
                const bf16x8 a = *(const bf16x8*)(S_s + (16 * ti + i16) * 72 + 32 * ks + 8 * g4);
                const bf16x8 bb = *(const bf16x8*)(vT_s + (16 * w + i16) * 72 + 32 * ks + 8 * g4);
                accO[ti] = mfma16(a, bb, accO[ti]);
            }
        if (w < 4) {
#pragma unroll
            for (int ks = 0; ks < 2; ++ks) {
                const bf16x8 a = *(const bf16x8*)(S_s + (16 * w + i16) * 72 + 32 * ks + 8 * g4);
                const bf16x8 bb = *(const bf16x8*)(vT_s + (128 + i16) * 72 + 32 * ks + 8 * g4);
                accO8 = mfma16(a, bb, accO8);
            }
        }
#pragma unroll
        for (int ti = 0; ti < 4; ++ti)
#pragma unroll
            for (int r = 0; r < 4; ++r) out_s[(16 * ti + 4 * g4 + r) * 132 + 16 * w + i16] = accO[ti][r];
        if (w < 4 && i16 == 0) {
#pragma unroll
            for (int r = 0; r < 4; ++r) den_s[16 * w + 4 * g4 + r] = accO8[r];
        }
        __syncthreads();
        {
            float nv[16];
#pragma unroll
            for (int j = 0; j < 16; ++j) nv[j] = out_s[et * 132 + ec + j];
            u32x4 s0, s1;
            s0.x = pk2(nv[0], nv[1]); s0.y = pk2(nv[2], nv[3]); s0.z = pk2(nv[4], nv[5]); s0.w = pk2(nv[6], nv[7]);
            s1.x = pk2(nv[8], nv[9]); s1.y = pk2(nv[10], nv[11]); s1.z = pk2(nv[12], nv[13]); s1.w = pk2(nv[14], nv[15]);
            u16* dst = NDn + (tq + et) * 128 + ec;
            *(u32x4*)dst = s0; *(u32x4*)(dst + 8) = s1;
            if ((tid & 7) == 0) AUX[(tq + et) * 4 + 2] = den_s[et];
        }
#pragma unroll
        for (int ki = 0; ki < 8; ++ki) {
            f32x4 acc = Cacc[ki] * s_old;
#pragma unroll
            for (int ks = 0; ks < 2; ++ks) {
                const bf16x8 a = *(const bf16x8*)(wkT_s + (16 * ki + i16) * 72 + 32 * ks + 8 * g4);
                const bf16x8 bb = *(const bf16x8*)(vT_s + (16 * w + i16) * 72 + 32 * ks + 8 * g4);
                acc = mfma16(a, bb, acc);
            }
            Cacc[ki] = acc;
            u32x2 pkd; pkd.x = pk2(acc[0], acc[1]); pkd.y = pk2(acc[2], acc[3]);
            *(u32x2*)(CT_s + (16 * w + i16) * 136 + 16 * ki + 4 * g4) = pkd;
        }
        {
            f32x4 acc = Cacc8 * s_old;
#pragma unroll
            for (int ks = 0; ks < 2; ++ks) {
                const bf16x8 a = *(const bf16x8*)(wkT_s + (16 * w + i16) * 72 + 32 * ks + 8 * g4);
                const bf16x8 bb = *(const bf16x8*)(vT_s + (128 + i16) * 72 + 32 * ks + 8 * g4);
                acc = mfma16(a, bb, acc);
            }
            Cacc8 = acc;
            u32x2 pkd; pkd.x = pk2(acc[0], acc[1]); pkd.y = pk2(acc[2], acc[3]);
            *(u32x2*)(CT_s + (128 + i16) * 136 + 16 * w + 4 * g4) = pkd;
        }
        m_prev = m_new; Pc *= s_old;
        __syncthreads();
    }
    {
        float* E = (float*)(p.ws + WS_E) + (size_t)(item * 4 + grp) * 144 * 128;
#pragma unroll
        for (int ki = 0; ki < 8; ++ki) *(f32x4*)(E + (16 * w + i16) * 128 + 16 * ki + 4 * g4) = Cacc[ki];
        *(f32x4*)(E + (128 + i16) * 128 + 16 * w + 4 * g4) = Cacc8;
        if (tid == 0) ((float*)(p.ws + WS_DG))[item * 4 + grp] = Pc;
    }
}

__device__ __forceinline__ void mlstm_pass2(const Params& p, const int item, const int grp) {
    extern __shared__ __attribute__((aligned(16))) unsigned char lds[];
    const int tid = opaque_tid(), lane = tid & 63, w = tid >> 6, i16 = lane & 15, g4 = lane >> 4;
    const int b = item >> 2, hh = item & 3;
    u16* q_s = (u16*)(lds + 0); float* o2_s = (float*)(lds + 17408); float* den2_s = (float*)(lds + 51200); u16* CT_s = (u16*)(lds + 83200);
    const u16* P = (const u16*)(p.ws + WS_P); u16* Hm = (u16*)(p.ws + WS_HMIX);
    const u16* NDn = (const u16*)(p.ws + WS_NDNUM); const u16* Q2 = (const u16*)(p.ws + WS_Q2); const float* AUX = (const float*)(p.ws + WS_AUX);
    const size_t tokb = (size_t)b * 4096;
    const int et = tid >> 3, ec = (tid & 7) * 16;
    if (grp > 0) {
        float cf[3] = {0.f, 0.f, 0.f}; float run = 1.f;
#pragma unroll
        for (int gp = 2; gp >= 0; --gp) if (gp < grp) { cf[gp] = run; run *= __hip_atomic_load((float*)(p.ws + WS_DG) + item * 4 + gp, __ATOMIC_RELAXED, __HIP_MEMORY_SCOPE_AGENT); }
        const float* E = (const float*)(p.ws + WS_E) + (size_t)(item * 4) * 144 * 128;
        for (int i = tid; i < 144 * 128; i += 512) {
            float sacc = 0.f;
#pragma unroll
            for (int gp = 0; gp < 3; ++gp) if (gp < grp) sacc += cf[gp] * E[(size_t)gp * 144 * 128 + i];
            CT_s[(i >> 7) * 136 + (i & 127)] = (u16)(pk2(sacc, 0.f) & 0xffffu);
        }
    }
    __syncthreads();
    float gml[16];
#pragma unroll
    for (int j = 0; j < 16; ++j) gml[j] = p.g_ml[hh * 128 + ec + j];
    u32x4 qa_n, qb_n, nd_n[2], ov_n[2], zv_n[2]; f32x4 ax_n;
    {
        const int c = grp * 16;
        const size_t tokc = tokb + (size_t)c * 64, tq = (size_t)item * 4096 + (size_t)c * 64;
        const u16* qsrc = Q2 + (tq + et) * 128 + ec; qa_n = *(const u32x4*)qsrc; qb_n = *(const u32x4*)(qsrc + 8);
        ax_n = *(const f32x4*)(AUX + (tq + lane) * 4);
        const u16* ns = NDn + (tq + et) * 128 + ec; nd_n[0] = *(const u32x4*)ns; nd_n[1] = *(const u32x4*)(ns + 8);
        const u16* po = P + (tokc + et) * NP + 1536 + hh * 128 + ec; ov_n[0] = *(const u32x4*)po; ov_n[1] = *(const u32x4*)(po + 8);
        zv_n[0] = *(const u32x4*)(po + 512); zv_n[1] = *(const u32x4*)(po + 520);
    }
    for (int cl = 0; cl < 16; ++cl) {
        const int c = grp * 16 + cl;
        const size_t tokc = tokb + (size_t)c * 64;
        *(u32x4*)(q_s + et * 136 + ec) = qa_n; *(u32x4*)(q_s + et * 136 + ec + 8) = qb_n;
        const f32x4 ax = ax_n;
        u32x4 nd[2], ov[2], zv[2];
        nd[0] = nd_n[0]; nd[1] = nd_n[1]; ov[0] = ov_n[0]; ov[1] = ov_n[1]; zv[0] = zv_n[0]; zv[1] = zv_n[1];
        __syncthreads();
        if (cl + 1 < 16) {
            const size_t tokn = tokc + 64, tqn = (size_t)item * 4096 + (size_t)(c + 1) * 64;
            const u16* qsrc = Q2 + (tqn + et) * 128 + ec; qa_n = *(const u32x4*)qsrc; qb_n = *(const u32x4*)(qsrc + 8);
            ax_n = *(const f32x4*)(AUX + (tqn + lane) * 4);
            const u16* ns = NDn + (tqn + et) * 128 + ec; nd_n[0] = *(const u32x4*)ns; nd_n[1] = *(const u32x4*)(ns + 8);
            const u16* po = P + (tokn + et) * NP + 1536 + hh * 128 + ec; ov_n[0] = *(const u32x4*)po; ov_n[1] = *(const u32x4*)(po + 8);
            zv_n[0] = *(const u32x4*)(po + 512); zv_n[1] = *(const u32x4*)(po + 520);
        }
        asm volatile("" ::: "memory");
        if (grp > 0) {
#pragma unroll
            for (int ti = 0; ti < 4; ++ti) {
                f32x4 acc = {0.f, 0.f, 0.f, 0.f};
#pragma unroll
                for (int ks = 0; ks < 4; ++ks) {
                    const bf16x8 a = *(const bf16x8*)(q_s + (16 * ti + i16) * 136 + 32 * ks + 8 * g4);
                    const bf16x8 bb = *(const bf16x8*)(CT_s + (16 * w + i16) * 136 + 32 * ks + 8 * g4);
                    acc = mfma16(a, bb, acc);
                }
#pragma unroll
                for (int r = 0; r < 4; ++r) o2_s[(16 * ti + 4 * g4 + r) * 132 + 16 * w + i16] = acc[r] * __shfl(ax.x, 16 * ti + 4 * g4 + r);
            }
            if (w < 4) {
                f32x4 acc = {0.f, 0.f, 0.f, 0.f};
#pragma unroll
                for (int ks = 0; ks < 4; ++ks) {
                    const bf16x8 a = *(const bf16x8*)(q_s + (16 * w + i16) * 136 + 32 * ks + 8 * g4);
                    const bf16x8 bb = *(const bf16x8*)(CT_s + (128 + i16) * 136 + 32 * ks + 8 * g4);
                    acc = mfma16(a, bb, acc);
                }
#pragma unroll
                for (int r = 0; r < 4; ++r) { const float v = acc[r] * __shfl(ax.x, 16 * w + 4 * g4 + r); if (i16 == 0) den2_s[16 * w + 4 * g4 + r] = v; }
            }
        }
        __syncthreads();
        {
            const float den = __shfl(ax.z, et) + (grp > 0 ? den2_s[et] : 0.f);
            const float inv = 1.f / fmaxf(fabsf(den), __shfl(ax.y, et));
            float ho[16]; float ss = 0.f;
#pragma unroll
            for (int j = 0; j < 16; ++j) {
                const unsigned wn = nd[j >> 3][(j >> 1) & 3]; float num = (j & 1) ? bfhi(wn) : bflo(wn);
                if (grp > 0) num += o2_s[et * 132 + ec + j];
                const unsigned wv = ov[j >> 3][(j >> 1) & 3]; const float o = (j & 1) ? bfhi(wv) : bflo(wv);
                ho[j] = num * inv * __builtin_amdgcn_rcpf(1.f + __expf(-o)); ss += ho[j] * ho[j];
            }
            ss += __shfl_xor(ss, 1); ss += __shfl_xor(ss, 2); ss += __shfl_xor(ss, 4);
            const float rr = rsqrtf(ss * (1.f / 128.f) + 1e-6f);
            float ob[16];
#pragma unroll
            for (int j = 0; j < 16; ++j) {
                const unsigned wv = zv[j >> 3][(j >> 1) & 3]; const float z = (j & 1) ? bfhi(wv) : bflo(wv);
                ob[j] = ho[j] * rr * gml[j] * (z * __builtin_amdgcn_rcpf(1.f + __expf(-z)));
            }
            u32x4 s0, s1;
            s0.x = pk2(ob[0], ob[1]); s0.y = pk2(ob[2], ob[3]); s0.z = pk2(ob[4], ob[5]); s0.w = pk2(ob[6], ob[7]);
            s1.x = pk2(ob[8], ob[9]); s1.y = pk2(ob[10], ob[11]); s1.z = pk2(ob[12], ob[13]); s1.w = pk2(ob[14], ob[15]);
            u16* dst = Hm + (tokc + et) * 1024 + hh * 128 + ec;
            *(u32x4*)dst = s0; *(u32x4*)(dst + 8) = s1;
        }
        __syncthreads();
    }
}

__device__ __forceinline__ void sb_unit(const Params& p, const int unit, u16* vT, const int lane) {
    const u16* P = (const u16*)(p.ws + WS_P); u16* Hm = (u16*)(p.ws + WS_HMIX);
    const int qt = unit & 127, hd = (unit >> 7) & 7, b = unit >> 10;
    const int r = lane & 31, h = lane >> 5;
    const size_t tokb = (size_t)b * 4096;
    bf16x8 qf[4];
    { const u16* qrow = P + (tokb + qt * 32 + r) * NP + 2560 + hd * 64 + 8 * h;
#pragma unroll
      for (int ks = 0; ks < 4; ++ks) qf[ks] = *(const bf16x8*)(qrow + 16 * ks); }
    u32x4 Tw[2];
#pragma unroll
    for (int st = 0; st < 2; ++st) {
        unsigned tw[4];
#pragma unroll
        for (int e = 0; e < 8; e += 2) {
            const int j0 = 16 * st + 8 * (e >> 2) + 4 * h + (e & 3), j1 = j0 + 1;
            tw[e >> 1] = ((j0 > r) ? 0x3C00u : 0u) | ((j1 > r) ? 0x3C000000u : 0u);
        }
        Tw[st].x = tw[0]; Tw[st].y = tw[1]; Tw[st].z = tw[2]; Tw[st].w = tw[3];
    }
    f32x16 O0, O1;
#pragma unroll
    for (int i = 0; i < 16; ++i) { O0[i] = 0.f; O1[i] = 0.f; }
    float R2 = 0.f;
    const float SC = 0.125f * 1.4426950408889634f;
    const size_t tok = tokb + qt * 32 + r;
    u32x2 zz8[8];
#pragma unroll
    for (int i = 0; i < 8; ++i) zz8[i] = *(const u32x2*)(P + tok * NP + 4096 + hd * 64 + 32 * (i >> 2) + 8 * (i & 3) + 4 * h);
    asm volatile("" ::: "memory");
    bf16x8 kfn[4]; u32x4 vvn[4];
    { const u16* krow = P + (tokb + qt * 32 + r) * NP + 3072 + hd * 64 + 8 * h;
#pragma unroll
      for (int ks = 0; ks < 4; ++ks) kfn[ks] = *(const bf16x8*)(krow + 16 * ks);
      const u16* vrow = P + (tokb + qt * 32 + (lane >> 1)) * NP + 3584 + hd * 64 + (lane & 1) * 32;
#pragma unroll
      for (int i = 0; i < 4; ++i) vvn[i] = *(const u32x4*)(vrow + 8 * i); }
    for (int kb = qt; kb >= 0; --kb) {
        bf16x8 kf[4]; u32x4 vv[4];
#pragma unroll
        for (int i = 0; i < 4; ++i) { kf[i] = kfn[i]; vv[i] = vvn[i]; }
        asm volatile("" ::: "memory");
        if (kb > 0) {
            const int s1 = (kb - 1) * 32;
            const u16* krow = P + (tokb + s1 + r) * NP + 3072 + hd * 64 + 8 * h;
#pragma unroll
            for (int ks = 0; ks < 4; ++ks) kfn[ks] = *(const bf16x8*)(krow + 16 * ks);
            const u16* vrow = P + (tokb + s1 + (lane >> 1)) * NP + 3584 + hd * 64 + (lane & 1) * 32;
#pragma unroll
            for (int i = 0; i < 4; ++i) vvn[i] = *(const u32x4*)(vrow + 8 * i);
        }
        asm volatile("" ::: "memory");
        f32x16 Z;
#pragma unroll
        for (int i = 0; i < 16; ++i) Z[i] = 0.f;
#pragma unroll
        for (int ks = 0; ks < 4; ++ks) Z = mfma32(kf[ks], qf[ks], Z);
        float lbv[16], lkv[16];
#pragma unroll
        for (int reg = 0; reg < 16; ++reg) {
            const float u = Z[reg] * SC;
            const float sp = __builtin_amdgcn_logf(1.f + __builtin_amdgcn_exp2f(-fabsf(u)));
            lbv[reg] = fminf(u, 0.f) - sp;
            lkv[reg] = lbv[reg] - u;
        }
        if (kb == qt) {
#pragma unroll
            for (int reg = 0; reg < 16; ++reg) {
                const int sl = (reg & 3) + 8 * (reg >> 2) + 4 * h;
                const bool valid = sl < r;
                lbv[reg] = valid ? lbv[reg] : -1e30f;
                lkv[reg] = valid ? lkv[reg] : 0.f;
            }
        }
        u32x4 lw[2];
#pragma unroll
        for (int st = 0; st < 2; ++st) {
            lw[st].x = pkh2(lkv[8 * st + 0], lkv[8 * st + 1]); lw[st].y = pkh2(lkv[8 * st + 2], lkv[8 * st + 3]);
            lw[st].z = pkh2(lkv[8 * st + 4], lkv[8 * st + 5]); lw[st].w = pkh2(lkv[8 * st + 6], lkv[8 * st + 7]);
        }
        f32x16 aft;
#pragma unroll
        for (int i = 0; i < 16; ++i) aft[i] = 0.f;
        aft = __builtin_amdgcn_mfma_f32_32x32x16_f16(__builtin_bit_cast(f16x8, Tw[0]), __builtin_bit_cast(f16x8, lw[0]), aft, 0, 0, 0);
        aft = __builtin_amdgcn_mfma_f32_32x32x16_f16(__builtin_bit_cast(f16x8, Tw[1]), __builtin_bit_cast(f16x8, lw[1]), aft, 0, 0, 0);
        const float tot = __shfl(aft[0] + lkv[0], r);
        bf16x8 pf[2];
#pragma unroll
        for (int st = 0; st < 2; ++st) {
            u32x4 pw;
            pw.x = pk2(__builtin_amdgcn_exp2f(lbv[8 * st + 0] + R2 + aft[8 * st + 0]), __builtin_amdgcn_exp2f(lbv[8 * st + 1] + R2 + aft[8 * st + 1]));
            pw.y = pk2(__builtin_amdgcn_exp2f(lbv[8 * st + 2] + R2 + aft[8 * st + 2]), __builtin_amdgcn_exp2f(lbv[8 * st + 3] + R2 + aft[8 * st + 3]));
            pw.z = pk2(__builtin_amdgcn_exp2f(lbv[8 * st + 4] + R2 + aft[8 * st + 4]), __builtin_amdgcn_exp2f(lbv[8 * st + 5] + R2 + aft[8 * st + 5]));
            pw.w = pk2(__builtin_amdgcn_exp2f(lbv[8 * st + 6] + R2 + aft[8 * st + 6]), __builtin_amdgcn_exp2f(lbv[8 * st + 7] + R2 + aft[8 * st + 7]));
            pf[st] = __builtin_bit_cast(bf16x8, pw);
        }
        {
            const int sv = lane >> 1, db = (lane & 1) * 32;
#pragma unroll
            for (int i = 0; i < 4; ++i)
#pragma unroll
                for (int wq = 0; wq < 4; ++wq) {
                    const unsigned x = vv[i][wq]; const int d = db + 8 * i + 2 * wq;
                    vT[d * 40 + sv] = (u16)(x & 0xffffu); vT[(d + 1) * 40 + sv] = (u16)(x >> 16);
                }
        }
        asm volatile("s_waitcnt lgkmcnt(0)" ::: "memory");
#pragma unroll
        for (int st = 0; st < 2; ++st) {
            const u32x2 a0 = *(const u32x2*)(vT + r * 40 + 16 * st + 4 * h), a1 = *(const u32x2*)(vT + r * 40 + 16 * st + 8 + 4 * h);
            const u32x2 b0 = *(const u32x2*)(vT + (32 + r) * 40 + 16 * st + 4 * h), b1 = *(const u32x2*)(vT + (32 + r) * 40 + 16 * st + 8 + 4 * h);
            u32x4 fa, fb; fa.x = a0.x; fa.y = a0.y; fa.z = a1.x; fa.w = a1.y; fb.x = b0.x; fb.y = b0.y; fb.z = b1.x; fb.w = b1.y;
            O0 = mfma32(__builtin_bit_cast(bf16x8, fa), pf[st], O0);
            O1 = mfma32(__builtin_bit_cast(bf16x8, fb), pf[st], O1);
        }
        asm volatile("s_waitcnt lgkmcnt(0)" ::: "memory");
        R2 += tot;
        if (!__any(R2 > -64.f)) break;
    }
#pragma unroll
    for (int dt = 0; dt < 2; ++dt)
#pragma unroll
        for (int q4 = 0; q4 < 4; ++q4) {
            const int d0 = 32 * dt + 8 * q4 + 4 * h;
            const u32x2 zz = zz8[4 * dt + q4];
            float o[4];
#pragma unroll
            for (int e = 0; e < 4; ++e) {
                const float ov = dt ? O1[4 * q4 + e] : O0[4 * q4 + e];
                const unsigned wv = (e < 2) ? zz.x : zz.y; const float z = (e & 1) ? bfhi(wv) : bflo(wv);
                o[e] = ov * (z * __builtin_amdgcn_rcpf(1.f + __expf(-z)));
            }
            u32x2 st; st.x = pk2(o[0], o[1]); st.y = pk2(o[2], o[3]);
            *(u32x2*)(Hm + tok * 1024 + 512 + hd * 64 + d0) = st;
        }
}

__device__ __forceinline__ void phase2a(const Params& p) {
    for (int u = blockIdx.x; u < 256; u += gridDim.x) { mlstm_pass1(p, u >> 2, u & 3); __syncthreads(); }
}
__device__ __forceinline__ void phase2b(const Params& p) {
    extern __shared__ __attribute__((aligned(16))) unsigned char lds[];
    for (int u = blockIdx.x; u < 256; u += gridDim.x) { mlstm_pass2(p, u >> 2, u & 3); __syncthreads(); }
    const int tid2 = opaque_tid(), lane = tid2 & 63, wave = tid2 >> 6;
    u16* vT = (u16*)(lds + wave * 5120);
    for (int u = blockIdx.x * 8 + wave; u < 16384; u += gridDim.x * 8) sb_unit(p, u, vT, lane);
}

__device__ __forceinline__ void phase4(const Params& p) {
    const int tid = opaque_tid(), lane = tid & 63, wave = tid >> 6;
    const float* modp = (const float*)(p.ws + WS_MOD);
    const u16* Y = (const u16*)(p.ws + WS_Y);
    for (int tb = blockIdx.x * 8 + wave; tb < 2048; tb += gridDim.x * 8) {
        const int tok0 = tb * 32, b = tok0 >> 12;
        f32x4 gg[4];
#pragma unroll
        for (int j = 0; j < 4; ++j) { const int k = lane * 4 + 256 * j; gg[j] = *(const f32x4*)(modp + b * 3072 + 2048 + k) * *(const f32x4*)(p.g_post + k); }
        u32x2 yn[4]; f32x4 xn[4];
#pragma unroll
        for (int j = 0; j < 4; ++j) { yn[j] = *(const u32x2*)(Y + (size_t)tok0 * 1024 + lane * 4 + 256 * j); xn[j] = __builtin_nontemporal_load((const f32x4*)(p.x + (size_t)tok0 * 1024 + lane * 4 + 256 * j)); }
        for (int t = 0; t < 32; ++t) {
            const size_t tok = (size_t)tok0 + t;
            f32x4 y[4], xv[4]; float ss = 0.f;
#pragma unroll
            for (int j = 0; j < 4; ++j) { const u32x2 w = yn[j]; xv[j] = xn[j];
                y[j] = (f32x4){bflo(w.x), bfhi(w.x), bflo(w.y), bfhi(w.y)}; ss += (y[j].x * y[j].x + y[j].y * y[j].y) + (y[j].z * y[j].z + y[j].w * y[j].w); }
            if (t + 1 < 32) {
#pragma unroll
                for (int j = 0; j < 4; ++j) { yn[j] = *(const u32x2*)(Y + (tok + 1) * 1024 + lane * 4 + 256 * j); xn[j] = __builtin_nontemporal_load((const f32x4*)(p.x + (tok + 1) * 1024 + lane * 4 + 256 * j)); }
            }
            ss = wave_sum(ss); const float r = rsqrtf(ss * (1.f / 1024.f) + 1e-6f);
#pragma unroll
            for (int j = 0; j < 4; ++j) __builtin_nontemporal_store(xv[j] + gg[j] * (y[j] * r), (f32x4*)(p.out + tok * 1024 + lane * 4 + 256 * j));
        }
    }
}

DEVI unsigned bar_ld(unsigned* q) { return __hip_atomic_load(q, __ATOMIC_RELAXED, __HIP_MEMORY_SCOPE_AGENT); }
DEVI unsigned bar_add(unsigned* q, unsigned v) { return __hip_atomic_fetch_add(q, v, __ATOMIC_RELAXED, __HIP_MEMORY_SCOPE_AGENT); }
DEVI unsigned xcc_id() { return (unsigned)__builtin_amdgcn_s_getreg((3 << 11) | 20) & 0xFu; }
DEVI void grid_sync0(const Params& p, cg::grid_group& g) {
    asm volatile("s_waitcnt vmcnt(0) lgkmcnt(0)" ::: "memory");
    g.sync();
    if (threadIdx.x == 0) { __builtin_amdgcn_fence(__ATOMIC_ACQUIRE, "agent"); asm volatile("s_waitcnt vmcnt(0)" ::: "memory"); }
    __syncthreads();
}
DEVI void grid_sync(const Params& p, const int idx, const unsigned xcc, const unsigned nloc, const unsigned nxcc) {
    asm volatile("s_waitcnt vmcnt(0) lgkmcnt(0)" ::: "memory");
    __syncthreads();
    if (threadIdx.x == 0) {
        unsigned* bar = (unsigned*)(p.ws + WS_BAR);
        unsigned* xsub = bar + 1024 + (16 * idx + xcc) * 64; unsigned* top = bar + 9216 + 64 * idx;
        const unsigned old = bar_add(xsub, 1u);
        if (old == nloc - 1u) {
            __builtin_amdgcn_fence(__ATOMIC_RELEASE, "agent");
            asm volatile("s_waitcnt vmcnt(0)" ::: "memory");
            bar_add(top, 1u);
        }
        while (bar_ld(top) < nxcc) __builtin_amdgcn_s_sleep(1);
        __builtin_amdgcn_fence(__ATOMIC_ACQUIRE, "agent");
        asm volatile("s_waitcnt vmcnt(0)" ::: "memory");
    }
    __syncthreads();
}
__global__ void __launch_bounds__(512) hymba_fwd(Params p) {
    cg::grid_group grid = cg::this_grid();
    const unsigned xcc = xcc_id();
    if (threadIdx.x == 0) bar_add((unsigned*)(p.ws + WS_BAR) + 64 * xcc, 1u);
    phase0(p);
    if (gridDim.x == 0x7fffffffu) grid_sync0(p, grid);
    if (threadIdx.x == 0) {
        unsigned* bar = (unsigned*)(p.ws + WS_BAR);
        for (;;) { unsigned tot = 0; for (int j = 0; j < 16; ++j) tot += bar_ld(bar + 64 * j); if (tot >= gridDim.x) break; __builtin_amdgcn_s_sleep(1); }
    }
    __syncthreads();
    unsigned nloc, nxcc = 0;
    { unsigned* bar = (unsigned*)(p.ws + WS_BAR); nloc = bar_ld(bar + 64 * xcc);
      for (int j = 0; j < 16; ++j) nxcc += (bar_ld(bar + 64 * j) != 0u) ? 1u : 0u; }
    grid_sync(p, 0, xcc, nloc, nxcc);
    phase1a(p);
    grid_sync(p, 1, xcc, nloc, nxcc);
    gemm_phase((const u16*)(p.ws + WS_H), (const u16*)(p.ws + WS_WTIN), (u16*)(p.ws + WS_P), 18, NP);
    grid_sync(p, 2, xcc, nloc, nxcc);
    phase2a(p);
    grid_sync(p, 5, xcc, nloc, nxcc);
    phase2b(p);
    grid_sync(p, 3, xcc, nloc, nxcc);
    gemm_phase((const u16*)(p.ws + WS_HMIX), (const u16*)(p.ws + WS_WTOUT), (u16*)(p.ws + WS_Y), 4, 1024);
    grid_sync(p, 4, xcc, nloc, nxcc);
    phase4(p);
}

extern "C" void kernel_launch(void* const* d_in, const int* in_sizes, int n_in, void* d_out, int out_size, void* d_ws, size_t ws_size, hipStream_t stream) {
    static int grid_blocks = 0;
    if (!grid_blocks) {
        if (n_in != 13 || out_size != NTOK * DM || ws_size < WS_END) { fprintf(stderr, "kernel_launch: unexpected shapes (n_in %d out %d ws %zu)\n", n_in, out_size, ws_size); grid_blocks = -1; return; }
        int dev = 0, cus = 0, per_cu = 0;
        hipGetDevice(&dev);
        hipDeviceGetAttribute(&cus, hipDeviceAttributeMultiprocessorCount, dev);
        if (hipFuncSetAttribute((const void*)hymba_fwd, hipFuncAttributeMaxDynamicSharedMemorySize, LDS_BYTES) != hipSuccess) fprintf(stderr, "kernel_launch: hipFuncSetAttribute failed\n");
        if (hipOccupancyMaxActiveBlocksPerMultiprocessor(&per_cu, (const void*)hymba_fwd, 512, LDS_BYTES) != hipSuccess || per_cu < 1) { fprintf(stderr, "kernel_launch: occupancy query says %d\n", per_cu); per_cu = 1; }
        (void)hipGetLastError();
        grid_blocks = cus * 1;
    }
    if (grid_blocks < 0) return;
    Params p{};
    p.x = (const float*)d_in[0]; p.c = (const float*)d_in[1]; p.w_ada = (const float*)d_in[2]; p.b_ada = (const float*)d_in[3]; p.g_pre = (const float*)d_in[4];
    p.w_in = (const float*)d_in[5]; p.b_ig = (const float*)d_in[6]; p.b_fg = (const float*)d_in[7]; p.conv_w = (const float*)d_in[8]; p.conv_b = (const float*)d_in[9];
    p.g_ml = (const float*)d_in[10]; p.w_out = (const float*)d_in[11]; p.g_post = (const float*)d_in[12];
    p.out = (float*)d_out; p.ws = (unsigned char*)d_ws;
    if (hipMemsetAsync((unsigned char*)d_ws + WS_BAR, 0, 40960, stream) != hipSuccess) fprintf(stderr, "kernel_launch: memset of the barrier words failed\n");
    void* args[] = {&p};
    hipError_t e = hipLaunchCooperativeKernel((const void*)hymba_fwd, dim3(grid_blocks), dim3(512), args, LDS_BYTES, stream);
    if (e != hipSuccess) fprintf(stderr, "cooperative launch failed: %s (grid %d)\n", hipGetErrorString(e), grid_blocks);
}
```

```cpp
#include <hip/hip_runtime.h>
#include <hip/hip_cooperative_groups.h>
#include <cstdio>
#include <cstdint>
namespace cg = cooperative_groups;

typedef unsigned short u16;
typedef short bf16x8 __attribute__((ext_vector_type(8)));
typedef float f32x4 __attribute__((ext_vector_type(4)));
typedef float f32x16 __attribute__((ext_vector_type(16)));
typedef unsigned u32x4 __attribute__((ext_vector_type(4)));
typedef unsigned u32x2 __attribute__((ext_vector_type(2)));
#define DEVI __device__ __forceinline__

constexpr int NTOK = 65536, DM = 1024, NP = 4608;
constexpr size_t WS_WTIN = 0;
constexpr size_t WS_WTOUT = 9437184;
constexpr size_t WS_WG = 11534336;
constexpr size_t WS_MOD = 11567104;
constexpr size_t WS_BAR = 13860864;
constexpr size_t WS_GATES = 11763712;
constexpr size_t WS_H = 16777216;
constexpr size_t WS_P = WS_H + 134217728;
constexpr size_t WS_HMIX = WS_P + 603979776;
constexpr size_t WS_Y = WS_HMIX + 134217728;
constexpr size_t WS_END = WS_Y + 134217728;
constexpr size_t WS_NDNUM = WS_H;
constexpr size_t WS_Q2 = WS_H + 67108864;
constexpr size_t WS_E = WS_Y;
constexpr size_t WS_AUX = WS_Y + 33554432;
constexpr size_t WS_DG = WS_Y + 41943040;
constexpr int LDS_BYTES = 131072;

struct Params {
    const float *x, *c, *w_ada, *b_ada, *g_pre, *w_in, *b_ig, *b_fg, *conv_w, *conv_b, *g_ml, *w_out, *g_post;
    float* out;
    unsigned char* ws;
};

DEVI int opaque_tid() { int t = threadIdx.x; asm volatile("" : "+v"(t)); return t; }
typedef __bf16 bf16x2_t __attribute__((ext_vector_type(2)));
typedef _Float16 f16x2_t __attribute__((ext_vector_type(2)));
typedef _Float16 f16x8 __attribute__((ext_vector_type(8)));
typedef float f32x2_t __attribute__((ext_vector_type(2)));
DEVI unsigned pk2(float lo, float hi) { const f32x2_t v = {lo, hi}; const bf16x2_t b = __builtin_convertvector(v, bf16x2_t); return __builtin_bit_cast(unsigned, b); }
DEVI unsigned pkh2(float lo, float hi) { const f32x2_t v = {lo, hi}; const f16x2_t b = __builtin_convertvector(v, f16x2_t); return __builtin_bit_cast(unsigned, b); }
DEVI float bflo(unsigned w) { return __uint_as_float(w << 16); }
DEVI float bfhi(unsigned w) { return __uint_as_float(w & 0xffff0000u); }
DEVI float wave_sum(float v) {
#pragma unroll
    for (int o = 1; o < 64; o <<= 1) v += __shfl_xor(v, o);
    return v;
}
DEVI float wave_max(float v) {
#pragma unroll
    for (int o = 1; o < 64; o <<= 1) v = fmaxf(v, __shfl_xor(v, o));
    return v;
}
DEVI int perm32(int rho) { const int n = rho >> 4, i = rho & 15; return 8 * (i >> 2) + 4 * n + (i & 3); }
DEVI f32x4 mfma16(bf16x8 a, bf16x8 b, f32x4 c) { return __builtin_amdgcn_mfma_f32_16x16x32_bf16(a, b, c, 0, 0, 0); }
DEVI f32x16 mfma32(bf16x8 a, bf16x8 b, f32x16 c) { return __builtin_amdgcn_mfma_f32_32x32x16_bf16(a, b, c, 0, 0, 0); }

DEVI void p0_transpose_item(const float* __restrict__ W, const int ldw, const int srccol0, u16* __restrict__ dst, const int n0, const int k0, float* scr, const int lane) {
#pragma unroll 8
    for (int i = 0; i < 32; ++i) { const int kk = 2 * i + (lane >> 5); scr[kk * 33 + (lane & 31)] = W[(size_t)(k0 + kk) * ldw + srccol0 + (lane & 31)]; }
    asm volatile("s_waitcnt lgkmcnt(0)" ::: "memory");
    const int c = lane & 7;
#pragma unroll
    for (int j = 0; j < 4; ++j) {
        const int slot = (lane >> 3) + 8 * j, cl = perm32(slot);
        const float* sp = scr + (8 * c) * 33 + cl;
        u32x4 o; o.x = pk2(sp[0], sp[33]); o.y = pk2(sp[2 * 33], sp[3 * 33]); o.z = pk2(sp[4 * 33], sp[5 * 33]); o.w = pk2(sp[6 * 33], sp[7 * 33]);
        *(u32x4*)(dst + (size_t)(n0 + slot) * 1024 + k0 + 8 * c) = o;
    }
    asm volatile("s_waitcnt lgkmcnt(0)" ::: "memory");
}
__device__ __forceinline__ void phase0(const Params& p) {
    extern __shared__ __attribute__((aligned(16))) unsigned char lds[];
    const int tid = opaque_tid(), lane = tid & 63, wave = tid >> 6;
    float* modp = (float*)(p.ws + WS_MOD);
    for (int job = blockIdx.x; job < 96; job += gridDim.x) {
        float* sc = (float*)lds; float* red = (float*)(lds + 65536);
        for (int i = tid; i < 16384; i += 512) { const float v = p.c[i]; sc[i] = v / (1.f + expf(-v)); }
        __syncthreads();
        const int jl = tid & 31, kq = tid >> 5, j0 = job * 32;
        float acc[16];
#pragma unroll
        for (int b = 0; b < 16; ++b) acc[b] = 0.f;
        for (int kk = 0; kk < 64; ++kk) {
            const int k = kq * 64 + kk; const float w = p.w_ada[(size_t)k * 3072 + j0 + jl];
#pragma unroll
            for (int b = 0; b < 16; ++b) acc[b] += sc[b * 1024 + k] * w;
        }
#pragma unroll
        for (int b = 0; b < 16; ++b) red[(kq * 16 + b) * 32 + jl] = acc[b];
        __syncthreads();
        { const int b = tid >> 5; float sacc = p.b_ada[j0 + jl];
          for (int q = 0; q < 16; ++q) sacc += red[(q * 16 + b) * 32 + jl];
          modp[b * 3072 + j0 + jl] = sacc; }
        __syncthreads();
    }
    if (blockIdx.x == (gridDim.x > 100 ? 100 : 0)) {
        float* Wg = (float*)(p.ws + WS_WG);
        for (int i = tid; i < 8192; i += 512) { const int g = i & 7, k = i >> 3; Wg[g * 1024 + k] = p.w_in[(size_t)k * 4616 + 2560 + g]; }
    }
    {
        float* scr = (float*)(lds + wave * 8448);
        const int NW = gridDim.x * 8, gw = NW - 1 - (blockIdx.x * 8 + wave);
        for (int it = gw; it < 2816; it += NW) {
            if (it < 2304) { const int nb = it >> 4, kb = it & 15, n0 = nb * 32;
                p0_transpose_item(p.w_in, 4616, n0 < 2560 ? n0 : n0 + 8, (u16*)(p.ws + WS_WTIN), n0, kb * 64, scr, lane); }
            else { const int r2 = it - 2304, nb = r2 >> 4, kb = r2 & 15, n0 = nb * 32;
                p0_transpose_item(p.w_out, 1024, n0, (u16*)(p.ws + WS_WTOUT), n0, kb * 64, scr, lane); }
        }
    }
}

__device__ __forceinline__ void phase1a(const Params& p) {
    extern __shared__ __attribute__((aligned(16))) unsigned char lds[];
    const int tid = opaque_tid(), lane = tid & 63, wave = tid >> 6;
    float* wg_s = (float*)lds;
    { const float* Wg = (const float*)(p.ws + WS_WG); for (int i = tid; i < 8192; i += 512) wg_s[i] = Wg[i]; }
    __syncthreads();
    const float* modp = (const float*)(p.ws + WS_MOD);
    u16* H = (u16*)(p.ws + WS_H); float* gates = (float*)(p.ws + WS_GATES);
    for (int tb = blockIdx.x * 8 + wave; tb < 2048; tb += gridDim.x * 8) {
        const int tok0 = tb * 32, b = tok0 >> 12;
        f32x4 gs[4], sh[4];
#pragma unroll
        for (int j = 0; j < 4; ++j) { const int k = lane * 4 + 256 * j; const f32x4 g = *(const f32x4*)(p.g_pre + k); const f32x4 s = *(const f32x4*)(modp + b * 3072 + 1024 + k);
            sh[j] = *(const f32x4*)(modp + b * 3072 + k); gs[j] = g * (1.f + s); }
        float bias = 0.f; if (lane < 4) bias = p.b_ig[lane]; else if (lane < 8) bias = p.b_fg[lane - 4];
        f32x4 vn[4];
#pragma unroll
        for (int j = 0; j < 4; ++j) vn[j] = __builtin_nontemporal_load((const f32x4*)(p.x + (size_t)tok0 * 1024 + lane * 4 + 256 * j));
        for (int t = 0; t < 32; ++t) {
            const size_t tok = (size_t)tok0 + t;
            f32x4 v[4]; float ss = 0.f;
#pragma unroll
            for (int j = 0; j < 4; ++j) { v[j] = vn[j]; ss += (v[j].x * v[j].x + v[j].y * v[j].y) + (v[j].z * v[j].z + v[j].w * v[j].w); }
            if (t + 1 < 32) {
#pragma unroll
                for (int j = 0; j < 4; ++j) vn[j] = __builtin_nontemporal_load((const f32x4*)(p.x + (tok + 1) * 1024 + lane * 4 + 256 * j));
            }
            ss = wave_sum(ss); const float r = rsqrtf(ss * (1.f / 1024.f) + 1e-6f);
            float part[8];
#pragma unroll
            for (int g = 0; g < 8; ++g) part[g] = 0.f;
#pragma unroll
            for (int j = 0; j < 4; ++j) {
                const f32x4 hv = v[j] * r * gs[j] + sh[j];
                u32x2 o; o.x = pk2(hv.x, hv.y); o.y = pk2(hv.z, hv.w);
                *(u32x2*)(H + tok * 1024 + lane * 4 + 256 * j) = o;
#pragma unroll
                for (int g = 0; g < 8; ++g) { const f32x4 w = *(const f32x4*)(wg_s + g * 1024 + lane * 4 + 256 * j); part[g] += (hv.x * w.x + hv.y * w.y) + (hv.z * w.z + hv.w * w.w); }
            }
#pragma unroll
            for (int g = 0; g < 8; ++g) part[g] = wave_sum(part[g]);
            float ov = part[0];
#pragma unroll
            for (int g = 1; g < 8; ++g) if (lane == g) ov = part[g];
            if (lane < 8) gates[tok * 8 + lane] = ov + bias;
        }
    }
}

constexpr int BM = 256, BK = 64, HALF = 128, HT = HALF * BK;
DEVI int lds_byte(int r, int c) { const int st = (r >> 4) * 2 + (c >> 5), rr = r & 15, cc = c & 31, ob = rr * 64 + cc * 2; return st * 1024 + (ob ^ (((ob >> 9) & 1) << 5)); }
DEVI void stage_rc(int b, int& R, int& C) { const int st = b / 1024, sb = b % 1024, swz = sb ^ (((sb >> 9) & 1) << 5); R = (st >> 1) * 16 + swz / 64; C = (st & 1) * 32 + (swz % 64) / 2; }

DEVI void gemm_unit(const int L, const int nM, const int nN, const int nwg, int& pm, int& pn) {
    int wgid = L;
    { const int q = nwg / 8, r = nwg % 8, xcd = wgid % 8, off = wgid / 8; wgid = (xcd < r ? xcd * (q + 1) : r * (q + 1) + (xcd - r) * q) + off; }
    const int nig = 8 * nN, gid = wgid / nig, fm = gid * 8, gsz = min(nM - fm, 8);
    pm = fm + ((wgid % nig) % gsz); pn = (wgid % nig) / gsz;
}
__device__ __forceinline__ void gemm_phase(const u16* __restrict__ A, const u16* __restrict__ Bt, u16* __restrict__ Out, const int nN, const int ldo) {
    extern __shared__ __attribute__((aligned(16))) unsigned char lds[];
    constexpr int K = 1024;
    const int tid = opaque_tid();
    u16* shm = (u16*)lds;
#define SA(b, h) (shm + ((b) * 2 + (h)) * HT)
#define SB(b, h) (shm + (4 + (b) * 2 + (h)) * HT)
#define STAGE(Pp, BASE, br, kt) do { const u16* _gb = (BASE) + ((size_t)(br) * K + (size_t)(kt) * BK); \
      __builtin_amdgcn_global_load_lds((const unsigned*)(_gb + so0), (unsigned*)((char*)(Pp) + tid * 16), 16, 0, 0); \
      __builtin_amdgcn_global_load_lds((const unsigned*)(_gb + 64 * K + so0), (unsigned*)((char*)(Pp) + tid * 16 + 8192), 16, 0, 0); } while (0)
#define LDA(dst, b, h) for (int m = 0; m < 4; ++m) for (int k = 0; k < 2; ++k) \
    dst[m][k] = *reinterpret_cast<const bf16x8*>((char*)SA(b, h) + lds_byte(wr * 64 + m * 16 + fr, k * 32 + fq * 8))
#define LDB(dst, b, h) for (int n = 0; n < 2; ++n) for (int k = 0; k < 2; ++k) \
    dst[n][k] = *reinterpret_cast<const bf16x8*>((char*)SB(b, h) + lds_byte(wc * 32 + n * 16 + fr, k * 32 + fq * 8))
#define MMA(ai, bj, At_, Bt_) do { __builtin_amdgcn_s_setprio(1); \
    for (int m = 0; m < 4; ++m) for (int n = 0; n < 2; ++n) for (int k = 0; k < 2; ++k) \
      acc[ai][bj][m][n] = __builtin_amdgcn_mfma_f32_16x16x32_bf16(Bt_[n][k], At_[m][k], acc[ai][bj][m][n], 0, 0, 0); \
    __builtin_amdgcn_s_setprio(0); } while (0)
#define WAIT_V(n) asm volatile("s_waitcnt vmcnt(" #n ")" ::: "memory")
#define WAIT_L(n) asm volatile("s_waitcnt lgkmcnt(" #n ")" ::: "memory")
#define BAR __builtin_amdgcn_s_barrier()
#define SCHED __builtin_amdgcn_sched_barrier(0)
#define EPILOGUE(ROW, COL) do { \
    _Pragma("unroll") for (int ai = 0; ai < 2; ++ai) \
    _Pragma("unroll") for (int m = 0; m < 4; ++m) { \
        u16* rowp = Out + (size_t)((ROW) + ai * HALF + wr * 64 + m * 16 + fr) * ldo + (COL) + wc * 32 + 8 * fq; \
        _Pragma("unroll") for (int bj = 0; bj < 2; ++bj) { \
            const f32x4 v0 = acc[ai][bj][m][0], v1 = acc[ai][bj][m][1]; \
            u32x4 w; w.x = pk2(v0[0], v0[1]); w.y = pk2(v0[2], v0[3]); w.z = pk2(v1[0], v1[1]); w.w = pk2(v1[2], v1[3]); \
            *(u32x4*)(rowp + bj * HALF) = w; \
        } } } while (0)
    const int wid = tid >> 6, lane = tid & 63, wr = wid >> 2, wc = wid & 3, fr = lane & 15, fq = lane >> 4;
    unsigned so0;
    { int r_, c_; stage_rc(tid * 16, r_, c_); so0 = (unsigned)(r_ * K + c_); }
    constexpr int nt = K / BK;
    const int nM = NTOK / BM, nwg = nM * nN, G = gridDim.x;
    int L = blockIdx.x;
    if (L < nwg) {
        int brow, bcol;
        { int pm, pn; gemm_unit(L, nM, nN, nwg, pm, pn); brow = pm * BM; bcol = pn * BM; }
        f32x4 acc[2][2][4][2] = {};
        bf16x8 At[4][2], B0[2][2], B1[2][2];
        STAGE(SB(0, 0), Bt, bcol, 0); STAGE(SA(0, 0), A, brow, 0);
        STAGE(SB(0, 1), Bt, bcol + HALF, 0); STAGE(SA(0, 1), A, brow + HALF, 0);
        if (wr == 1) BAR;
        WAIT_V(4); BAR;
        STAGE(SB(1, 0), Bt, bcol, 1); STAGE(SA(1, 0), A, brow, 1); STAGE(SB(1, 1), Bt, bcol + HALF, 1);
        WAIT_V(6); BAR;
        for (;;) {
            const bool last = (L + G >= nwg);
            int nbrow = brow, nbcol = bcol;
            if (!last) { int qm, qn; gemm_unit(L + G, nM, nN, nwg, qm, qn); nbrow = qm * BM; nbcol = qn * BM; }
            const int tend = last ? nt - 2 : nt;
            for (int t = 0; t < tend; t += 2) {
                const bool bnd = (t == nt - 2);
                const int r2 = bnd ? nbrow : brow, c2 = bnd ? nbcol : bcol, k2 = bnd ? 0 : t + 2, k3 = bnd ? 1 : t + 3;
                LDB(B0, 0, 0); SCHED; LDA(At, 0, 0); STAGE(SA(1, 1), A, brow + HALF, t + 1);
                WAIT_L(8); BAR; WAIT_L(0); MMA(0, 0, At, B0); BAR; SCHED;
                LDB(B1, 0, 1); STAGE(SB(0, 0), Bt, c2, k2);
                BAR; WAIT_L(0); MMA(0, 1, At, B1); BAR;
                LDA(At, 0, 1); STAGE(SA(0, 0), A, r2, k2);
                BAR; WAIT_L(0); MMA(1, 0, At, B0); BAR; SCHED;
                STAGE(SB(0, 1), Bt, c2 + HALF, k2);
                WAIT_V(6); BAR; MMA(1, 1, At, B1); BAR;
                LDB(B0, 1, 0); SCHED; LDA(At, 1, 0); STAGE(SA(0, 1), A, r2 + HALF, k2);
                WAIT_L(8); BAR; WAIT_L(0); MMA(0, 0, At, B0); BAR; SCHED;
                LDB(B1, 1, 1); STAGE(SB(1, 0), Bt, c2, k3);
                BAR; WAIT_L(0); MMA(0, 1, At, B1); BAR;
                LDA(At, 1, 1); STAGE(SA(1, 0), A, r2, k3);
                BAR; WAIT_L(0); MMA(1, 0, At, B0); BAR; SCHED;
                STAGE(SB(1, 1), Bt, c2 + HALF, k3);
                WAIT_V(6); BAR; MMA(1, 1, At, B1); BAR;
            }
            if (last) break;
            EPILOGUE(brow, bcol);
#pragma unroll
            for (int ai = 0; ai < 2; ++ai)
#pragma unroll
                for (int bj = 0; bj < 2; ++bj)
#pragma unroll
                    for (int m = 0; m < 4; ++m)
#pragma unroll
                        for (int n = 0; n < 2; ++n) acc[ai][bj][m][n] = (f32x4){0.f, 0.f, 0.f, 0.f};
            brow = nbrow; bcol = nbcol; L += G;
        }
        { LDB(B0, 0, 0); LDA(At, 0, 0); STAGE(SA(1, 1), A, brow + HALF, nt - 1);
          BAR; WAIT_L(0); MMA(0, 0, At, B0); BAR;
          LDB(B1, 0, 1); BAR; WAIT_L(0); MMA(0, 1, At, B1); BAR;
          LDA(At, 0, 1); WAIT_V(4); BAR; WAIT_L(0); MMA(1, 0, At, B0); MMA(1, 1, At, B1); BAR; }
        { LDB(B0, 1, 0); LDA(At, 1, 0); WAIT_V(2); BAR; WAIT_L(0); MMA(0, 0, At, B0); BAR;
          LDB(B1, 1, 1); WAIT_V(0); BAR; WAIT_L(0); MMA(0, 1, At, B1); BAR;
          LDA(At, 1, 1); BAR; WAIT_L(0); MMA(1, 0, At, B0); MMA(1, 1, At, B1); BAR; }
        if (wr == 0) BAR;
        EPILOGUE(brow, bcol);
    }
    __syncthreads();
#undef SA
#undef SB
#undef STAGE
#undef LDA
#undef LDB
#undef MMA
#undef EPILOGUE
}

__device__ __forceinline__ void mlstm_pass1(const Params& p, const int item, const int grp) {
    extern __shared__ __attribute__((aligned(16))) unsigned char lds[];
    const int tid = opaque_tid(), lane = tid & 63, w = tid >> 6, i16 = lane & 15, g4 = lane >> 4;
    const int b = item >> 2, hh = item & 3;
    u16* q_s = (u16*)(lds + 0); u16* k_s = (u16*)(lds + 17408); float* out_s = (float*)lds;
    u16* wkT_s = (u16*)(lds + 34816); u16* vT_s = (u16*)(lds + 53248); u16* S_s = (u16*)(lds + 73984);
    u16* CT_s = (u16*)(lds + 83200); float* den_s = (float*)(lds + 122368); float* a_s = (float*)(lds + 122368 + 256); float* ml_s = a_s + 64;
    const u16* P = (const u16*)(p.ws + WS_P); const float* gates = (const float*)(p.ws + WS_GATES);
    u16* NDn = (u16*)(p.ws + WS_NDNUM); u16* Q2 = (u16*)(p.ws + WS_Q2); float* AUX = (float*)(p.ws + WS_AUX);
    const int c0 = grp * 16;
    const size_t tokb = (size_t)b * 4096;
    for (int i = tid; i < 144 * 136 / 2; i += 512) ((unsigned*)CT_s)[i] = 0u;
    for (int i = tid; i < 16 * 72; i += 512) vT_s[128 * 72 + i] = (i < 72) ? (u16)0x3F80 : (u16)0;
    const int cp = tid & 63, t0 = 8 * w, ch = 2 * cp;
    float cwq[4][2], cwk[4][2], cbq[2], cbk[2];
#pragma unroll
    for (int j = 0; j < 4; ++j)
#pragma unroll
        for (int e = 0; e < 2; ++e) { cwq[j][e] = p.conv_w[j * 1024 + hh * 128 + ch + e]; cwk[j][e] = p.conv_w[j * 1024 + 512 + hh * 128 + ch + e]; }
#pragma unroll
    for (int e = 0; e < 2; ++e) { cbq[e] = p.conv_b[hh * 128 + ch + e]; cbk[e] = p.conv_b[512 + hh * 128 + ch + e]; }
    f32x4 Cacc[8], Cacc8 = {0.f, 0.f, 0.f, 0.f};
#pragma unroll
    for (int i = 0; i < 8; ++i) Cacc[i] = (f32x4){0.f, 0.f, 0.f, 0.f};
    for (int cc = w; cc < c0; cc += 8) {
        const size_t tk = tokb + (size_t)cc * 64 + lane;
        const float gi = gates[tk * 8 + hh], gf = gates[tk * 8 + 4 + hh];
        const float logf = fminf(gf, 0.f) - log1pf(expf(-fabsf(gf)));
        float bcs = logf;
#pragma unroll
        for (int o = 1; o < 64; o <<= 1) { const float u = __shfl_up(bcs, o); if (lane >= o) bcs += u; }
        const float a_tot = __shfl(bcs, 63);
        const float igb = gi - bcs;
        const float gg = a_tot + igb;
        const float m_loc = wave_max(gg);
        if (lane == 0) { a_s[cc] = a_tot; ml_s[cc] = m_loc; }
    }
    __syncthreads();
    float m_prev = 0.f;
    for (int cc = 0; cc < c0; ++cc) m_prev = fmaxf(a_s[cc] + m_prev, ml_s[cc]);
    float Pc = 1.f;
    const int et = tid >> 3, ec = (tid & 7) * 16;
    unsigned rq[11], rk[11], rv[8]; float gi_n, gf_n;
    {
        const size_t tokc = tokb + (size_t)c0 * 64;
#pragma unroll
        for (int i = 0; i < 11; ++i) { const int row = t0 - 3 + i; const bool ok = (c0 > 0) || (row >= 0); const size_t o = (size_t)((long)tokc + (ok ? row : 0)) * NP + hh * 128 + ch;
            rq[i] = ok ? *(const unsigned*)(P + o) : 0u; rk[i] = ok ? *(const unsigned*)(P + o + 512) : 0u; }
#pragma unroll
        for (int i = 0; i < 8; ++i) rv[i] = *(const unsigned*)(P + (tokc + t0 + i) * NP + 1024 + hh * 128 + ch);
        gi_n = gates[(tokc + lane) * 8 + hh]; gf_n = gates[(tokc + lane) * 8 + 4 + hh];
    }
    for (int c = c0; c < c0 + 16; ++c) {
        const size_t tokc = tokb + (size_t)c * 64;
        const size_t tq = (size_t)item * 4096 + (size_t)c * 64;
        const float gi = gi_n, gf = gf_n;
        const float logf = fminf(gf, 0.f) - log1pf(expf(-fabsf(gf)));
        float bcs = logf;
#pragma unroll
        for (int o = 1; o < 64; o <<= 1) { const float u = __shfl_up(bcs, o); if (lane >= o) bcs += u; }
        const float a_tot = __shfl(bcs, 63);
        const float igb = gi - bcs;
        const float gg = a_tot + igb;
        const float m_loc = wave_max(gg);
        const float m_new = fmaxf(a_tot + m_prev, m_loc);
        const float s_old = expf(a_tot + m_prev - m_new);
        const float wp = expf(gg - m_new);
        float mx = igb;
#pragma unroll
        for (int o = 1; o < 64; o <<= 1) { const float u = __shfl_up(mx, o); if (lane >= o) mx = fmaxf(mx, u); }
        const float m_t = bcs + fmaxf(m_prev, mx);
        const float iw = expf(bcs + m_prev - m_t);
        const float bm = bcs - m_t;
        {
            float kv0[8], kv1[8];
#pragma unroll
            for (int i = 0; i < 8; ++i) {
                float aq0 = cbq[0], aq1 = cbq[1], ak0 = cbk[0], ak1 = cbk[1];
#pragma unroll
                for (int j = 0; j < 4; ++j) { aq0 += cwq[j][0] * bflo(rq[i + j]); aq1 += cwq[j][1] * bfhi(rq[i + j]); ak0 += cwk[j][0] * bflo(rk[i + j]); ak1 += cwk[j][1] * bfhi(rk[i + j]); }
                const float q0 = aq0 * __builtin_amdgcn_rcpf(1.f + __expf(-aq0)), q1 = aq1 * __builtin_amdgcn_rcpf(1.f + __expf(-aq1));
                const float k0 = ak0 * __builtin_amdgcn_rcpf(1.f + __expf(-ak0)) * 0.08838834764831845f, k1 = ak1 * __builtin_amdgcn_rcpf(1.f + __expf(-ak1)) * 0.08838834764831845f;
                *(unsigned*)(q_s + (t0 + i) * 136 + ch) = pk2(q0, q1);
                *(unsigned*)(k_s + (t0 + i) * 136 + ch) = pk2(k0, k1);
                const float wpi = __shfl(wp, t0 + i);
                kv0[i] = k0 * wpi; kv1[i] = k1 * wpi;
            }
            u32x4 o0, o1;
            o0.x = pk2(kv0[0], kv0[1]); o0.y = pk2(kv0[2], kv0[3]); o0.z = pk2(kv0[4], kv0[5]); o0.w = pk2(kv0[6], kv0[7]);
            o1.x = pk2(kv1[0], kv1[1]); o1.y = pk2(kv1[2], kv1[3]); o1.z = pk2(kv1[4], kv1[5]); o1.w = pk2(kv1[6], kv1[7]);
            *(u32x4*)(wkT_s + ch * 72 + t0) = o0; *(u32x4*)(wkT_s + (ch + 1) * 72 + t0) = o1;
            u32x4 v0, v1;
            v0.x = (rv[0] & 0xffffu) | (rv[1] << 16); v0.y = (rv[2] & 0xffffu) | (rv[3] << 16); v0.z = (rv[4] & 0xffffu) | (rv[5] << 16); v0.w = (rv[6] & 0xffffu) | (rv[7] << 16);
            v1.x = (rv[0] >> 16) | (rv[1] & 0xffff0000u); v1.y = (rv[2] >> 16) | (rv[3] & 0xffff0000u); v1.z = (rv[4] >> 16) | (rv[5] & 0xffff0000u); v1.w = (rv[6] >> 16) | (rv[7] & 0xffff0000u);
            *(u32x4*)(vT_s + ch * 72 + t0) = v0; *(u32x4*)(vT_s + (ch + 1) * 72 + t0) = v1;
        }
        if (c + 1 < c0 + 16) {
            const size_t tn = tokc + 64;
#pragma unroll
            for (int i = 0; i < 11; ++i) { const size_t o = (tn + t0 - 3 + i) * NP + hh * 128 + ch; rq[i] = *(const unsigned*)(P + o); rk[i] = *(const unsigned*)(P + o + 512); }
#pragma unroll
            for (int i = 0; i < 8; ++i) rv[i] = *(const unsigned*)(P + (tn + t0 + i) * NP + 1024 + hh * 128 + ch);
            gi_n = gates[(tn + lane) * 8 + hh]; gf_n = gates[(tn + lane) * 8 + 4 + hh];
        }
        __syncthreads();
        {
            const u32x4 qa = *(const u32x4*)(q_s + et * 136 + ec), qb = *(const u32x4*)(q_s + et * 136 + ec + 8);
            u16* qd = Q2 + (tq + et) * 128 + ec; *(u32x4*)qd = qa; *(u32x4*)(qd + 8) = qb;
            if (w == 0) { AUX[(tq + lane) * 4 + 0] = iw * Pc; AUX[(tq + lane) * 4 + 1] = expf(-m_t); }
        }
        {
            const int ti = w >> 1;
#pragma unroll
            for (int sj = 0; sj < 2; ++sj) {
                const int si = 2 * (w & 1) + sj;
                f32x4 acc = {0.f, 0.f, 0.f, 0.f};
                if (si <= ti) {
#pragma unroll
                    for (int ks = 0; ks < 4; ++ks) {
                        const bf16x8 a = *(const bf16x8*)(q_s + (16 * ti + i16) * 136 + 32 * ks + 8 * g4);
                        const bf16x8 bb = *(const bf16x8*)(k_s + (16 * si + i16) * 136 + 32 * ks + 8 * g4);
                        acc = mfma16(a, bb, acc);
                    }
                }
                const int s = 16 * si + i16; const float igb_s = __shfl(igb, s);
#pragma unroll
                for (int r = 0; r < 4; ++r) {
                    const int t = 16 * ti + 4 * g4 + r; const float bm_t = __shfl(bm, t);
                    const float val = (s <= t) ? acc[r] * __expf(bm_t + igb_s) : 0.f;
                    S_s[t * 72 + s] = (u16)(pk2(val, 0.f) & 0xffffu);
                }
            }
        }
        f32x4 accO[4], accO8 = {0.f, 0.f, 0.f, 0.f};
#pragma unroll
        for (int ti = 0; ti < 4; ++ti) {
            f32x4 acc = {0.f, 0.f, 0.f, 0.f};
#pragma unroll
            for (int ks = 0; ks < 4; ++ks) {
                const bf16x8 a = *(const bf16x8*)(q_s + (16 * ti + i16) * 136 + 32 * ks + 8 * g4);
                const bf16x8 bb = *(const bf16x8*)(CT_s + (16 * w + i16) * 136 + 32 * ks + 8 * g4);
                acc = mfma16(a, bb, acc);
            }
#pragma unroll
            for (int r = 0; r < 4; ++r) acc[r] *= __shfl(iw, 16 * ti + 4 * g4 + r);
            accO[ti] = acc;
        }
        if (w < 4) {
            f32x4 acc = {0.f, 0.f, 0.f, 0.f};
#pragma unroll
            for (int ks = 0; ks < 4; ++ks) {
                const bf16x8 a = *(const bf16x8*)(q_s + (16 * w + i16) * 136 + 32 * ks + 8 * g4);
                const bf16x8 bb = *(const bf16x8*)(CT_s + (128 + i16) * 136 + 32 * ks + 8 * g4);
                acc = mfma16(a, bb, acc);
            }
#pragma unroll
            for (int r = 0; r < 4; ++r) acc[r] *= __shfl(iw, 16 * w + 4 * g4 + r);
            accO8 = acc;
        }
        __syncthreads();
#pragma unroll
        for (int ti = 0; ti < 4; ++ti)
#pragma unroll
            for (int ks = 0; ks < 2; ++ks) {
                const bf16x8 a = *(const bf16x8*)(S_s + (16 * ti + i16) * 72 + 32 * ks + 8 * g4);
                const bf16x8 bb = *(const bf16x8*)(vT_s + (16 * w + i16) * 72 + 32 * ks + 8 * g4);
                accO[ti] = mfma16(a, bb, accO[ti]);
            }
        if (w < 4) {
#pragma unroll
            for (int ks = 0; ks < 2; ++ks) {
                const bf16x8 a = *(const bf16x8*)(S_s + (16 * w + i16) * 72 + 32 * ks + 8 * g4);
                const bf16x8 bb = *(const bf16x8*)(vT_s + (128 + i16) * 72 + 32 * ks + 8 * g4);
                accO8 = mfma16(a, bb, accO8);
            }
        }
#pragma unroll
        for (int ti = 0; ti < 4; ++ti)
#pragma unroll
            for (int r = 0; r < 4; ++r) out_s[(16 * ti + 4 * g4 + r) * 132 + 16 * w + i16] = accO[ti][r];
        if (w < 4 && i16 == 0) {
#pragma unroll
            for (int r = 0; r < 4; ++r) den_s[16 * w + 4 * g4 + r] = accO8[r];
        }
        __syncthreads();
        {
            float nv[16];
#pragma unroll
            for (int j = 0; j < 16; ++j) nv[j] = out_s[et * 132 + ec + j];
            u32x4 s0, s1;
            s0.x = pk2(nv[0], nv[1]); s0.y = pk2(nv[2], nv[3]); s0.z = pk2(nv[4], nv[5]); s0.w = pk2(nv[6], nv[7]);
            s1.x = pk2(nv[8], nv[9]); s1.y = pk2(nv[10], nv[11]); s1.z = pk2(nv[12], nv[13]); s1.w = pk2(nv[14], nv[15]);
            u16* dst = NDn + (tq + et) * 128 + ec;
            *(u32x4*)dst = s0; *(u32x4*)(dst + 8) = s1;
            if ((tid & 7) == 0) AUX[(tq + et) * 4 + 2] = den_s[et];
        }
#pragma unroll
        for (int ki = 0; ki < 8; ++ki) {
            f32x4 acc = Cacc[ki] * s_old;
#pragma unroll
            for (int ks = 0; ks < 2; ++ks) {
                const bf16x8 a = *(const bf16x8*)(wkT_s + (16 * ki + i16) * 72 + 32 * ks + 8 * g4);
                const bf16x8 bb = *(const bf16x8*)(vT_s + (16 * w + i16) * 72 + 32 * ks + 8 * g4);
                acc = mfma16(a, bb, acc);
            }
            Cacc[ki] = acc;
            u32x2 pkd; pkd.x = pk2(acc[0], acc[1]); pkd.y = pk2(acc[2], acc[3]);
            *(u32x2*)(CT_s + (16 * w + i16) * 136 + 16 * ki + 4 * g4) = pkd;
        }
        {
            f32x4 acc = Cacc8 * s_old;
#pragma unroll
            for (int ks = 0; ks < 2; ++ks) {
                const bf16x8 a = *(const bf16x8*)(wkT_s + (16 * w + i16) * 72 + 32 * ks + 8 * g4);
                const bf16x8 bb = *(const bf16x8*)(vT_s + (128 + i16) * 72 + 32 * ks + 8 * g4);
                acc = mfma16(a, bb, acc);
            }
            Cacc8 = acc;
            u32x2 pkd; pkd.x = pk2(acc[0], acc[1]); pkd.y = pk2(acc[2], acc[3]);
            *(u32x2*)(CT_s + (128 + i16) * 136 + 16 * w + 4 * g4) = pkd;
        }
        m_prev = m_new; Pc *= s_old;
        __syncthreads();
    }
    {
        float* E = (float*)(p.ws + WS_E) + (size_t)(item * 4 + grp) * 144 * 128;
#pragma unroll
        for (int ki = 0; ki < 8; ++ki) *(f32x4*)(E + (16 * w + i16) * 128 + 16 * ki + 4 * g4) = Cacc[ki];
        *(f32x4*)(E + (128 + i16) * 128 + 16 * w + 4 * g4) = Cacc8;
        if (tid == 0) ((float*)(p.ws + WS_DG))[item * 4 + grp] = Pc;
    }
}

__device__ __forceinline__ void mlstm_pass2(const Params& p, const int item, const int grp) {
    extern __shared__ __attribute__((aligned(16))) unsigned char lds[];
    const int tid = opaque_tid(), lane = tid & 63, w = tid >> 6, i16 = lane & 15, g4 = lane >> 4;
    const int b = item >> 2, hh = item & 3;
    u16* q_s = (u16*)(lds + 0); float* o2_s = (float*)(lds + 17408); float* den2_s = (float*)(lds + 51200); u16* CT_s = (u16*)(lds + 83200);
    const u16* P = (const u16*)(p.ws + WS_P); u16* Hm = (u16*)(p.ws + WS_HMIX);
    const u16* NDn = (const u16*)(p.ws + WS_NDNUM); const u16* Q2 = (const u16*)(p.ws + WS_Q2); const float* AUX = (const float*)(p.ws + WS_AUX);
    const size_t tokb = (size_t)b * 4096;
    const int et = tid >> 3, ec = (tid & 7) * 16;
    if (grp > 0) {
        float cf[3] = {0.f, 0.f, 0.f}; float run = 1.f;
#pragma unroll
        for (int gp = 2; gp >= 0; --gp) if (gp < grp) { cf[gp] = run; run *= __hip_atomic_load((float*)(p.ws + WS_DG) + item * 4 + gp, __ATOMIC_RELAXED, __HIP_MEMORY_SCOPE_AGENT); }
        const float* E = (const float*)(p.ws + WS_E) + (size_t)(item * 4) * 144 * 128;
        for (int i = tid; i < 144 * 128; i += 512) {
            float sacc = 0.f;
#pragma unroll
            for (int gp = 0; gp < 3; ++gp) if (gp < grp) sacc += cf[gp] * E[(size_t)gp * 144 * 128 + i];
            CT_s[(i >> 7) * 136 + (i & 127)] = (u16)(pk2(sacc, 0.f) & 0xffffu);
        }
    }
    __syncthreads();
    float gml[16];
#pragma unroll
    for (int j = 0; j < 16; ++j) gml[j] = p.g_ml[hh * 128 + ec + j];
    u32x4 qa_n, qb_n, nd_n[2], ov_n[2], zv_n[2]; f32x4 ax_n;
    {
        const int c = grp * 16;
        const size_t tokc = tokb + (size_t)c * 64, tq = (size_t)item * 4096 + (size_t)c * 64;
        const u16* qsrc = Q2 + (tq + et) * 128 + ec; qa_n = *(const u32x4*)qsrc; qb_n = *(const u32x4*)(qsrc + 8);
        ax_n = *(const f32x4*)(AUX + (tq + lane) * 4);
        const u16* ns = NDn + (tq + et) * 128 + ec; nd_n[0] = *(const u32x4*)ns; nd_n[1] = *(const u32x4*)(ns + 8);
        const u16* po = P + (tokc + et) * NP + 1536 + hh * 128 + ec; ov_n[0] = *(const u32x4*)po; ov_n[1] = *(const u32x4*)(po + 8);
        zv_n[0] = *(const u32x4*)(po + 512); zv_n[1] = *(const u32x4*)(po + 520);
    }
    for (int cl = 0; cl < 16; ++cl) {
        const int c = grp * 16 + cl;
        const size_t tokc = tokb + (size_t)c * 64;
        *(u32x4*)(q_s + et * 136 + ec) = qa_n; *(u32x4*)(q_s + et * 136 + ec + 8) = qb_n;
        const f32x4 ax = ax_n;
        u32x4 nd[2], ov[2], zv[2];
        nd[0] = nd_n[0]; nd[1] = nd_n[1]; ov[0] = ov_n[0]; ov[1] = ov_n[1]; zv[0] = zv_n[0]; zv[1] = zv_n[1];
        __syncthreads();
        if (cl + 1 < 16) {
            const size_t tokn = tokc + 64, tqn = (size_t)item * 4096 + (size_t)(c + 1) * 64;
            const u16* qsrc = Q2 + (tqn + et) * 128 + ec; qa_n = *(const u32x4*)qsrc; qb_n = *(const u32x4*)(qsrc + 8);
            ax_n = *(const f32x4*)(AUX + (tqn + lane) * 4);
            const u16* ns = NDn + (tqn + et) * 128 + ec; nd_n[0] = *(const u32x4*)ns; nd_n[1] = *(const u32x4*)(ns + 8);
            const u16* po = P + (tokn + et) * NP + 1536 + hh * 128 + ec; ov_n[0] = *(const u32x4*)po; ov_n[1] = *(const u32x4*)(po + 8);
            zv_n[0] = *(const u32x4*)(po + 512); zv_n[1] = *(const u32x4*)(po + 520);
        }
        asm volatile("" ::: "memory");
        if (grp > 0) {
#pragma unroll
            for (int ti = 0; ti < 4; ++ti) {
                f32x4 acc = {0.f, 0.f, 0.f, 0.f};
#pragma unroll
                for (int ks = 0; ks < 4; ++ks) {
                    const bf16x8 a = *(const bf16x8*)(q_s + (16 * ti + i16) * 136 + 32 * ks + 8 * g4);
                    const bf16x8 bb = *(const bf16x8*)(CT_s + (16 * w + i16) * 136 + 32 * ks + 8 * g4);
                    acc = mfma16(a, bb, acc);
                }
#pragma unroll
                for (int r = 0; r < 4; ++r) o2_s[(16 * ti + 4 * g4 + r) * 132 + 16 * w + i16] = acc[r] * __shfl(ax.x, 16 * ti + 4 * g4 + r);
            }
            if (w < 4) {
                f32x4 acc = {0.f, 0.f, 0.f, 0.f};
#pragma unroll
                for (int ks = 0; ks < 4; ++ks) {
                    const bf16x8 a = *(const bf16x8*)(q_s + (16 * w + i16) * 136 + 32 * ks + 8 * g4);
                    const bf16x8 bb = *(const bf16x8*)(CT_s + (128 + i16) * 136 + 32 * ks + 8 * g4);
                    acc = mfma16(a, bb, acc);
                }
#pragma unroll
                for (int r = 0; r < 4; ++r) { const float v = acc[r] * __shfl(ax.x, 16 * w + 4 * g4 + r); if (i16 == 0) den2_s[16 * w + 4 * g4 + r] = v; }
            }
        }
        __syncthreads();
        {
            const float den = __shfl(ax.z, et) + (grp > 0 ? den2_s[et] : 0.f);
            const float inv = 1.f / fmaxf(fabsf(den), __shfl(ax.y, et));
            float ho[16]; float ss = 0.f;
#pragma unroll
            for (int j = 0; j < 16; ++j) {
                const unsigned wn = nd[j >> 3][(j >> 1) & 3]; float num = (j & 1) ? bfhi(wn) : bflo(wn);
                if (grp > 0) num += o2_s[et * 132 + ec + j];
                const unsigned wv = ov[j >> 3][(j >> 1) & 3]; const float o = (j & 1) ? bfhi(wv) : bflo(wv);
                ho[j] = num * inv * __builtin_amdgcn_rcpf(1.f + __expf(-o)); ss += ho[j] * ho[j];
            }
            ss += __shfl_xor(ss, 1); ss += __shfl_xor(ss, 2); ss += __shfl_xor(ss, 4);
            const float rr = rsqrtf(ss * (1.f / 128.f) + 1e-6f);
            float ob[16];
#pragma unroll
            for (int j = 0; j < 16; ++j) {
                const unsigned wv = zv[j >> 3][(j >> 1) & 3]; const float z = (j & 1) ? bfhi(wv) : bflo(wv);
                ob[j] = ho[j] * rr * gml[j] * (z * __builtin_amdgcn_rcpf(1.f + __expf(-z)));
            }
            u32x4 s0, s1;
            s0.x = pk2(ob[0], ob[1]); s0.y = pk2(ob[2], ob[3]); s0.z = pk2(ob[4], ob[5]); s0.w = pk2(ob[6], ob[7]);
            s1.x = pk2(ob[8], ob[9]); s1.y = pk2(ob[10], ob[11]); s1.z = pk2(ob[12], ob[13]); s1.w = pk2(ob[14], ob[15]);
            u16* dst = Hm + (tokc + et) * 1024 + hh * 128 + ec;
            *(u32x4*)dst = s0; *(u32x4*)(dst + 8) = s1;
        }
        __syncthreads();
    }
}

__device__ __forceinline__ void sb_unit(const Params& p, const int unit, u16* vT, const int lane) {
    const u16* P = (const u16*)(p.ws + WS_P); u16* Hm = (u16*)(p.ws + WS_HMIX);
    const int qt = unit & 127, hd = (unit >> 7) & 7, b = unit >> 10;
    const int r = lane & 31, h = lane >> 5;
    const size_t tokb = (size_t)b * 4096;
    bf16x8 qf[4];
    { const u16* qrow = P + (tokb + qt * 32 + r) * NP + 2560 + hd * 64 + 8 * h;
#pragma unroll
      for (int ks = 0; ks < 4; ++ks) qf[ks] = *(const bf16x8*)(qrow + 16 * ks); }
    u32x4 Tw[2];
#pragma unroll
    for (int st = 0; st < 2; ++st) {
        unsigned tw[4];
#pragma unroll
        for (int e = 0; e < 8; e += 2) {
            const int j0 = 16 * st + 8 * (e >> 2) + 4 * h + (e & 3), j1 = j0 + 1;
            tw[e >> 1] = ((j0 > r) ? 0x3C00u : 0u) | ((j1 > r) ? 0x3C000000u : 0u);
        }
        Tw[st].x = tw[0]; Tw[st].y = tw[1]; Tw[st].z = tw[2]; Tw[st].w = tw[3];
    }
    f32x16 O0, O1;
#pragma unroll
    for (int i = 0; i < 16; ++i) { O0[i] = 0.f; O1[i] = 0.f; }
    float R2 = 0.f;
    const float SC = 0.125f * 1.4426950408889634f;
    const size_t tok = tokb + qt * 32 + r;
    u32x2 zz8[8];
#pragma unroll
    for (int i = 0; i < 8; ++i) zz8[i] = *(const u32x2*)(P + tok * NP + 4096 + hd * 64 + 32 * (i >> 2) + 8 * (i & 3) + 4 * h);
    asm volatile("" ::: "memory");
    bf16x8 kfn[4]; u32x4 vvn[4];
    { const u16* krow = P + (tokb + qt * 32 + r) * NP + 3072 + hd * 64 + 8 * h;
#pragma unroll
      for (int ks = 0; ks < 4; ++ks) kfn[ks] = *(const bf16x8*)(krow + 16 * ks);
      const u16* vrow = P + (tokb + qt * 32 + (lane >> 1)) * NP + 3584 + hd * 64 + (lane & 1) * 32;
#pragma unroll
      for (int i = 0; i < 4; ++i) vvn[i] = *(const u32x4*)(vrow + 8 * i); }
    bool have = true;
    for (int kb = qt; kb >= 0; --kb) {
        if (!have) {
            const u16* krow = P + (tokb + kb * 32 + r) * NP + 3072 + hd * 64 + 8 * h;
#pragma unroll
            for (int ks = 0; ks < 4; ++ks) kfn[ks] = *(const bf16x8*)(krow + 16 * ks);
            const u16* vrow = P + (tokb + kb * 32 + (lane >> 1)) * NP + 3584 + hd * 64 + (lane & 1) * 32;
#pragma unroll
            for (int i = 0; i < 4; ++i) vvn[i] = *(const u32x4*)(vrow + 8 * i);
        }
        bf16x8 kf[4]; u32x4 vv[4];
#pragma unroll
        for (int i = 0; i < 4; ++i) { kf[i] = kfn[i]; vv[i] = vvn[i]; }
        asm volatile("" ::: "memory");
        have = (kb > 0) && __any(R2 > -30.f);
        if (have) {
            const int s1 = (kb - 1) * 32;
            const u16* krow = P + (tokb + s1 + r) * NP + 3072 + hd * 64 + 8 * h;
#pragma unroll
            for (int ks = 0; ks < 4; ++ks) kfn[ks] = *(const bf16x8*)(krow + 16 * ks);
            const u16* vrow = P + (tokb + s1 + (lane >> 1)) * NP + 3584 + hd * 64 + (lane & 1) * 32;
#pragma unroll
            for (int i = 0; i < 4; ++i) vvn[i] = *(const u32x4*)(vrow + 8 * i);
        }
        asm volatile("" ::: "memory");
        f32x16 Z;
#pragma unroll
        for (int i = 0; i < 16; ++i) Z[i] = 0.f;
#pragma unroll
        for (int ks = 0; ks < 4; ++ks) Z = mfma32(kf[ks], qf[ks], Z);
        float lbv[16], lkv[16];
#pragma unroll
        for (int reg = 0; reg < 16; ++reg) {
            const float u = Z[reg] * SC;
            const float sp = __builtin_amdgcn_logf(1.f + __builtin_amdgcn_exp2f(-fabsf(u)));
            lbv[reg] = fminf(u, 0.f) - sp;
            lkv[reg] = lbv[reg] - u;
        }
        if (kb == qt) {
#pragma unroll
            for (int reg = 0; reg < 16; ++reg) {
                const int sl = (reg & 3) + 8 * (reg >> 2) + 4 * h;
                const bool valid = sl < r;
                lbv[reg] = valid ? lbv[reg] : -1e30f;
                lkv[reg] = valid ? lkv[reg] : 0.f;
            }
        }
        u32x4 lw[2];
#pragma unroll
        for (int st = 0; st < 2; ++st) {
            lw[st].x = pkh2(lkv[8 * st + 0], lkv[8 * st + 1]); lw[st].y = pkh2(lkv[8 * st + 2], lkv[8 * st + 3]);
            lw[st].z = pkh2(lkv[8 * st + 4], lkv[8 * st + 5]); lw[st].w = pkh2(lkv[8 * st + 6], lkv[8 * st + 7]);
        }
        f32x16 aft;
#pragma unroll
        for (int i = 0; i < 16; ++i) aft[i] = 0.f;
        aft = __builtin_amdgcn_mfma_f32_32x32x16_f16(__builtin_bit_cast(f16x8, Tw[0]), __builtin_bit_cast(f16x8, lw[0]), aft, 0, 0, 0);
        aft = __builtin_amdgcn_mfma_f32_32x32x16_f16(__builtin_bit_cast(f16x8, Tw[1]), __builtin_bit_cast(f16x8, lw[1]), aft, 0, 0, 0);
        const float tot = __shfl(aft[0] + lkv[0], r);
        bf16x8 pf[2];
#pragma unroll
        for (int st = 0; st < 2; ++st) {
            u32x4 pw;
            pw.x = pk2(__builtin_amdgcn_exp2f(lbv[8 * st + 0] + R2 + aft[8 * st + 0]), __builtin_amdgcn_exp2f(lbv[8 * st + 1] + R2 + aft[8 * st + 1]));
            pw.y = pk2(__builtin_amdgcn_exp2f(lbv[8 * st + 2] + R2 + aft[8 * st + 2]), __builtin_amdgcn_exp2f(lbv[8 * st + 3] + R2 + aft[8 * st + 3]));
            pw.z = pk2(__builtin_amdgcn_exp2f(lbv[8 * st + 4] + R2 + aft[8 * st + 4]), __builtin_amdgcn_exp2f(lbv[8 * st + 5] + R2 + aft[8 * st + 5]));
            pw.w = pk2(__builtin_amdgcn_exp2f(lbv[8 * st + 6] + R2 + aft[8 * st + 6]), __builtin_amdgcn_exp2f(lbv[8 * st + 7] + R2 + aft[8 * st + 7]));
            pf[st] = __builtin_bit_cast(bf16x8, pw);
        }
        {
            const int sv = lane >> 1, db = (lane & 1) * 32;
#pragma unroll
            for (int i = 0; i < 4; ++i)
#pragma unroll
                for (int wq = 0; wq < 4; ++wq) {
                    const unsigned x = vv[i][wq]; const int d = db + 8 * i + 2 * wq;
                    vT[d * 40 + sv] = (u16)(x & 0xffffu); vT[(d + 1) * 40 + sv] = (u16)(x >> 16);
                }
        }
        asm volatile("s_waitcnt lgkmcnt(0)" ::: "memory");
#pragma unroll
        for (int st = 0; st < 2; ++st) {
            const u32x2 a0 = *(const u32x2*)(vT + r * 40 + 16 * st + 4 * h), a1 = *(const u32x2*)(vT + r * 40 + 16 * st + 8 + 4 * h);
            const u32x2 b0 = *(const u32x2*)(vT + (32 + r) * 40 + 16 * st + 4 * h), b1 = *(const u32x2*)(vT + (32 + r) * 40 + 16 * st + 8 + 4 * h);
            u32x4 fa, fb; fa.x = a0.x; fa.y = a0.y; fa.z = a1.x; fa.w = a1.y; fb.x = b0.x; fb.y = b0.y; fb.z = b1.x; fb.w = b1.y;
            O0 = mfma32(__builtin_bit_cast(bf16x8, fa), pf[st], O0);
            O1 = mfma32(__builtin_bit_cast(bf16x8, fb), pf[st], O1);
        }
        asm volatile("s_waitcnt lgkmcnt(0)" ::: "memory");
        R2 += tot;
        if (!__any(R2 > -64.f)) break;
    }
#pragma unroll
    for (int dt = 0; dt < 2; ++dt)
#pragma unroll
        for (int q4 = 0; q4 < 4; ++q4) {
            const int d0 = 32 * dt + 8 * q4 + 4 * h;
            const u32x2 zz = zz8[4 * dt + q4];
            float o[4];
#pragma unroll
            for (int e = 0; e < 4; ++e) {
                const float ov = dt ? O1[4 * q4 + e] : O0[4 * q4 + e];
                const unsigned wv = (e < 2) ? zz.x : zz.y; const float z = (e & 1) ? bfhi(wv) : bflo(wv);
                o[e] = ov * (z * __builtin_amdgcn_rcpf(1.f + __expf(-z)));
            }
            u32x2 st; st.x = pk2(o[0], o[1]); st.y = pk2(o[2], o[3]);
            *(u32x2*)(Hm + tok * 1024 + 512 + hd * 64 + d0) = st;
        }
}

__device__ __forceinline__ void phase2a(const Params& p) {
    for (int u = blockIdx.x; u < 256; u += gridDim.x) { mlstm_pass1(p, u >> 2, u & 3); __syncthreads(); }
}
__device__ __forceinline__ void phase2b(const Params& p) {
    extern __shared__ __attribute__((aligned(16))) unsigned char lds[];
    for (int u = blockIdx.x; u < 256; u += gridDim.x) { mlstm_pass2(p, u >> 2, u & 3); __syncthreads(); }
    const int tid2 = opaque_tid(), lane = tid2 & 63, wave = tid2 >> 6;
    u16* vT = (u16*)(lds + wave * 5120);
    for (int u = blockIdx.x * 8 + wave; u < 16384; u += gridDim.x * 8) sb_unit(p, u, vT, lane);
}

__device__ __forceinline__ void phase4(const Params& p) {
    const int tid = opaque_tid(), lane = tid & 63, wave = tid >> 6;
    const float* modp = (const float*)(p.ws + WS_MOD);
    const u16* Y = (const u16*)(p.ws + WS_Y);
    for (int tb = blockIdx.x * 8 + wave; tb < 2048; tb += gridDim.x * 8) {
        const int tok0 = tb * 32, b = tok0 >> 12;
        f32x4 gg[4];
#pragma unroll
        for (int j = 0; j < 4; ++j) { const int k = lane * 4 + 256 * j; gg[j] = *(const f32x4*)(modp + b * 3072 + 2048 + k) * *(const f32x4*)(p.g_post + k); }
        u32x2 yn[4]; f32x4 xn[4];
#pragma unroll
        for (int j = 0; j < 4; ++j) { yn[j] = *(const u32x2*)(Y + (size_t)tok0 * 1024 + lane * 4 + 256 * j); xn[j] = __builtin_nontemporal_load((const f32x4*)(p.x + (size_t)tok0 * 1024 + lane * 4 + 256 * j)); }
        for (int t = 0; t < 32; ++t) {
            const size_t tok = (size_t)tok0 + t;
            f32x4 y[4], xv[4]; float ss = 0.f;
#pragma unroll
            for (int j = 0; j < 4; ++j) { const u32x2 w = yn[j]; xv[j] = xn[j];
                y[j] = (f32x4){bflo(w.x), bfhi(w.x), bflo(w.y), bfhi(w.y)}; ss += (y[j].x * y[j].x + y[j].y * y[j].y) + (y[j].z * y[j].z + y[j].w * y[j].w); }
            if (t + 1 < 32) {
#pragma unroll
                for (int j = 0; j < 4; ++j) { yn[j] = *(const u32x2*)(Y + (tok + 1) * 1024 + lane * 4 + 256 * j); xn[j] = __builtin_nontemporal_load((const f32x4*)(p.x + (tok + 1) * 1024 + lane * 4 + 256 * j)); }
            }
            ss = wave_sum(ss); const float r = rsqrtf(ss * (1.f / 1024.f) + 1e-6f);
#pragma unroll
            for (int j = 0; j < 4; ++j) __builtin_nontemporal_store(xv[j] + gg[j] * (y[j] * r), (f32x4*)(p.out + tok * 1024 + lane * 4 + 256 * j));
        }
    }
}

DEVI unsigned bar_ld(unsigned* q) { return __hip_atomic_load(q, __ATOMIC_RELAXED, __HIP_MEMORY_SCOPE_AGENT); }
DEVI unsigned bar_add(unsigned* q, unsigned v) { return __hip_atomic_fetch_add(q, v, __ATOMIC_RELAXED, __HIP_MEMORY_SCOPE_AGENT); }
DEVI unsigned xcc_id() { return (unsigned)__builtin_amdgcn_s_getreg((3 << 11) | 20) & 0xFu; }
DEVI void grid_sync0(const Params& p, cg::grid_group& g) {
    asm volatile("s_waitcnt vmcnt(0) lgkmcnt(0)" ::: "memory");
    g.sync();
    if (threadIdx.x == 0) { __builtin_amdgcn_fence(__ATOMIC_ACQUIRE, "agent"); asm volatile("s_waitcnt vmcnt(0)" ::: "memory"); }
    __syncthreads();
}
DEVI void grid_sync(const Params& p, const int idx, const unsigned xcc, const unsigned nloc, const unsigned nxcc) {
    asm volatile("s_waitcnt vmcnt(0) lgkmcnt(0)" ::: "memory");
    __syncthreads();
    if (threadIdx.x == 0) {
        unsigned* bar = (unsigned*)(p.ws + WS_BAR);
        unsigned* xsub = bar + 1024 + (16 * idx + xcc) * 64; unsigned* top = bar + 9216 + 64 * idx;
        const unsigned old = bar_add(xsub, 1u);
        if (old == nloc - 1u) {
            __builtin_amdgcn_fence(__ATOMIC_RELEASE, "agent");
            asm volatile("s_waitcnt vmcnt(0)" ::: "memory");
            bar_add(top, 1u);
        }
        while (bar_ld(top) < nxcc) __builtin_amdgcn_s_sleep(1);
        __builtin_amdgcn_fence(__ATOMIC_ACQUIRE, "agent");
        asm volatile("s_waitcnt vmcnt(0)" ::: "memory");
    }
    __syncthreads();
}
__global__ void __launch_bounds__(512) hymba_fwd(Params p) {
    cg::grid_group grid = cg::this_grid();
    const unsigned xcc = xcc_id();
    if (threadIdx.x == 0) bar_add((unsigned*)(p.ws + WS_BAR) + 64 * xcc, 1u);
    phase0(p);
    if (gridDim.x == 0x7fffffffu) grid_sync0(p, grid);
    if (threadIdx.x == 0) {
        unsigned* bar = (unsigned*)(p.ws + WS_BAR);
        for (;;) { unsigned tot = 0; for (int j = 0; j < 16; ++j) tot += bar_ld(bar + 64 * j); if (tot >= gridDim.x) break; __builtin_amdgcn_s_sleep(1); }
    }
    __syncthreads();
    unsigned nloc, nxcc = 0;
    { unsigned* bar = (unsigned*)(p.ws + WS_BAR); nloc = bar_ld(bar + 64 * xcc);
      for (int j = 0; j < 16; ++j) nxcc += (bar_ld(bar + 64 * j) != 0u) ? 1u : 0u; }
    grid_sync(p, 0, xcc, nloc, nxcc);
    phase1a(p);
    grid_sync(p, 1, xcc, nloc, nxcc);
    gemm_phase((const u16*)(p.ws + WS_H), (const u16*)(p.ws + WS_WTIN), (u16*)(p.ws + WS_P), 18, NP);
    grid_sync(p, 2, xcc, nloc, nxcc);
    phase2a(p);
    grid_sync(p, 5, xcc, nloc, nxcc);
    phase2b(p);
    grid_sync(p, 3, xcc, nloc, nxcc);
    gemm_phase((const u16*)(p.ws + WS_HMIX), (const u16*)(p.ws + WS_WTOUT), (u16*)(p.ws + WS_Y), 4, 1024);
    grid_sync(p, 4, xcc, nloc, nxcc);
    phase4(p);
}

extern "C" void kernel_launch(void* const* d_in, const int* in_sizes, int n_in, void* d_out, int out_size, void* d_ws, size_t ws_size, hipStream_t stream) {
    static int grid_blocks = 0;
    if (!grid_blocks) {
        if (n_in != 13 || out_size != NTOK * DM || ws_size < WS_END) { fprintf(stderr, "kernel_launch: unexpected shapes (n_in %d out %d ws %zu)\n", n_in, out_size, ws_size); grid_blocks = -1; return; }
        int dev = 0, cus = 0, per_cu = 0;
        hipGetDevice(&dev);
        hipDeviceGetAttribute(&cus, hipDeviceAttributeMultiprocessorCount, dev);
        if (hipFuncSetAttribute((const void*)hymba_fwd, hipFuncAttributeMaxDynamicSharedMemorySize, LDS_BYTES) != hipSuccess) fprintf(stderr, "kernel_launch: hipFuncSetAttribute failed\n");
        if (hipOccupancyMaxActiveBlocksPerMultiprocessor(&per_cu, (const void*)hymba_fwd, 512, LDS_BYTES) != hipSuccess || per_cu < 1) { fprintf(stderr, "kernel_launch: occupancy query says %d\n", per_cu); per_cu = 1; }
        (void)hipGetLastError();
        grid_blocks = cus * 1;
    }
    if (grid_blocks < 0) return;
    Params p{};
    p.x = (const float*)d_in[0]; p.c = (const float*)d_in[1]; p.w_ada = (const float*)d_in[2]; p.b_ada = (const float*)d_in[3]; p.g_pre = (const float*)d_in[4];
    p.w_in = (const float*)d_in[5]; p.b_ig = (const float*)d_in[6]; p.b_fg = (const float*)d_in[7]; p.conv_w = (const float*)d_in[8]; p.conv_b = (const float*)d_in[9];
    p.g_ml = (const float*)d_in[10]; p.w_out = (const float*)d_in[11]; p.g_post = (const float*)d_in[12];
    p.out = (float*)d_out; p.ws = (unsigned char*)d_ws;
    if (hipMemsetAsync((unsigned char*)d_ws + WS_BAR, 0, 40960, stream) != hipSuccess) fprintf(stderr, "kernel_launch: memset of the barrier words failed\n");
    void* args[] = {&p};
    hipError_t e = hipLaunchCooperativeKernel((const void*)hymba_fwd, dim3(grid_blocks), dim3(512), args, LDS_BYTES, stream);
    if (e != hipSuccess) fprintf(stderr, "cooperative launch failed: %s (grid %d)\n", hipGetErrorString(e), grid_blocks);
}
```

```cpp
#include <hip/hip_runtime.h>
#include <hip/hip_cooperative_groups.h>
#include <cstdio>
#include <cstdint>
namespace cg = cooperative_groups;

typedef unsigned short u16;
typedef short bf16x8 __attribute__((ext_vector_type(8)));
typedef float f32x4 __attribute__((ext_vector_type(4)));
typedef float f32x16 __attribute__((ext_vector_type(16)));
typedef unsigned u32x4 __attribute__((ext_vector_type(4)));
typedef unsigned u32x2 __attribute__((ext_vector_type(2)));
#define DEVI __device__ __forceinline__

constexpr int NTOK = 65536, DM = 1024, NP = 4608;
constexpr size_t WS_WTIN = 0;
constexpr size_t WS_WTOUT = 9437184;
constexpr size_t WS_WG = 11534336;
constexpr size_t WS_MOD = 11567104;
constexpr size_t WS_BAR = 13860864;
constexpr size_t WS_GATES = 11763712;
constexpr size_t WS_H = 16777216;
constexpr size_t WS_P = WS_H + 134217728;
constexpr size_t WS_HMIX = WS_P + 603979776;
constexpr size_t WS_Y = WS_HMIX + 134217728;
constexpr size_t WS_END = WS_Y + 134217728;
constexpr size_t WS_NDNUM = WS_H;
constexpr size_t WS_Q2 = WS_H + 67108864;
constexpr size_t WS_E = WS_Y;
constexpr size_t WS_AUX = WS_Y + 33554432;
constexpr size_t WS_DG = WS_Y + 41943040;
constexpr int LDS_BYTES = 131072;

struct Params {
    const float *x, *c, *w_ada, *b_ada, *g_pre, *w_in, *b_ig, *b_fg, *conv_w, *conv_b, *g_ml, *w_out, *g_post;
    float* out;
    unsigned char* ws;
};

DEVI int opaque_tid() { int t = threadIdx.x; asm volatile("" : "+v"(t)); return t; }
typedef __bf16 bf16x2_t __attribute__((ext_vector_type(2)));
typedef _Float16 f16x2_t __attribute__((ext_vector_type(2)));
typedef _Float16 f16x8 __attribute__((ext_vector_type(8)));
typedef float f32x2_t __attribute__((ext_vector_type(2)));
DEVI unsigned pk2(float lo, float hi) { const f32x2_t v = {lo, hi}; const bf16x2_t b = __builtin_convertvector(v, bf16x2_t); return __builtin_bit_cast(unsigned, b); }
DEVI unsigned pkh2(float lo, float hi) { const f32x2_t v = {lo, hi}; const f16x2_t b = __builtin_convertvector(v, f16x2_t); return __builtin_bit_cast(unsigned, b); }
DEVI float bflo(unsigned w) { return __uint_as_float(w << 16); }
DEVI float bfhi(unsigned w) { return __uint_as_float(w & 0xffff0000u); }
DEVI float wave_sum(float v) {
#pragma unroll
    for (int o = 1; o < 64; o <<= 1) v += __shfl_xor(v, o);
    return v;
}
DEVI float wave_max(float v) {
#pragma unroll
    for (int o = 1; o < 64; o <<= 1) v = fmaxf(v, __shfl_xor(v, o));
    return v;
}
DEVI int perm32(int rho) { const int n = rho >> 4, i = rho & 15; return 8 * (i >> 2) + 4 * n + (i & 3); }
DEVI f32x4 mfma16(bf16x8 a, bf16x8 b, f32x4 c) { return __builtin_amdgcn_mfma_f32_16x16x32_bf16(a, b, c, 0, 0, 0); }
DEVI f32x16 mfma32(bf16x8 a, bf16x8 b, f32x16 c) { return __builtin_amdgcn_mfma_f32_32x32x16_bf16(a, b, c, 0, 0, 0); }

DEVI void p0_transpose_item(const float* __restrict__ W, const int ldw, const int srccol0, u16* __restrict__ dst, const int n0, const int k0, float* scr, const int lane) {
#pragma unroll 8
    for (int i = 0; i < 32; ++i) { const int kk = 2 * i + (lane >> 5); scr[kk * 33 + (lane & 31)] = W[(size_t)(k0 + kk) * ldw + srccol0 + (lane & 31)]; }
    asm volatile("s_waitcnt lgkmcnt(0)" ::: "memory");
    const int c = lane & 7;
#pragma unroll
    for (int j = 0; j < 4; ++j) {
        const int slot = (lane >> 3) + 8 * j, cl = perm32(slot);
        const float* sp = scr + (8 * c) * 33 + cl;
        u32x4 o; o.x = pk2(sp[0], sp[33]); o.y = pk2(sp[2 * 33], sp[3 * 33]); o.z = pk2(sp[4 * 33], sp[5 * 33]); o.w = pk2(sp[6 * 33], sp[7 * 33]);
        *(u32x4*)(dst + (size_t)(n0 + slot) * 1024 + k0 + 8 * c) = o;
    }
    asm volatile("s_waitcnt lgkmcnt(0)" ::: "memory");
}
__device__ __forceinline__ void phase0(const Params& p) {
    extern __shared__ __attribute__((aligned(16))) unsigned char lds[];
    const int tid = opaque_tid(), lane = tid & 63, wave = tid >> 6;
    float* modp = (float*)(p.ws + WS_MOD);
    for (int job = blockIdx.x; job < 96; job += gridDim.x) {
        float* sc = (float*)lds; float* red = (float*)(lds + 65536);
        for (int i = tid; i < 16384; i += 512) { const float v = p.c[i]; sc[i] = v / (1.f + expf(-v)); }
        __syncthreads();
        const int jl = tid & 31, kq = tid >> 5, j0 = job * 32;
        float acc[16];
#pragma unroll
        for (int b = 0; b < 16; ++b) acc[b] = 0.f;
        for (int kk = 0; kk < 64; ++kk) {
            const int k = kq * 64 + kk; const float w = p.w_ada[(size_t)k * 3072 + j0 + jl];
#pragma unroll
            for (int b = 0; b < 16; ++b) acc[b] += sc[b * 1024 + k] * w;
        }
#pragma unroll
        for (int b = 0; b < 16; ++b) red[(kq * 16 + b) * 32 + jl] = acc[b];
        __syncthreads();
        { const int b = tid >> 5; float sacc = p.b_ada[j0 + jl];
          for (int q = 0; q < 16; ++q) sacc += red[(q * 16 + b) * 32 + jl];
          modp[b * 3072 + j0 + jl] = sacc; }
        __syncthreads();
    }
    if (blockIdx.x == (gridDim.x > 100 ? 100 : 0)) {
        float* Wg = (float*)(p.ws + WS_WG);
        for (int i = tid; i < 8192; i += 512) { const int g = i & 7, k = i >> 3; Wg[g * 1024 + k] = p.w_in[(size_t)k * 4616 + 2560 + g]; }
    }
    {
        float* scr = (float*)(lds + wave * 8448);
        const int NW = gridDim.x * 8, gw = NW - 1 - (blockIdx.x * 8 + wave);
        for (int it = gw; it < 2816; it += NW) {
            if (it < 2304) { const int nb = it >> 4, kb = it & 15, n0 = nb * 32;
                p0_transpose_item(p.w_in, 4616, n0 < 2560 ? n0 : n0 + 8, (u16*)(p.ws + WS_WTIN), n0, kb * 64, scr, lane); }
            else { const int r2 = it - 2304, nb = r2 >> 4, kb = r2 & 15, n0 = nb * 32;
                p0_transpose_item(p.w_out, 1024, n0, (u16*)(p.ws + WS_WTOUT), n0, kb * 64, scr, lane); }
        }
    }
}

__device__ __forceinline__ void phase1a(const Params& p) {
    extern __shared__ __attribute__((aligned(16))) unsigned char lds[];
    const int tid = opaque_tid(), lane = tid & 63, wave = tid >> 6;
    float* wg_s = (float*)lds;
    { const float* Wg = (const float*)(p.ws + WS_WG); for (int i = tid; i < 8192; i += 512) wg_s[i] = Wg[i]; }
    __syncthreads();
    const float* modp = (const float*)(p.ws + WS_MOD);
    u16* H = (u16*)(p.ws + WS_H); float* gates = (float*)(p.ws + WS_GATES);
    for (int tb = blockIdx.x * 8 + wave; tb < 2048; tb += gridDim.x * 8) {
        const int tok0 = tb * 32, b = tok0 >> 12;
        f32x4 gs[4], sh[4];
#pragma unroll
        for (int j = 0; j < 4; ++j) { const int k = lane * 4 + 256 * j; const f32x4 g = *(const f32x4*)(p.g_pre + k); const f32x4 s = *(const f32x4*)(modp + b * 3072 + 1024 + k);
            sh[j] = *(const f32x4*)(modp + b * 3072 + k); gs[j] = g * (1.f + s); }
        float bias = 0.f; if (lane < 4) bias = p.b_ig[lane]; else if (lane < 8) bias = p.b_fg[lane - 4];
        f32x4 vn[4];
#pragma unroll
        for (int j = 0; j < 4; ++j) vn[j] = __builtin_nontemporal_load((const f32x4*)(p.x + (size_t)tok0 * 1024 + lane * 4 + 256 * j));
        for (int t = 0; t < 32; ++t) {
            const size_t tok = (size_t)tok0 + t;
            f32x4 v[4]; float ss = 0.f;
#pragma unroll
            for (int j = 0; j < 4; ++j) { v[j] = vn[j]; ss += (v[j].x * v[j].x + v[j].y * v[j].y) + (v[j].z * v[j].z + v[j].w * v[j].w); }
            if (t + 1 < 32) {
#pragma unroll
                for (int j = 0; j < 4; ++j) vn[j] = __builtin_nontemporal_load((const f32x4*)(p.x + (tok + 1) * 1024 + lane * 4 + 256 * j));
            }
            ss = wave_sum(ss); const float r = rsqrtf(ss * (1.f / 1024.f) + 1e-6f);
            float part[8];
#pragma unroll
            for (int g = 0; g < 8; ++g) part[g] = 0.f;
#pragma unroll
            for (int j = 0; j < 4; ++j) {
                const f32x4 hv = v[j] * r * gs[j] + sh[j];
                u32x2 o; o.x = pk2(hv.x, hv.y); o.y = pk2(hv.z, hv.w);
                *(u32x2*)(H + tok * 1024 + lane * 4 + 256 * j) = o;
#pragma unroll
                for (int g = 0; g < 8; ++g) { const f32x4 w = *(const f32x4*)(wg_s + g * 1024 + lane * 4 + 256 * j); part[g] += (hv.x * w.x + hv.y * w.y) + (hv.z * w.z + hv.w * w.w); }
            }
#pragma unroll
            for (int g = 0; g < 8; ++g) part[g] = wave_sum(part[g]);
            float ov = part[0];
#pragma unroll
            for (int g = 1; g < 8; ++g) if (lane == g) ov = part[g];
            if (lane < 8) gates[tok * 8 + lane] = ov + bias;
        }
    }
}

constexpr int BM = 256, BK = 64, HALF = 128, HT = HALF * BK;
DEVI int lds_byte(int r, int c) { const int st = (r >> 4) * 2 + (c >> 5), rr = r & 15, cc = c & 31, ob = rr * 64 + cc * 2; return st * 1024 + (ob ^ (((ob >> 9) & 1) << 5)); }
DEVI void stage_rc(int b, int& R, int& C) { const int st = b / 1024, sb = b % 1024, swz = sb ^ (((sb >> 9) & 1) << 5); R = (st >> 1) * 16 + swz / 64; C = (st & 1) * 32 + (swz % 64) / 2; }

DEVI void gemm_unit(const int L, const int nM, const int nN, const int nwg, int& pm, int& pn) {
    int wgid = L;
    { const int q = nwg / 8, r = nwg % 8, xcd = wgid % 8, off = wgid / 8; wgid = (xcd < r ? xcd * (q + 1) : r * (q + 1) + (xcd - r) * q) + off; }
    const int nig = 8 * nN, gid = wgid / nig, fm = gid * 8, gsz = min(nM - fm, 8);
    pm = fm + ((wgid % nig) % gsz); pn = (wgid % nig) / gsz;
}
__device__ __forceinline__ void gemm_phase(const u16* __restrict__ A, const u16* __restrict__ Bt, u16* __restrict__ Out, const int nN, const int ldo) {
    extern __shared__ __attribute__((aligned(16))) unsigned char lds[];
    constexpr int K = 1024;
    const int tid = opaque_tid();
    u16* shm = (u16*)lds;
#define SA(b, h) (shm + ((b) * 2 + (h)) * HT)
#define SB(b, h) (shm + (4 + (b) * 2 + (h)) * HT)
#define STAGE(Pp, BASE, br, kt) do { const u16* _gb = (BASE) + ((size_t)(br) * K + (size_t)(kt) * BK); \
      __builtin_amdgcn_global_load_lds((const unsigned*)(_gb + so0), (unsigned*)((char*)(Pp) + tid * 16), 16, 0, 0); \
      __builtin_amdgcn_global_load_lds((const unsigned*)(_gb + 64 * K + so0), (unsigned*)((char*)(Pp) + tid * 16 + 8192), 16, 0, 0); } while (0)
#define LDA(dst, b, h) for (int m = 0; m < 4; ++m) for (int k = 0; k < 2; ++k) \
    dst[m][k] = *reinterpret_cast<const bf16x8*>((char*)SA(b, h) + lds_byte(wr * 64 + m * 16 + fr, k * 32 + fq * 8))
#define LDB(dst, b, h) for (int n = 0; n < 2; ++n) for (int k = 0; k < 2; ++k) \
    dst[n][k] = *reinterpret_cast<const bf16x8*>((char*)SB(b, h) + lds_byte(wc * 32 + n * 16 + fr, k * 32 + fq * 8))
#define MMA(ai, bj, At_, Bt_) do { __builtin_amdgcn_s_setprio(1); \
    for (int m = 0; m < 4; ++m) for (int n = 0; n < 2; ++n) for (int k = 0; k < 2; ++k) \
      acc[ai][bj][m][n] = __builtin_amdgcn_mfma_f32_16x16x32_bf16(Bt_[n][k], At_[m][k], acc[ai][bj][m][n], 0, 0, 0); \
    __builtin_amdgcn_s_setprio(0); } while (0)
#define WAIT_V(n) asm volatile("s_waitcnt vmcnt(" #n ")" ::: "memory")
#define WAIT_L(n) asm volatile("s_waitcnt lgkmcnt(" #n ")" ::: "memory")
#define BAR __builtin_amdgcn_s_barrier()
#define SCHED __builtin_amdgcn_sched_barrier(0)
#define EPILOGUE(ROW, COL) do { \
    _Pragma("unroll") for (int ai = 0; ai < 2; ++ai) \
    _Pragma("unroll") for (int m = 0; m < 4; ++m) { \
        u16* rowp = Out + (size_t)((ROW) + ai * HALF + wr * 64 + m * 16 + fr) * ldo + (COL) + wc * 32 + 8 * fq; \
        _Pragma("unroll") for (int bj = 0; bj < 2; ++bj) { \
            const f32x4 v0 = acc[ai][bj][m][0], v1 = acc[ai][bj][m][1]; \
            u32x4 w; w.x = pk2(v0[0], v0[1]); w.y = pk2(v0[2], v0[3]); w.z = pk2(v1[0], v1[1]); w.w = pk2(v1[2], v1[3]); \
            *(u32x4*)(rowp + bj * HALF) = w; \
        } } } while (0)
    const int wid = tid >> 6, lane = tid & 63, wr = wid >> 2, wc = wid & 3, fr = lane & 15, fq = lane >> 4;
    unsigned so0;
    { int r_, c_; stage_rc(tid * 16, r_, c_); so0 = (unsigned)(r_ * K + c_); }
    constexpr int nt = K / BK;
    const int nM = NTOK / BM, nwg = nM * nN, G = gridDim.x;
    int L = blockIdx.x;
    if (L < nwg) {
        int brow, bcol;
        { int pm, pn; gemm_unit(L, nM, nN, nwg, pm, pn); brow = pm * BM; bcol = pn * BM; }
        f32x4 acc[2][2][4][2] = {};
        bf16x8 At[4][2], B0[2][2], B1[2][2];
        STAGE(SB(0, 0), Bt, bcol, 0); STAGE(SA(0, 0), A, brow, 0);
        STAGE(SB(0, 1), Bt, bcol + HALF, 0); STAGE(SA(0, 1), A, brow + HALF, 0);
        if (wr == 1) BAR;
        WAIT_V(4); BAR;
        STAGE(SB(1, 0), Bt, bcol, 1); STAGE(SA(1, 0), A, brow, 1); STAGE(SB(1, 1), Bt, bcol + HALF, 1);
        WAIT_V(6); BAR;
        for (;;) {
            const bool last = (L + G >= nwg);
            int nbrow = brow, nbcol = bcol;
            if (!last) { int qm, qn; gemm_unit(L + G, nM, nN, nwg, qm, qn); nbrow = qm * BM; nbcol = qn * BM; }
            const int tend = last ? nt - 2 : nt;
            for (int t = 0; t < tend; t += 2) {
                const bool bnd = (t == nt - 2);
                const int r2 = bnd ? nbrow : brow, c2 = bnd ? nbcol : bcol, k2 = bnd ? 0 : t + 2, k3 = bnd ? 1 : t + 3;
                LDB(B0, 0, 0); SCHED; LDA(At, 0, 0); STAGE(SA(1, 1), A, brow + HALF, t + 1);
                WAIT_L(8); BAR; WAIT_L(0); MMA(0, 0, At, B0); BAR; SCHED;
                LDB(B1, 0, 1); STAGE(SB(0, 0), Bt, c2, k2);
                BAR; WAIT_L(0); MMA(0, 1, At, B1); BAR;
                LDA(At, 0, 1); STAGE(SA(0, 0), A, r2, k2);
                BAR; WAIT_L(0); MMA(1, 0, At, B0); BAR; SCHED;
                STAGE(SB(0, 1), Bt, c2 + HALF, k2);
                WAIT_V(6); BAR; MMA(1, 1, At, B1); BAR;
                LDB(B0, 1, 0); SCHED; LDA(At, 1, 0); STAGE(SA(0, 1), A, r2 + HALF, k2);
                WAIT_L(8); BAR; WAIT_L(0); MMA(0, 0, At, B0); BAR; SCHED;
                LDB(B1, 1, 1); STAGE(SB(1, 0), Bt, c2, k3);
                BAR; WAIT_L(0); MMA(0, 1, At, B1); BAR;
                LDA(At, 1, 1); STAGE(SA(1, 0), A, r2, k3);
                BAR; WAIT_L(0); MMA(1, 0, At, B0); BAR; SCHED;
                STAGE(SB(1, 1), Bt, c2 + HALF, k3);
                WAIT_V(6); BAR; MMA(1, 1, At, B1); BAR;
            }
            if (last) break;
            EPILOGUE(brow, bcol);
#pragma unroll
            for (int ai = 0; ai < 2; ++ai)
#pragma unroll
                for (int bj = 0; bj < 2; ++bj)
#pragma unroll
                    for (int m = 0; m < 4; ++m)
#pragma unroll
                        for (int n = 0; n < 2; ++n) acc[ai][bj][m][n] = (f32x4){0.f, 0.f, 0.f, 0.f};
            brow = nbrow; bcol = nbcol; L += G;
        }
        { LDB(B0, 0, 0); LDA(At, 0, 0); STAGE(SA(1, 1), A, brow + HALF, nt - 1);
          BAR; WAIT_L(0); MMA(0, 0, At, B0); BAR;
          LDB(B1, 0, 1); BAR; WAIT_L(0); MMA(0, 1, At, B1); BAR;
          LDA(At, 0, 1); WAIT_V(4); BAR; WAIT_L(0); MMA(1, 0, At, B0); MMA(1, 1, At, B1); BAR; }
        { LDB(B0, 1, 0); LDA(At, 1, 0); WAIT_V(2); BAR; WAIT_L(0); MMA(0, 0, At, B0); BAR;
          LDB(B1, 1, 1); WAIT_V(0); BAR; WAIT_L(0); MMA(0, 1, At, B1); BAR;
          LDA(At, 1, 1); BAR; WAIT_L(0); MMA(1, 0, At, B0); MMA(1, 1, At, B1); BAR; }
        if (wr == 0) BAR;
        EPILOGUE(brow, bcol);
    }
    __syncthreads();
#undef SA
#undef SB
#undef STAGE
#undef LDA
#undef LDB
#undef MMA
#undef EPILOGUE
}

__device__ __forceinline__ void mlstm_pass1(const Params& p, const int item, const int grp) {
    extern __shared__ __attribute__((aligned(16))) unsigned char lds[];
    const int tid = opaque_tid(), lane = tid & 63, w = tid >> 6, i16 = lane & 15, g4 = lane >> 4;
    const int b = item >> 2, hh = item & 3;
    u16* q_s = (u16*)(lds + 0); u16* k_s = (u16*)(lds + 17408); float* out_s = (float*)lds;
    u16* wkT_s = (u16*)(lds + 34816); u16* vT_s = (u16*)(lds + 53248); u16* S_s = (u16*)(lds + 73984);
    u16* CT_s = (u16*)(lds + 83200); float* den_s = (float*)(lds + 122368); float* a_s = (float*)(lds + 122368 + 256); float* ml_s = a_s + 64;
    const u16* P = (const u16*)(p.ws + WS_P); const float* gates = (const float*)(p.ws + WS_GATES);
    u16* NDn = (u16*)(p.ws + WS_NDNUM); u16* Q2 = (u16*)(p.ws + WS_Q2); float* AUX = (float*)(p.ws + WS_AUX);
    const int c0 = grp * 16;
    const size_t tokb = (size_t)b * 4096;
    for (int i = tid; i < 144 * 136 / 2; i += 512) ((unsigned*)CT_s)[i] = 0u;
    for (int i = tid; i < 16 * 72; i += 512) vT_s[128 * 72 + i] = (i < 72) ? (u16)0x3F80 : (u16)0;
    const int cp = tid & 63, t0 = 8 * w, ch = 2 * cp;
    float cwq[4][2], cwk[4][2], cbq[2], cbk[2];
#pragma unroll
    for (int j = 0; j < 4; ++j)
#pragma unroll
        for (int e = 0; e < 2; ++e) { cwq[j][e] = p.conv_w[j * 1024 + hh * 128 + ch + e]; cwk[j][e] = p.conv_w[j * 1024 + 512 + hh * 128 + ch + e]; }
#pragma unroll
    for (int e = 0; e < 2; ++e) { cbq[e] = p.conv_b[hh * 128 + ch + e]; cbk[e] = p.conv_b[512 + hh * 128 + ch + e]; }
    f32x4 Cacc[8], Cacc8 = {0.f, 0.f, 0.f, 0.f};
#pragma unroll
    for (int i = 0; i < 8; ++i) Cacc[i] = (f32x4){0.f, 0.f, 0.f, 0.f};
    for (int cc = w; cc < c0; cc += 8) {
        const size_t tk = tokb + (size_t)cc * 64 + lane;
        const float gi = gates[tk * 8 + hh], gf = gates[tk * 8 + 4 + hh];
        const float logf = fminf(gf, 0.f) - log1pf(expf(-fabsf(gf)));
        float bcs = logf;
#pragma unroll
        for (int o = 1; o < 64; o <<= 1) { const float u = __shfl_up(bcs, o); if (lane >= o) bcs += u; }
        const float a_tot = __shfl(bcs, 63);
        const float igb = gi - bcs;
        const float gg = a_tot + igb;
        const float m_loc = wave_max(gg);
        if (lane == 0) { a_s[cc] = a_tot; ml_s[cc] = m_loc; }
    }
    __syncthreads();
    float m_prev = 0.f;
    for (int cc = 0; cc < c0; ++cc) m_prev = fmaxf(a_s[cc] + m_prev, ml_s[cc]);
    float Pc = 1.f;
    const int et = tid >> 3, ec = (tid & 7) * 16;
    unsigned rq[11], rk[11], rv[8]; float gi_n, gf_n;
    {
        const size_t tokc = tokb + (size_t)c0 * 64;
#pragma unroll
        for (int i = 0; i < 11; ++i) { const int row = t0 - 3 + i; const bool ok = (c0 > 0) || (row >= 0); const size_t o = (size_t)((long)tokc + (ok ? row : 0)) * NP + hh * 128 + ch;
            rq[i] = ok ? *(const unsigned*)(P + o) : 0u; rk[i] = ok ? *(const unsigned*)(P + o + 512) : 0u; }
#pragma unroll
        for (int i = 0; i < 8; ++i) rv[i] = *(const unsigned*)(P + (tokc + t0 + i) * NP + 1024 + hh * 128 + ch);
        gi_n = gates[(tokc + lane) * 8 + hh]; gf_n = gates[(tokc + lane) * 8 + 4 + hh];
    }
    for (int c = c0; c < c0 + 16; ++c) {
        const size_t tokc = tokb + (size_t)c * 64;
        const size_t tq = (size_t)item * 4096 + (size_t)c * 64;
        const float gi = gi_n, gf = gf_n;
        const float logf = fminf(gf, 0.f) - log1pf(expf(-fabsf(gf)));
        float bcs = logf;
#pragma unroll
        for (int o = 1; o < 64; o <<= 1) { const float u = __shfl_up(bcs, o); if (lane >= o) bcs += u; }
        const float a_tot = __shfl(bcs, 63);
        const float igb = gi - bcs;
        const float gg = a_tot + igb;
        const float m_loc = wave_max(gg);
        const float m_new = fmaxf(a_tot + m_prev, m_loc);
        const float s_old = expf(a_tot + m_prev - m_new);
        const float wp = expf(gg - m_new);
        float mx = igb;
#pragma unroll
        for (int o = 1; o < 64; o <<= 1) { const float u = __shfl_up(mx, o); if (lane >= o) mx = fmaxf(mx, u); }
        const float m_t = bcs + fmaxf(m_prev, mx);
        const float iw = expf(bcs + m_prev - m_t);
        const float bm = bcs - m_t;
        {
            float kv0[8], kv1[8];
#pragma unroll
            for (int i = 0; i < 8; ++i) {
                float aq0 = cbq[0], aq1 = cbq[1], ak0 = cbk[0], ak1 = cbk[1];
#pragma unroll
                for (int j = 0; j < 4; ++j) { aq0 += cwq[j][0] * bflo(rq[i + j]); aq1 += cwq[j][1] * bfhi(rq[i + j]); ak0 += cwk[j][0] * bflo(rk[i + j]); ak1 += cwk[j][1] * bfhi(rk[i + j]); }
                const float q0 = aq0 * __builtin_amdgcn_rcpf(1.f + __expf(-aq0)), q1 = aq1 * __builtin_amdgcn_rcpf(1.f + __expf(-aq1));
                const float k0 = ak0 * __builtin_amdgcn_rcpf(1.f + __expf(-ak0)) * 0.08838834764831845f, k1 = ak1 * __builtin_amdgcn_rcpf(1.f + __expf(-ak1)) * 0.08838834764831845f;
                *(unsigned*)(q_s + (t0 + i) * 136 + ch) = pk2(q0, q1);
                *(unsigned*)(k_s + (t0 + i) * 136 + ch) = pk2(k0, k1);
                const float wpi = __shfl(wp, t0 + i);
                kv0[i] = k0 * wpi; kv1[i] = k1 * wpi;
            }
            u32x4 o0, o1;
            o0.x = pk2(kv0[0], kv0[1]); o0.y = pk2(kv0[2], kv0[3]); o0.z = pk2(kv0[4], kv0[5]); o0.w = pk2(kv0[6], kv0[7]);
            o1.x = pk2(kv1[0], kv1[1]); o1.y = pk2(kv1[2], kv1[3]); o1.z = pk2(kv1[4], kv1[5]); o1.w = pk2(kv1[6], kv1[7]);
            *(u32x4*)(wkT_s + ch * 72 + t0) = o0; *(u32x4*)(wkT_s + (ch + 1) * 72 + t0) = o1;
            u32x4 v0, v1;
            v0.x = (rv[0] & 0xffffu) | (rv[1] << 16); v0.y = (rv[2] & 0xffffu) | (rv[3] << 16); v0.z = (rv[4] & 0xffffu) | (rv[5] << 16); v0.w = (rv[6] & 0xffffu) | (rv[7] << 16);
            v1.x = (rv[0] >> 16) | (rv[1] & 0xffff0000u); v1.y = (rv[2] >> 16) | (rv[3] & 0xffff0000u); v1.z = (rv[4] >> 16) | (rv[5] & 0xffff0000u); v1.w = (rv[6] >> 16) | (rv[7] & 0xffff0000u);
            *(u32x4*)(vT_s + ch * 72 + t0) = v0; *(u32x4*)(vT_s + (ch + 1) * 72 + t0) = v1;
        }
        if (c + 1 < c0 + 16) {
            const size_t tn = tokc + 64;
#pragma unroll
            for (int i = 0; i < 11; ++i) { const size_t o = (tn + t0 - 3 + i) * NP + hh * 128 + ch; rq[i] = *(const unsigned*)(P + o); rk[i] = *(const unsigned*)(P + o + 512); }
#pragma unroll
            for (int i = 0; i < 8; ++i) rv[i] = *(const unsigned*)(P + (tn + t0 + i) * NP + 1024 + hh * 128 + ch);
            gi_n = gates[(tn + lane) * 8 + hh]; gf_n = gates[(tn + lane) * 8 + 4 + hh];
        }
        __syncthreads();
        {
            const u32x4 qa = *(const u32x4*)(q_s + et * 136 + ec), qb = *(const u32x4*)(q_s + et * 136 + ec + 8);
            u16* qd = Q2 + (tq + et) * 128 + ec; *(u32x4*)qd = qa; *(u32x4*)(qd + 8) = qb;
            if (w == 0) { AUX[(tq + lane) * 4 + 0] = iw * Pc; AUX[(tq + lane) * 4 + 1] = expf(-m_t); }
        }
        {
            const int ti = w >> 1;
#pragma unroll
            for (int sj = 0; sj < 2; ++sj) {
                const int si = 2 * (w & 1) + sj;
                f32x4 acc = {0.f, 0.f, 0.f, 0.f};
                if (si <= ti) {
#pragma unroll
                    for (int ks = 0; ks < 4; ++ks) {
                        const bf16x8 a = *(const bf16x8*)(q_s + (16 * ti + i16) * 136 + 32 * ks + 8 * g4);
                        const bf16x8 bb = *(const bf16x8*)(k_s + (16 * si + i16) * 136 + 32 * ks + 8 * g4);
                        acc = mfma16(a, bb, acc);
                    }
                }
                const int s = 16 * si + i16; const float igb_s = __shfl(igb, s);
#pragma unroll
                for (int r = 0; r < 4; ++r) {
                    const int t = 16 * ti + 4 * g4 + r; const float bm_t = __shfl(bm, t);
                    const float val = (s <= t) ? acc[r] * __expf(bm_t + igb_s) : 0.f;
                    S_s[t * 72 + s] = (u16)(pk2(val, 0.f) & 0xffffu);
                }
            }
        }
        f32x4 accO[4], accO8 = {0.f, 0.f, 0.f, 0.f};
#pragma unroll
        for (int ti = 0; ti < 4; ++ti) {
            f32x4 acc = {0.f, 0.f, 0.f, 0.f};
#pragma unroll
            for (int ks = 0; ks < 4; ++ks) {
                const bf16x8 a = *(const bf16x8*)(q_s + (16 * ti + i16) * 136 + 32 * ks + 8 * g4);
                const bf16x8 bb = *(const bf16x8*)(CT_s + (16 * w + i16) * 136 + 32 * ks + 8 * g4);
                acc = mfma16(a, bb, acc);
            }
#pragma unroll
            for (int r = 0; r < 4; ++r) acc[r] *= __shfl(iw, 16 * ti + 4 * g4 + r);
            accO[ti] = acc;
        }
        if (w < 4) {
            f32x4 acc = {0.f, 0.f, 0.f, 0.f};
#pragma unroll
            for (int ks = 0; ks < 4; ++ks) {
                const bf16x8 a = *(const bf16x8*)(q_s + (16 * w + i16) * 136 + 32 * ks + 8 * g4);
                const bf16x8 bb = *(const bf16x8*)(CT_s + (128 + i16) * 136 + 32 * ks + 8 * g4);
                acc = mfma16(a, bb, acc);
            }
#pragma unroll
            for (int r = 0; r < 4; ++r) acc[r] *= __shfl(iw, 16 * w + 4 * g4 + r);
            accO8 = acc;
        }
        __syncthreads();
#pragma unroll
        for (int ti = 0; ti < 4; ++ti)
#pragma unroll
            for (int ks = 0; ks < 2; ++ks) {
                const bf16x8 a = *(const bf16x8*)(S_s + (16 * ti + i16) * 72 + 32 * ks + 8 * g4);
                const bf16x8 bb = *(const bf16x8*)(vT_s + (16 * w + i16) * 72 + 32 * ks + 8 * g4);
                accO[ti] = mfma16(a, bb, accO[ti]);
            }
        if (w < 4) {
#pragma unroll
            for (int ks = 0; ks < 2; ++ks) {
                const bf16x8 a = *(const bf16x8*)(S_s + (16 * w + i16) * 72 + 32 * ks + 8 * g4);
                const bf16x8 bb = *(const bf16x8*)(vT_s + (128 + i16) * 72 + 32 * ks + 8 * g4);
                accO8 = mfma16(a, bb, accO8);
            }
        }
#pragma unroll
        for (int ti = 0; ti < 4; ++ti)
#pragma unroll
            for (int r = 0; r < 4; ++r) out_s[(16 * ti + 4 * g4 + r) * 132 + 16 * w + i16] = accO[ti][r];
        if (w < 4 && i16 == 0) {
#pragma unroll
            for (int r = 0; r < 4; ++r) den_s[16 * w + 4 * g4 + r] = accO8[r];
        }
        __syncthreads();
        {
            float nv[16];
#pragma unroll
            for (int j = 0; j < 16; ++j) nv[j] = out_s[et * 132 + ec + j];
            u32x4 s0, s1;
            s0.x = pk2(nv[0], nv[1]); s0.y = pk2(nv[2], nv[3]); s0.z = pk2(nv[4], nv[5]); s0.w = pk2(nv[6], nv[7]);
            s1.x = pk2(nv[8], nv[9]); s1.y = pk2(nv[10], nv[11]); s1.z = pk2(nv[12], nv[13]); s1.w = pk2(nv[14], nv[15]);
            u16* dst = NDn + (tq + et) * 128 + ec;
            *(u32x4*)dst = s0; *(u32x4*)(dst + 8) = s1;
            if ((tid & 7) == 0) AUX[(tq + et) * 4 + 2] = den_s[et];
        }
#pragma unroll
        for (int ki = 0; ki < 8; ++ki) {
            f32x4 acc = Cacc[ki] * s_old;
#pragma unroll
            for (int ks = 0; ks < 2; ++ks) {
                const bf16x8 a = *(const bf16x8*)(wkT_s + (16 * ki + i16) * 72 + 32 * ks + 8 * g4);
                const bf16x8 bb = *(const bf16x8*)(vT_s + (16 * w + i16) * 72 + 32 * ks + 8 * g4);
                acc = mfma16(a, bb, acc);
            }
            Cacc[ki] = acc;
            u32x2 pkd; pkd.x = pk2(acc[0], acc[1]); pkd.y = pk2(acc[2], acc[3]);
            *(u32x2*)(CT_s + (16 * w + i16) * 136 + 16 * ki + 4 * g4) = pkd;
        }
        {
            f32x4 acc = Cacc8 * s_old;
#pragma unroll
            for (int ks = 0; ks < 2; ++ks) {
                const bf16x8 a = *(const bf16x8*)(wkT_s + (16 * w + i16) * 72 + 32 * ks + 8 * g4);
                const bf16x8 bb = *(const bf16x8*)(vT_s + (128 + i16) * 72 + 32 * ks + 8 * g4);
                acc = mfma16(a, bb, acc);
            }
            Cacc8 = acc;
            u32x2 pkd; pkd.x = pk2(acc[0], acc[1]); pkd.y = pk2(acc[2], acc[3]);
            *(u32x2*)(CT_s + (128 + i16) * 136 + 16 * w + 4 * g4) = pkd;
        }
        m_prev = m_new; Pc *= s_old;
        __syncthreads();
    }
    {
        float* E = (float*)(p.ws + WS_E) + (size_t)(item * 4 + grp) * 144 * 128;
#pragma unroll
        for (int ki = 0; ki < 8; ++ki) *(f32x4*)(E + (16 * w + i16) * 128 + 16 * ki + 4 * g4) = Cacc[ki];
        *(f32x4*)(E + (128 + i16) * 128 + 16 * w + 4 * g4) = Cacc8;
        if (tid == 0) ((float*)(p.ws + WS_DG))[item * 4 + grp] = Pc;
    }
}

__device__ __forceinline__ void mlstm_pass2(const Params& p, const int item, const int grp) {
    extern __shared__ __attribute__((aligned(16))) unsigned char lds[];
    const int tid = opaque_tid(), lane = tid & 63, w = tid >> 6, i16 = lane & 15, g4 = lane >> 4;
    const int b = item >> 2, hh = item & 3;
    u16* q_s = (u16*)(lds + 0); float* o2_s = (float*)(lds + 17408); float* den2_s = (float*)(lds + 51200); u16* CT_s = (u16*)(lds + 83200);
    const u16* P = (const u16*)(p.ws + WS_P); u16* Hm = (u16*)(p.ws + WS_HMIX);
    const u16* NDn = (const u16*)(p.ws + WS_NDNUM); const u16* Q2 = (const u16*)(p.ws + WS_Q2); const float* AUX = (const float*)(p.ws + WS_AUX);
    const size_t tokb = (size_t)b * 4096;
    const int et = tid >> 3, ec = (tid & 7) * 16;
    if (grp > 0) {
        float cf[3] = {0.f, 0.f, 0.f}; float run = 1.f;
#pragma unroll
        for (int gp = 2; gp >= 0; --gp) if (gp < grp) { cf[gp] = run; run *= __hip_atomic_load((float*)(p.ws + WS_DG) + item * 4 + gp, __ATOMIC_RELAXED, __HIP_MEMORY_SCOPE_AGENT); }
        const float* E = (const float*)(p.ws + WS_E) + (size_t)(item * 4) * 144 * 128;
        for (int i4 = tid; i4 < 144 * 128 / 4; i4 += 512) {
            const int i = i4 * 4;
            f32x4 sacc = {0.f, 0.f, 0.f, 0.f};
#pragma unroll
            for (int gp = 0; gp < 3; ++gp) if (gp < grp) sacc += cf[gp] * *(const f32x4*)(E + (size_t)gp * 144 * 128 + i);
            u32x2 w; w.x = pk2(sacc[0], sacc[1]); w.y = pk2(sacc[2], sacc[3]);
            *(u32x2*)(CT_s + (i >> 7) * 136 + (i & 127)) = w;
        }
    }
    __syncthreads();
    float gml[16];
#pragma unroll
    for (int j = 0; j < 16; ++j) gml[j] = p.g_ml[hh * 128 + ec + j];
    u32x4 qa_n, qb_n, nd_n[2], ov_n[2], zv_n[2]; f32x4 ax_n;
    {
        const int c = grp * 16;
        const size_t tokc = tokb + (size_t)c * 64, tq = (size_t)item * 4096 + (size_t)c * 64;
        const u16* qsrc = Q2 + (tq + et) * 128 + ec; qa_n = *(const u32x4*)qsrc; qb_n = *(const u32x4*)(qsrc + 8);
        ax_n = *(const f32x4*)(AUX + (tq + lane) * 4);
        const u16* ns = NDn + (tq + et) * 128 + ec; nd_n[0] = *(const u32x4*)ns; nd_n[1] = *(const u32x4*)(ns + 8);
        const u16* po = P + (tokc + et) * NP + 1536 + hh * 128 + ec; ov_n[0] = *(const u32x4*)po; ov_n[1] = *(const u32x4*)(po + 8);
        zv_n[0] = *(const u32x4*)(po + 512); zv_n[1] = *(const u32x4*)(po + 520);
    }
    for (int cl = 0; cl < 16; ++cl) {
        const int c = grp * 16 + cl;
        const size_t tokc = tokb + (size_t)c * 64;
        *(u32x4*)(q_s + et * 136 + ec) = qa_n; *(u32x4*)(q_s + et * 136 + ec + 8) = qb_n;
        const f32x4 ax = ax_n;
        u32x4 nd[2], ov[2], zv[2];
        nd[0] = nd_n[0]; nd[1] = nd_n[1]; ov[0] = ov_n[0]; ov[1] = ov_n[1]; zv[0] = zv_n[0]; zv[1] = zv_n[1];
        __syncthreads();
        if (cl + 1 < 16) {
            const size_t tokn = tokc + 64, tqn = (size_t)item * 4096 + (size_t)(c + 1) * 64;
            const u16* qsrc = Q2 + (tqn + et) * 128 + ec; qa_n = *(const u32x4*)qsrc; qb_n = *(const u32x4*)(qsrc + 8);
            ax_n = *(const f32x4*)(AUX + (tqn + lane) * 4);
            const u16* ns = NDn + (tqn + et) * 128 + ec; nd_n[0] = *(const u32x4*)ns; nd_n[1] = *(const u32x4*)(ns + 8);
            const u16* po = P + (tokn + et) * NP + 1536 + hh * 128 + ec; ov_n[0] = *(const u32x4*)po; ov_n[1] = *(const u32x4*)(po + 8);
            zv_n[0] = *(const u32x4*)(po + 512); zv_n[1] = *(const u32x4*)(po + 520);
        }
        asm volatile("" ::: "memory");
        if (grp > 0) {
#pragma unroll
            for (int ti = 0; ti < 4; ++ti) {
                f32x4 acc = {0.f, 0.f, 0.f, 0.f};
#pragma unroll
                for (int ks = 0; ks < 4; ++ks) {
                    const bf16x8 a = *(const bf16x8*)(q_s + (16 * ti + i16) * 136 + 32 * ks + 8 * g4);
                    const bf16x8 bb = *(const bf16x8*)(CT_s + (16 * w + i16) * 136 + 32 * ks + 8 * g4);
                    acc = mfma16(a, bb, acc);
                }
#pragma unroll
                for (int r = 0; r < 4; ++r) o2_s[(16 * ti + 4 * g4 + r) * 132 + 16 * w + i16] = acc[r] * __shfl(ax.x, 16 * ti + 4 * g4 + r);
            }
            if (w < 4) {
                f32x4 acc = {0.f, 0.f, 0.f, 0.f};
#pragma unroll
                for (int ks = 0; ks < 4; ++ks) {
                    const bf16x8 a = *(const bf16x8*)(q_s + (16 * w + i16) * 136 + 32 * ks + 8 * g4);
                    const bf16x8 bb = *(const bf16x8*)(CT_s + (128 + i16) * 136 + 32 * ks + 8 * g4);
                    acc = mfma16(a, bb, acc);
                }
#pragma unroll
                for (int r = 0; r < 4; ++r) { const float v = acc[r] * __shfl(ax.x, 16 * w + 4 * g4 + r); if (i16 == 0) den2_s[16 * w + 4 * g4 + r] = v; }
            }
        }
        __syncthreads();
        {
            const float den = __shfl(ax.z, et) + (grp > 0 ? den2_s[et] : 0.f);
            const float inv = 1.f / fmaxf(fabsf(den), __shfl(ax.y, et));
            float ho[16]; float ss = 0.f;
#pragma unroll
            for (int j = 0; j < 16; ++j) {
                const unsigned wn = nd[j >> 3][(j >> 1) & 3]; float num = (j & 1) ? bfhi(wn) : bflo(wn);
                if (grp > 0) num += o2_s[et * 132 + ec + j];
                const unsigned wv = ov[j >> 3][(j >> 1) & 3]; const float o = (j & 1) ? bfhi(wv) : bflo(wv);
                ho[j] = num * inv * __builtin_amdgcn_rcpf(1.f + __expf(-o)); ss += ho[j] * ho[j];
            }
            ss += __shfl_xor(ss, 1); ss += __shfl_xor(ss, 2); ss += __shfl_xor(ss, 4);
            const float rr = rsqrtf(ss * (1.f / 128.f) + 1e-6f);
            float ob[16];
#pragma unroll
            for (int j = 0; j < 16; ++j) {
                const unsigned wv = zv[j >> 3][(j >> 1) & 3]; const float z = (j & 1) ? bfhi(wv) : bflo(wv);
                ob[j] = ho[j] * rr * gml[j] * (z * __builtin_amdgcn_rcpf(1.f + __expf(-z)));
            }
            u32x4 s0, s1;
            s0.x = pk2(ob[0], ob[1]); s0.y = pk2(ob[2], ob[3]); s0.z = pk2(ob[4], ob[5]); s0.w = pk2(ob[6], ob[7]);
            s1.x = pk2(ob[8], ob[9]); s1.y = pk2(ob[10], ob[11]); s1.z = pk2(ob[12], ob[13]); s1.w = pk2(ob[14], ob[15]);
            u16* dst = Hm + (tokc + et) * 1024 + hh * 128 + ec;
            *(u32x4*)dst = s0; *(u32x4*)(dst + 8) = s1;
        }
        __syncthreads();
    }
}

__device__ __forceinline__ void sb_unit(const Params& p, const int unit, u16* vT, const int lane) {
    const u16* P = (const u16*)(p.ws + WS_P); u16* Hm = (u16*)(p.ws + WS_HMIX);
    const int qt = unit & 127, hd = (unit >> 7) & 7, b = unit >> 10;
    const int r = lane & 31, h = lane >> 5;
    const size_t tokb = (size_t)b * 4096;
    bf16x8 qf[4];
    { const u16* qrow = P + (tokb + qt * 32 + r) * NP + 2560 + hd * 64 + 8 * h;
#pragma unroll
      for (int ks = 0; ks < 4; ++ks) qf[ks] = *(const bf16x8*)(qrow + 16 * ks); }
    u32x4 Tw[2];
#pragma unroll
    for (int st = 0; st < 2; ++st) {
        unsigned tw[4];
#pragma unroll
        for (int e = 0; e < 8; e += 2) {
            const int j0 = 16 * st + 8 * (e >> 2) + 4 * h + (e & 3), j1 = j0 + 1;
            tw[e >> 1] = ((j0 > r) ? 0x3C00u : 0u) | ((j1 > r) ? 0x3C000000u : 0u);
        }
        Tw[st].x = tw[0]; Tw[st].y = tw[1]; Tw[st].z = tw[2]; Tw[st].w = tw[3];
    }
    f32x16 O0, O1;
#pragma unroll
    for (int i = 0; i < 16; ++i) { O0[i] = 0.f; O1[i] = 0.f; }
    float R2 = 0.f;
    const float SC = 0.125f * 1.4426950408889634f;
    const size_t tok = tokb + qt * 32 + r;
    u32x2 zz8[8];
#pragma unroll
    for (int i = 0; i < 8; ++i) zz8[i] = *(const u32x2*)(P + tok * NP + 4096 + hd * 64 + 32 * (i >> 2) + 8 * (i & 3) + 4 * h);
    asm volatile("" ::: "memory");
    bf16x8 kfn[4]; u32x4 vvn[4];
    { const u16* krow = P + (tokb + qt * 32 + r) * NP + 3072 + hd * 64 + 8 * h;
#pragma unroll
      for (int ks = 0; ks < 4; ++ks) kfn[ks] = *(const bf16x8*)(krow + 16 * ks);
      const u16* vrow = P + (tokb + qt * 32 + (lane >> 1)) * NP + 3584 + hd * 64 + (lane & 1) * 32;
#pragma unroll
      for (int i = 0; i < 4; ++i) vvn[i] = *(const u32x4*)(vrow + 8 * i); }
    bool have = true;
    for (int kb = qt; kb >= 0; --kb) {
        if (!have) {
            const u16* krow = P + (tokb + kb * 32 + r) * NP + 3072 + hd * 64 + 8 * h;
#pragma unroll
            for (int ks = 0; ks < 4; ++ks) kfn[ks] = *(const bf16x8*)(krow + 16 * ks);
            const u16* vrow = P + (tokb + kb * 32 + (lane >> 1)) * NP + 3584 + hd * 64 + (lane & 1) * 32;
#pragma unroll
            for (int i = 0; i < 4; ++i) vvn[i] = *(const u32x4*)(vrow + 8 * i);
        }
        bf16x8 kf[4]; u32x4 vv[4];
#pragma unroll
        for (int i = 0; i < 4; ++i) { kf[i] = kfn[i]; vv[i] = vvn[i]; }
        asm volatile("" ::: "memory");
        have = (kb > 0) && __any(R2 > -30.f);
        if (have) {
            const int s1 = (kb - 1) * 32;
            const u16* krow = P + (tokb + s1 + r) * NP + 3072 + hd * 64 + 8 * h;
#pragma unroll
            for (int ks = 0; ks < 4; ++ks) kfn[ks] = *(const bf16x8*)(krow + 16 * ks);
            const u16* vrow = P + (tokb + s1 + (lane >> 1)) * NP + 3584 + hd * 64 + (lane & 1) * 32;
#pragma unroll
            for (int i = 0; i < 4; ++i) vvn[i] = *(const u32x4*)(vrow + 8 * i);
        }
        asm volatile("" ::: "memory");
        f32x16 Z;
#pragma unroll
        for (int i = 0; i < 16; ++i) Z[i] = 0.f;
#pragma unroll
        for (int ks = 0; ks < 4; ++ks) Z = mfma32(kf[ks], qf[ks], Z);
        float lbv[16], lkv[16];
#pragma unroll
        for (int reg = 0; reg < 16; ++reg) {
            const float u = Z[reg] * SC;
            const float sp = __builtin_amdgcn_logf(1.f + __builtin_amdgcn_exp2f(-fabsf(u)));
            lbv[reg] = fminf(u, 0.f) - sp;
            lkv[reg] = lbv[reg] - u;
        }
        if (kb == qt) {
#pragma unroll
            for (int reg = 0; reg < 16; ++reg) {
                const int sl = (reg & 3) + 8 * (reg >> 2) + 4 * h;
                const bool valid = sl < r;
                lbv[reg] = valid ? lbv[reg] : -1e30f;
                lkv[reg] = valid ? lkv[reg] : 0.f;
            }
        }
        u32x4 lw[2];
#pragma unroll
        for (int st = 0; st < 2; ++st) {
            lw[st].x = pkh2(lkv[8 * st + 0], lkv[8 * st + 1]); lw[st].y = pkh2(lkv[8 * st + 2], lkv[8 * st + 3]);
            lw[st].z = pkh2(lkv[8 * st + 4], lkv[8 * st + 5]); lw[st].w = pkh2(lkv[8 * st + 6], lkv[8 * st + 7]);
        }
        f32x16 aft;
#pragma unroll
        for (int i = 0; i < 16; ++i) aft[i] = 0.f;
        aft = __builtin_amdgcn_mfma_f32_32x32x16_f16(__builtin_bit_cast(f16x8, Tw[0]), __builtin_bit_cast(f16x8, lw[0]), aft, 0, 0, 0);
        aft = __builtin_amdgcn_mfma_f32_32x32x16_f16(__builtin_bit_cast(f16x8, Tw[1]), __builtin_bit_cast(f16x8, lw[1]), aft, 0, 0, 0);
        const float tot = __shfl(aft[0] + lkv[0], r);
        bf16x8 pf[2];
#pragma unroll
        for (int st = 0; st < 2; ++st) {
            u32x4 pw;
            pw.x = pk2(__builtin_amdgcn_exp2f(lbv[8 * st + 0] + R2 + aft[8 * st + 0]), __builtin_amdgcn_exp2f(lbv[8 * st + 1] + R2 + aft[8 * st + 1]));
            pw.y = pk2(__builtin_amdgcn_exp2f(lbv[8 * st + 2] + R2 + aft[8 * st + 2]), __builtin_amdgcn_exp2f(lbv[8 * st + 3] + R2 + aft[8 * st + 3]));
            pw.z = pk2(__builtin_amdgcn_exp2f(lbv[8 * st + 4] + R2 + aft[8 * st + 4]), __builtin_amdgcn_exp2f(lbv[8 * st + 5] + R2 + aft[8 * st + 5]));
            pw.w = pk2(__builtin_amdgcn_exp2f(lbv[8 * st + 6] + R2 + aft[8 * st + 6]), __builtin_amdgcn_exp2f(lbv[8 * st + 7] + R2 + aft[8 * st + 7]));
            pf[st] = __builtin_bit_cast(bf16x8, pw);
        }
        {
            const int sv = lane >> 1, db = (lane & 1) * 32;
#pragma unroll
            for (int i = 0; i < 4; ++i)
#pragma unroll
                for (int wq = 0; wq < 4; ++wq) {
                    const unsigned x = vv[i][wq]; const int d = db + 8 * i + 2 * wq;
                    vT[d * 40 + sv] = (u16)(x & 0xffffu); vT[(d + 1) * 40 + sv] = (u16)(x >> 16);
                }
        }
        asm volatile("s_waitcnt lgkmcnt(0)" ::: "memory");
#pragma unroll
        for (int st = 0; st < 2; ++st) {
            const u32x2 a0 = *(const u32x2*)(vT + r * 40 + 16 * st + 4 * h), a1 = *(const u32x2*)(vT + r * 40 + 16 * st + 8 + 4 * h);
            const u32x2 b0 = *(const u32x2*)(vT + (32 + r) * 40 + 16 * st + 4 * h), b1 = *(const u32x2*)(vT + (32 + r) * 40 + 16 * st + 8 + 4 * h);
            u32x4 fa, fb; fa.x = a0.x; fa.y = a0.y; fa.z = a1.x; fa.w = a1.y; fb.x = b0.x; fb.y = b0.y; fb.z = b1.x; fb.w = b1.y;
            O0 = mfma32(__builtin_bit_cast(bf16x8, fa), pf[st], O0);
            O1 = mfma32(__builtin_bit_cast(bf16x8, fb), pf[st], O1);
        }
        asm volatile("s_waitcnt lgkmcnt(0)" ::: "memory");
        R2 += tot;
        if (!__any(R2 > -64.f)) break;
    }
#pragma unroll
    for (int dt = 0; dt < 2; ++dt)
#pragma unroll
        for (int q4 = 0; q4 < 4; ++q4) {
            const int d0 = 32 * dt + 8 * q4 + 4 * h;
            const u32x2 zz = zz8[4 * dt + q4];
            float o[4];
#pragma unroll
            for (int e = 0; e < 4; ++e) {
                const float ov = dt ? O1[4 * q4 + e] : O0[4 * q4 + e];
                const unsigned wv = (e < 2) ? zz.x : zz.y; const float z = (e & 1) ? bfhi(wv) : bflo(wv);
                o[e] = ov * (z * __builtin_amdgcn_rcpf(1.f + __expf(-z)));
            }
            u32x2 st; st.x = pk2(o[0], o[1]); st.y = pk2(o[2], o[3]);
            *(u32x2*)(Hm + tok * 1024 + 512 + hd * 64 + d0) = st;
        }
}

__device__ __forceinline__ void phase2a(const Params& p) {
    for (int u = blockIdx.x; u < 256; u += gridDim.x) { mlstm_pass1(p, u >> 2, u & 3); __syncthreads(); }
}
__device__ __forceinline__ void phase2b(const Params& p) {
    extern __shared__ __attribute__((aligned(16))) unsigned char lds[];
    for (int u = blockIdx.x; u < 256; u += gridDim.x) { mlstm_pass2(p, u >> 2, u & 3); __syncthreads(); }
    const int tid2 = opaque_tid(), lane = tid2 & 63, wave = tid2 >> 6;
    u16* vT = (u16*)(lds + wave * 5120);
    for (int u = blockIdx.x * 8 + wave; u < 16384; u += gridDim.x * 8) sb_unit(p, u, vT, lane);
}

__device__ __forceinline__ void phase4(const Params& p) {
    const int tid = opaque_tid(), lane = tid & 63, wave = tid >> 6;
    const float* modp = (const float*)(p.ws + WS_MOD);
    const u16* Y = (const u16*)(p.ws + WS_Y);
    for (int tb = blockIdx.x * 8 + wave; tb < 2048; tb += gridDim.x * 8) {
        const int tok0 = tb * 32, b = tok0 >> 12;
        f32x4 gg[4];
#pragma unroll
        for (int j = 0; j < 4; ++j) { const int k = lane * 4 + 256 * j; gg[j] = *(const f32x4*)(modp + b * 3072 + 2048 + k) * *(const f32x4*)(p.g_post + k); }
        u32x2 yn[4]; f32x4 xn[4];
#pragma unroll
        for (int j = 0; j < 4; ++j) { yn[j] = *(const u32x2*)(Y + (size_t)tok0 * 1024 + lane * 4 + 256 * j); xn[j] = __builtin_nontemporal_load((const f32x4*)(p.x + (size_t)tok0 * 1024 + lane * 4 + 256 * j)); }
        for (int t = 0; t < 32; ++t) {
            const size_t tok = (size_t)tok0 + t;
            f32x4 y[4], xv[4]; float ss = 0.f;
#pragma unroll
            for (int j = 0; j < 4; ++j) { const u32x2 w = yn[j]; xv[j] = xn[j];
                y[j] = (f32x4){bflo(w.x), bfhi(w.x), bflo(w.y), bfhi(w.y)}; ss += (y[j].x * y[j].x + y[j].y * y[j].y) + (y[j].z * y[j].z + y[j].w * y[j].w); }
            if (t + 1 < 32) {
#pragma unroll
                for (int j = 0; j < 4; ++j) { yn[j] = *(const u32x2*)(Y + (tok + 1) * 1024 + lane * 4 + 256 * j); xn[j] = __builtin_nontemporal_load((const f32x4*)(p.x + (tok + 1) * 1024 + lane * 4 + 256 * j)); }
            }
            ss = wave_sum(ss); const float r = rsqrtf(ss * (1.f / 1024.f) + 1e-6f);
#pragma unroll
            for (int j = 0; j < 4; ++j) __builtin_nontemporal_store(xv[j] + gg[j] * (y[j] * r), (f32x4*)(p.out + tok * 1024 + lane * 4 + 256 * j));
        }
    }
}

DEVI unsigned bar_ld(unsigned* q) { return __hip_atomic_load(q, __ATOMIC_RELAXED, __HIP_MEMORY_SCOPE_AGENT); }
DEVI unsigned bar_add(unsigned* q, unsigned v) { return __hip_atomic_fetch_add(q, v, __ATOMIC_RELAXED, __HIP_MEMORY_SCOPE_AGENT); }
DEVI unsigned xcc_id() { return (unsigned)__builtin_amdgcn_s_getreg((3 << 11) | 20) & 0xFu; }
DEVI void grid_sync0(const Params& p, cg::grid_group& g) {
    asm volatile("s_waitcnt vmcnt(0) lgkmcnt(0)" ::: "memory");
    g.sync();
    if (threadIdx.x == 0) { __builtin_amdgcn_fence(__ATOMIC_ACQUIRE, "agent"); asm volatile("s_waitcnt vmcnt(0)" ::: "memory"); }
    __syncthreads();
}
DEVI void grid_sync(const Params& p, const int idx, const unsigned xcc, const unsigned nloc, const unsigned nxcc) {
    asm volatile("s_waitcnt vmcnt(0) lgkmcnt(0)" ::: "memory");
    __syncthreads();
    if (threadIdx.x == 0) {
        unsigned* bar = (unsigned*)(p.ws + WS_BAR);
        unsigned* xsub = bar + 1024 + (16 * idx + xcc) * 64; unsigned* top = bar + 9216 + 64 * idx;
        const unsigned old = bar_add(xsub, 1u);
        if (old == nloc - 1u) {
            __builtin_amdgcn_fence(__ATOMIC_RELEASE, "agent");
            asm volatile("s_waitcnt vmcnt(0)" ::: "memory");
            bar_add(top, 1u);
        }
        while (bar_ld(top) < nxcc) __builtin_amdgcn_s_sleep(1);
        __builtin_amdgcn_fence(__ATOMIC_ACQUIRE, "agent");
        asm volatile("s_waitcnt vmcnt(0)" ::: "memory");
    }
    __syncthreads();
}
__global__ void __launch_bounds__(512) hymba_fwd(Params p) {
    cg::grid_group grid = cg::this_grid();
    const unsigned xcc = xcc_id();
    if (threadIdx.x == 0) bar_add((unsigned*)(p.ws + WS_BAR) + 64 * xcc, 1u);
    phase0(p);
    if (gridDim.x == 0x7fffffffu) grid_sync0(p, grid);
    if (threadIdx.x == 0) {
        unsigned* bar = (unsigned*)(p.ws + WS_BAR);
        for (;;) { unsigned tot = 0; for (int j = 0; j < 16; ++j) tot += bar_ld(bar + 64 * j); if (tot >= gridDim.x) break; __builtin_amdgcn_s_sleep(1); }
    }
    __syncthreads();
    unsigned nloc, nxcc = 0;
    { unsigned* bar = (unsigned*)(p.ws + WS_BAR); nloc = bar_ld(bar + 64 * xcc);
      for (int j = 0; j < 16; ++j) nxcc += (bar_ld(bar + 64 * j) != 0u) ? 1u : 0u; }
    grid_sync(p, 0, xcc, nloc, nxcc);
    phase1a(p);
    grid_sync(p, 1, xcc, nloc, nxcc);
    gemm_phase((const u16*)(p.ws + WS_H), (const u16*)(p.ws + WS_WTIN), (u16*)(p.ws + WS_P), 18, NP);
    grid_sync(p, 2, xcc, nloc, nxcc);
    phase2a(p);
    grid_sync(p, 5, xcc, nloc, nxcc);
    phase2b(p);
    grid_sync(p, 3, xcc, nloc, nxcc);
    gemm_phase((const u16*)(p.ws + WS_HMIX), (const u16*)(p.ws + WS_WTOUT), (u16*)(p.ws + WS_Y), 4, 1024);
    grid_sync(p, 4, xcc, nloc, nxcc);
    phase4(p);
}

extern "C" void kernel_launch(void* const* d_in, const int* in_sizes, int n_in, void* d_out, int out_size, void* d_ws, size_t ws_size, hipStream_t stream) {
    static int grid_blocks = 0;
    if (!grid_blocks) {
        if (n_in != 13 || out_size != NTOK * DM || ws_size < WS_END) { fprintf(stderr, "kernel_launch: unexpected shapes (n_in %d out %d ws %zu)\n", n_in, out_size, ws_size); grid_blocks = -1; return; }
        int dev = 0, cus = 0, per_cu = 0;
        hipGetDevice(&dev);
        hipDeviceGetAttribute(&cus, hipDeviceAttributeMultiprocessorCount, dev);
        if (hipFuncSetAttribute((const void*)hymba_fwd, hipFuncAttributeMaxDynamicSharedMemorySize, LDS_BYTES) != hipSuccess) fprintf(stderr, "kernel_launch: hipFuncSetAttribute failed\n");
        if (hipOccupancyMaxActiveBlocksPerMultiprocessor(&per_cu, (const void*)hymba_fwd, 512, LDS_BYTES) != hipSuccess || per_cu < 1) { fprintf(stderr, "kernel_launch: occupancy query says %d\n", per_cu); per_cu = 1; }
        (void)hipGetLastError();
        grid_blocks = cus * 1;
    }
    if (grid_blocks < 0) return;
    Params p{};
    p.x = (const float*)d_in[0]; p.c = (const float*)d_in[1]; p.w_ada = (const float*)d_in[2]; p.b_ada = (const float*)d_in[3]; p.g_pre = (const float*)d_in[4];
    p.w_in = (const float*)d_in[5]; p.b_ig = (const float*)d_in[6]; p.b_fg = (const float*)d_in[7]; p.conv_w = (const float*)d_in[8]; p.conv_b = (const float*)d_in[9];
    p.g_ml = (const float*)d_in[10]; p.w_out = (const float*)d_in[11]; p.g_post = (const float*)d_in[12];
    p.out = (float*)d_out; p.ws = (unsigned char*)d_ws;
    if (hipMemsetAsync((unsigned char*)d_ws + WS_BAR, 0, 40960, stream) != hipSuccess) fprintf(stderr, "kernel_launch: memset of the barrier words failed\n");
    void* args[] = {&p};
    hipError_t e = hipLaunchCooperativeKernel((const void*)hymba_fwd, dim3(grid_blocks), dim3(512), args, LDS_BYTES, stream);
    if (e != hipSuccess) fprintf(stderr, "cooperative launch failed: %s (grid %d)\n", hipGetErrorString(e), grid_blocks);
}
```

```cpp
#include <hip/hip_runtime.h>
#include <hip/hip_cooperative_groups.h>
#include <cstdio>
#include <cstdint>
namespace cg = cooperative_groups;

typedef unsigned short u16;
typedef short bf16x8 __attribute__((ext_vector_type(8)));
typedef float f32x4 __attribute__((ext_vector_type(4)));
typedef float f32x16 __attribute__((ext_vector_type(16)));
typedef unsigned u32x4 __attribute__((ext_vector_type(4)));
typedef unsigned u32x2 __attribute__((ext_vector_type(2)));
#define DEVI __device__ __forceinline__

constexpr int NTOK = 65536, DM = 1024, NP = 4608;
constexpr size_t WS_WTIN = 0;
constexpr size_t WS_WTOUT = 9437184;
constexpr size_t WS_WG = 11534336;
constexpr size_t WS_MOD = 11567104;
constexpr size_t WS_BAR = 13860864;
constexpr size_t WS_GATES = 11763712;
constexpr size_t WS_H = 16777216;
constexpr size_t WS_P = WS_H + 134217728;
constexpr size_t WS_HMIX = WS_P + 603979776;
constexpr size_t WS_Y = WS_HMIX + 134217728;
constexpr size_t WS_END = WS_Y + 134217728;
constexpr size_t WS_NDNUM = WS_H;
constexpr size_t WS_Q2 = WS_H + 67108864;
constexpr size_t WS_E = WS_Y;
constexpr size_t WS_AUX = WS_Y + 33554432;
constexpr size_t WS_DG = WS_Y + 41943040;
constexpr int LDS_BYTES = 131072;

struct Params {
    const float *x, *c, *w_ada, *b_ada, *g_pre, *w_in, *b_ig, *b_fg, *conv_w, *conv_b, *g_ml, *w_out, *g_post;
    float* out;
    unsigned char* ws;
};

DEVI int opaque_tid() { int t = threadIdx.x; asm volatile("" : "+v"(t)); return t; }
typedef __bf16 bf16x2_t __attribute__((ext_vector_type(2)));
typedef _Float16 f16x2_t __attribute__((ext_vector_type(2)));
typedef _Float16 f16x8 __attribute__((ext_vector_type(8)));
typedef float f32x2_t __attribute__((ext_vector_type(2)));
DEVI unsigned pk2(float lo, float hi) { const f32x2_t v = {lo, hi}; const bf16x2_t b = __builtin_convertvector(v, bf16x2_t); return __builtin_bit_cast(unsigned, b); }
DEVI unsigned pkh2(float lo, float hi) { const f32x2_t v = {lo, hi}; const f16x2_t b = __builtin_convertvector(v, f16x2_t); return __builtin_bit_cast(unsigned, b); }
DEVI float bflo(unsigned w) { return __uint_as_float(w << 16); }
DEVI float bfhi(unsigned w) { return __uint_as_float(w & 0xffff0000u); }
DEVI float wave_sum(float v) {
#pragma unroll
    for (int o = 1; o < 64; o <<= 1) v += __shfl_xor(v, o);
    return v;
}
DEVI float wave_max(float v) {
#pragma unroll
    for (int o = 1; o < 64; o <<= 1) v = fmaxf(v, __shfl_xor(v, o));
    return v;
}
DEVI int perm32(int rho) { const int n = rho >> 4, i = rho & 15; return 8 * (i >> 2) + 4 * n + (i & 3); }
DEVI f32x4 mfma16(bf16x8 a, bf16x8 b, f32x4 c) { return __builtin_amdgcn_mfma_f32_16x16x32_bf16(a, b, c, 0, 0, 0); }
DEVI f32x16 mfma32(bf16x8 a, bf16x8 b, f32x16 c) { return __builtin_amdgcn_mfma_f32_32x32x16_bf16(a, b, c, 0, 0, 0); }

DEVI void p0_transpose_item(const float* __restrict__ W, const int ldw, const int srccol0, u16* __restrict__ dst, const int n0, const int k0, float* scr, const int lane) {
    { float tv[32];
#pragma unroll
      for (int i = 0; i < 32; ++i) tv[i] = W[(size_t)(k0 + 2 * i + (lane >> 5)) * ldw + srccol0 + (lane & 31)];
#pragma unroll
      for (int i = 0; i < 32; ++i) scr[(2 * i + (lane >> 5)) * 33 + (lane & 31)] = tv[i]; }
    asm volatile("s_waitcnt lgkmcnt(0)" ::: "memory");
    const int c = lane & 7;
#pragma unroll
    for (int j = 0; j < 4; ++j) {
        const int slot = (lane >> 3) + 8 * j, cl = perm32(slot);
        const float* sp = scr + (8 * c) * 33 + cl;
        u32x4 o; o.x = pk2(sp[0], sp[33]); o.y = pk2(sp[2 * 33], sp[3 * 33]); o.z = pk2(sp[4 * 33], sp[5 * 33]); o.w = pk2(sp[6 * 33], sp[7 * 33]);
        *(u32x4*)(dst + (size_t)(n0 + slot) * 1024 + k0 + 8 * c) = o;
    }
    asm volatile("s_waitcnt lgkmcnt(0)" ::: "memory");
}
__device__ __forceinline__ void phase0(const Params& p) {
    extern __shared__ __attribute__((aligned(16))) unsigned char lds[];
    const int tid = opaque_tid(), lane = tid & 63, wave = tid >> 6;
    float* modp = (float*)(p.ws + WS_MOD);
    for (int job = blockIdx.x; job < 96; job += gridDim.x) {
        float* sc = (float*)lds; float* red = (float*)(lds + 65536);
        for (int i = tid; i < 16384; i += 512) { const float v = p.c[i]; sc[i] = v / (1.f + expf(-v)); }
        __syncthreads();
        const int jl = tid & 31, kq = tid >> 5, j0 = job * 32;
        float acc[16];
#pragma unroll
        for (int b = 0; b < 16; ++b) acc[b] = 0.f;
#pragma unroll 1
        for (int kb = 0; kb < 64; kb += 16) {
            float wv[16];
#pragma unroll
            for (int kk = 0; kk < 16; ++kk) wv[kk] = p.w_ada[(size_t)(kq * 64 + kb + kk) * 3072 + j0 + jl];
#pragma unroll
            for (int kk = 0; kk < 16; ++kk) {
                const int k = kq * 64 + kb + kk;
#pragma unroll
                for (int b = 0; b < 16; ++b) acc[b] += sc[b * 1024 + k] * wv[kk];
            }
        }
#pragma unroll
        for (int b = 0; b < 16; ++b) red[(kq * 16 + b) * 32 + jl] = acc[b];
        __syncthreads();
        { const int b = tid >> 5; float sacc = p.b_ada[j0 + jl];
          for (int q = 0; q < 16; ++q) sacc += red[(q * 16 + b) * 32 + jl];
          modp[b * 3072 + j0 + jl] = sacc; }
        __syncthreads();
    }
    if (blockIdx.x == (gridDim.x > 100 ? 100 : 0)) {
        float* Wg = (float*)(p.ws + WS_WG);
        for (int i = tid; i < 8192; i += 512) { const int g = i & 7, k = i >> 3; Wg[g * 1024 + k] = p.w_in[(size_t)k * 4616 + 2560 + g]; }
    }
    {
        float* scr = (float*)(lds + wave * 8448);
        const int NW = gridDim.x * 8, gw = NW - 1 - (blockIdx.x * 8 + wave);
        for (int it = gw; it < 2816; it += NW) {
            if (it < 2304) { const int nb = it >> 4, kb = it & 15, n0 = nb * 32;
                p0_transpose_item(p.w_in, 4616, n0 < 2560 ? n0 : n0 + 8, (u16*)(p.ws + WS_WTIN), n0, kb * 64, scr, lane); }
            else { const int r2 = it - 2304, nb = r2 >> 4, kb = r2 & 15, n0 = nb * 32;
                p0_transpose_item(p.w_out, 1024, n0, (u16*)(p.ws + WS_WTOUT), n0, kb * 64, scr, lane); }
        }
    }
}

__device__ __forceinline__ void phase1a(const Params& p) {
    extern __shared__ __attribute__((aligned(16))) unsigned char lds[];
    const int tid = opaque_tid(), lane = tid & 63, wave = tid >> 6;
    float* wg_s = (float*)lds;
    { const float* Wg = (const float*)(p.ws + WS_WG); for (int i = tid; i < 8192; i += 512) wg_s[i] = Wg[i]; }
    __syncthreads();
    const float* modp = (const float*)(p.ws + WS_MOD);
    u16* H = (u16*)(p.ws + WS_H); float* gates = (float*)(p.ws + WS_GATES);
    for (int tb = blockIdx.x * 8 + wave; tb < 2048; tb += gridDim.x * 8) {
        const int tok0 = tb * 32, b = tok0 >> 12;
        f32x4 gs[4], sh[4];
#pragma unroll
        for (int j = 0; j < 4; ++j) { const int k = lane * 4 + 256 * j; const f32x4 g = *(const f32x4*)(p.g_pre + k); const f32x4 s = *(const f32x4*)(modp + b * 3072 + 1024 + k);
            sh[j] = *(const f32x4*)(modp + b * 3072 + k); gs[j] = g * (1.f + s); }
        float bias = 0.f; if (lane < 4) bias = p.b_ig[lane]; else if (lane < 8) bias = p.b_fg[lane - 4];
        f32x4 vn[4];
#pragma unroll
        for (int j = 0; j < 4; ++j) vn[j] = __builtin_nontemporal_load((const f32x4*)(p.x + (size_t)tok0 * 1024 + lane * 4 + 256 * j));
        for (int t = 0; t < 32; ++t) {
            const size_t tok = (size_t)tok0 + t;
            f32x4 v[4]; float ss = 0.f;
#pragma unroll
            for (int j = 0; j < 4; ++j) { v[j] = vn[j]; ss += (v[j].x * v[j].x + v[j].y * v[j].y) + (v[j].z * v[j].z + v[j].w * v[j].w); }
            if (t + 1 < 32) {
#pragma unroll
                for (int j = 0; j < 4; ++j) vn[j] = __builtin_nontemporal_load((const f32x4*)(p.x + (tok + 1) * 1024 + lane * 4 + 256 * j));
            }
            ss = wave_sum(ss); const float r = rsqrtf(ss * (1.f / 1024.f) + 1e-6f);
            float part[8];
#pragma unroll
            for (int g = 0; g < 8; ++g) part[g] = 0.f;
#pragma unroll
            for (int j = 0; j < 4; ++j) {
                const f32x4 hv = v[j] * r * gs[j] + sh[j];
                u32x2 o; o.x = pk2(hv.x, hv.y); o.y = pk2(hv.z, hv.w);
                *(u32x2*)(H + tok * 1024 + lane * 4 + 256 * j) = o;
#pragma unroll
                for (int g = 0; g < 8; ++g) { const f32x4 w = *(const f32x4*)(wg_s + g * 1024 + lane * 4 + 256 * j); part[g] += (hv.x * w.x + hv.y * w.y) + (hv.z * w.z + hv.w * w.w); }
            }
#pragma unroll
            for (int g = 0; g < 8; ++g) part[g] = wave_sum(part[g]);
            float ov = part[0];
#pragma unroll
            for (int g = 1; g < 8; ++g) if (lane == g) ov = part[g];
            if (lane < 8) gates[tok * 8 + lane] = ov + bias;
        }
    }
}

constexpr int BM = 256, BK = 64, HALF = 128, HT = HALF * BK;
DEVI int lds_byte(int r, int c) { const int st = (r >> 4) * 2 + (c >> 5), rr = r & 15, cc = c & 31, ob = rr * 64 + cc * 2; return st * 1024 + (ob ^ (((ob >> 9) & 1) << 5)); }
DEVI void stage_rc(int b, int& R, int& C) { const int st = b / 1024, sb = b % 1024, swz = sb ^ (((sb >> 9) & 1) << 5); R = (st >> 1) * 16 + swz / 64; C = (st & 1) * 32 + (swz % 64) / 2; }

DEVI void gemm_unit(const int L, const int nM, const int nN, const int nwg, int& pm, int& pn) {
    int wgid = L;
    { const int q = nwg / 8, r = nwg % 8, xcd = wgid % 8, off = wgid / 8; wgid = (xcd < r ? xcd * (q + 1) : r * (q + 1) + (xcd - r) * q) + off; }
    const int nig = 8 * nN, gid = wgid / nig, fm = gid * 8, gsz = min(nM - fm, 8);
    pm = fm + ((wgid % nig) % gsz); pn = (wgid % nig) / gsz;
}
__device__ __forceinline__ void gemm_phase(const u16* __restrict__ A, const u16* __restrict__ Bt, u16* __restrict__ Out, const int nN, const int ldo) {
    extern __shared__ __attribute__((aligned(16))) unsigned char lds[];
    constexpr int K = 1024;
    const int tid = opaque_tid();
    u16* shm = (u16*)lds;
#define SA(b, h) (shm + ((b) * 2 + (h)) * HT)
#define SB(b, h) (shm + (4 + (b) * 2 + (h)) * HT)
#define STAGE(Pp, BASE, br, kt) do { const u16* _gb = (BASE) + ((size_t)(br) * K + (size_t)(kt) * BK); \
      __builtin_amdgcn_global_load_lds((const unsigned*)(_gb + so0), (unsigned*)((char*)(Pp) + tid * 16), 16, 0, 0); \
      __builtin_amdgcn_global_load_lds((const unsigned*)(_gb + 64 * K + so0), (unsigned*)((char*)(Pp) + tid * 16 + 8192), 16, 0, 0); } while (0)
#define LDA(dst, b, h) for (int m = 0; m < 4; ++m) for (int k = 0; k < 2; ++k) \
    dst[m][k] = *reinterpret_cast<const bf16x8*>((char*)SA(b, h) + lds_byte(wr * 64 + m * 16 + fr, k * 32 + fq * 8))
#define LDB(dst, b, h) for (int n = 0; n < 2; ++n) for (int k = 0; k < 2; ++k) \
    dst[n][k] = *reinterpret_cast<const bf16x8*>((char*)SB(b, h) + lds_byte(wc * 32 + n * 16 + fr, k * 32 + fq * 8))
#define MMA(ai, bj, At_, Bt_) do { __builtin_amdgcn_s_setprio(1); \
    for (int m = 0; m < 4; ++m) for (int n = 0; n < 2; ++n) for (int k = 0; k < 2; ++k) \
      acc[ai][bj][m][n] = __builtin_amdgcn_mfma_f32_16x16x32_bf16(Bt_[n][k], At_[m][k], acc[ai][bj][m][n], 0, 0, 0); \
    __builtin_amdgcn_s_setprio(0); } while (0)
#define WAIT_V(n) asm volatile("s_waitcnt vmcnt(" #n ")" ::: "memory")
#define WAIT_L(n) asm volatile("s_waitcnt lgkmcnt(" #n ")" ::: "memory")
#define BAR __builtin_amdgcn_s_barrier()
#define SCHED __builtin_amdgcn_sched_barrier(0)
#define EPILOGUE(ROW, COL) do { \
    _Pragma("unroll") for (int ai = 0; ai < 2; ++ai) \
    _Pragma("unroll") for (int m = 0; m < 4; ++m) { \
        u16* rowp = Out + (size_t)((ROW) + ai * HALF + wr * 64 + m * 16 + fr) * ldo + (COL) + wc * 32 + 8 * fq; \
        _Pragma("unroll") for (int bj = 0; bj < 2; ++bj) { \
            const f32x4 v0 = acc[ai][bj][m][0], v1 = acc[ai][bj][m][1]; \
            u32x4 w; w.x = pk2(v0[0], v0[1]); w.y = pk2(v0[2], v0[3]); w.z = pk2(v1[0], v1[1]); w.w = pk2(v1[2], v1[3]); \
            *(u32x4*)(rowp + bj * HALF) = w; \
        } } } while (0)
    const int wid = tid >> 6, lane = tid & 63, wr = wid >> 2, wc = wid & 3, fr = lane & 15, fq = lane >> 4;
    unsigned so0;
    { int r_, c_; stage_rc(tid * 16, r_, c_); so0 = (unsigned)(r_ * K + c_); }
    constexpr int nt = K / BK;
    const int nM = NTOK / BM, nwg = nM * nN, G = gridDim.x;
    int L = blockIdx.x;
    if (L < nwg) {
        int brow, bcol;
        { int pm, pn; gemm_unit(L, nM, nN, nwg, pm, pn); brow = pm * BM; bcol = pn * BM; }
        f32x4 acc[2][2][4][2] = {};
        bf16x8 At[4][2], B0[2][2], B1[2][2];
        STAGE(SB(0, 0), Bt, bcol, 0); STAGE(SA(0, 0), A, brow, 0);
        STAGE(SB(0, 1), Bt, bcol + HALF, 0); STAGE(SA(0, 1), A, brow + HALF, 0);
        if (wr == 1) BAR;
        WAIT_V(4); BAR;
        STAGE(SB(1, 0), Bt, bcol, 1); STAGE(SA(1, 0), A, brow, 1); STAGE(SB(1, 1), Bt, bcol + HALF, 1);
        WAIT_V(6); BAR;
        for (;;) {
            const bool last = (L + G >= nwg);
            int nbrow = brow, nbcol = bcol;
            if (!last) { int qm, qn; gemm_unit(L + G, nM, nN, nwg, qm, qn); nbrow = qm * BM; nbcol = qn * BM; }
            const int tend = last ? nt - 2 : nt;
            for (int t = 0; t < tend; t += 2) {
                const bool bnd = (t == nt - 2);
                const int r2 = bnd ? nbrow : brow, c2 = bnd ? nbcol : bcol, k2 = bnd ? 0 : t + 2, k3 = bnd ? 1 : t + 3;
                LDB(B0, 0, 0); SCHED; LDA(At, 0, 0); STAGE(SA(1, 1), A, brow + HALF, t + 1);
                WAIT_L(8); BAR; WAIT_L(0); MMA(0, 0, At, B0); BAR; SCHED;
                LDB(B1, 0, 1); STAGE(SB(0, 0), Bt, c2, k2);
                BAR; WAIT_L(0); MMA(0, 1, At, B1); BAR;
                LDA(At, 0, 1); STAGE(SA(0, 0), A, r2, k2);
                BAR; WAIT_L(0); MMA(1, 0, At, B0); BAR; SCHED;
                STAGE(SB(0, 1), Bt, c2 + HALF, k2);
                WAIT_V(6); BAR; MMA(1, 1, At, B1); BAR;
                LDB(B0, 1, 0); SCHED; LDA(At, 1, 0); STAGE(SA(0, 1), A, r2 + HALF, k2);
                WAIT_L(8); BAR; WAIT_L(0); MMA(0, 0, At, B0); BAR; SCHED;
                LDB(B1, 1, 1); STAGE(SB(1, 0), Bt, c2, k3);
                BAR; WAIT_L(0); MMA(0, 1, At, B1); BAR;
                LDA(At, 1, 1); STAGE(SA(1, 0), A, r2, k3);
                BAR; WAIT_L(0); MMA(1, 0, At, B0); BAR; SCHED;
                STAGE(SB(1, 1), Bt, c2 + HALF, k3);
                WAIT_V(6); BAR; MMA(1, 1, At, B1); BAR;
            }
            if (last) break;
            EPILOGUE(brow, bcol);
#pragma unroll
            for (int ai = 0; ai < 2; ++ai)
#pragma unroll
                for (int bj = 0; bj < 2; ++bj)
#pragma unroll
                    for (int m = 0; m < 4; ++m)
#pragma unroll
                        for (int n = 0; n < 2; ++n) acc[ai][bj][m][n] = (f32x4){0.f, 0.f, 0.f, 0.f};
            brow = nbrow; bcol = nbcol; L += G;
        }
        { LDB(B0, 0, 0); LDA(At, 0, 0); STAGE(SA(1, 1), A, brow + HALF, nt - 1);
          BAR; WAIT_L(0); MMA(0, 0, At, B0); BAR;
          LDB(B1, 0, 1); BAR; WAIT_L(0); MMA(0, 1, At, B1); BAR;
          LDA(At, 0, 1); WAIT_V(4); BAR; WAIT_L(0); MMA(1, 0, At, B0); MMA(1, 1, At, B1); BAR; }
        { LDB(B0, 1, 0); LDA(At, 1, 0); WAIT_V(2); BAR; WAIT_L(0); MMA(0, 0, At, B0); BAR;
          LDB(B1, 1, 1); WAIT_V(0); BAR; WAIT_L(0); MMA(0, 1, At, B1); BAR;
          LDA(At, 1, 1); BAR; WAIT_L(0); MMA(1, 0, At, B0); MMA(1, 1, At, B1); BAR; }
        if (wr == 0) BAR;
        EPILOGUE(brow, bcol);
    }
    __syncthreads();
#undef SA
#undef SB
#undef STAGE
#undef LDA
#undef LDB
#undef MMA
#undef EPILOGUE
}

__device__ __forceinline__ void mlstm_pass1(const Params& p, const int item, const int grp) {
    extern __shared__ __attribute__((aligned(16))) unsigned char lds[];
    const int tid = opaque_tid(), lane = tid & 63, w = tid >> 6, i16 = lane & 15, g4 = lane >> 4;
    const int b = item >> 2, hh = item & 3;
    u16* q_s = (u16*)(lds + 0); u16* k_s = (u16*)(lds + 17408); float* out_s = (float*)lds;
    u16* wkT_s = (u16*)(lds + 34816); u16* vT_s = (u16*)(lds + 53248); u16* S_s = (u16*)(lds + 73984);
    u16* CT_s = (u16*)(lds + 83200); float* den_s = (float*)(lds + 122368); float* a_s = (float*)(lds + 122368 + 256); float* ml_s = a_s + 64;
    const u16* P = (const u16*)(p.ws + WS_P); const float* gates = (const float*)(p.ws + WS_GATES);
    u16* NDn = (u16*)(p.ws + WS_NDNUM); u16* Q2 = (u16*)(p.ws + WS_Q2); float* AUX = (float*)(p.ws + WS_AUX);
    const int c0 = grp * 16;
    const size_t tokb = (size_t)b * 4096;
    for (int i = tid; i < 144 * 136 / 2; i += 512) ((unsigned*)CT_s)[i] = 0u;
    for (int i = tid; i < 16 * 72; i += 512) vT_s[128 * 72 + i] = (i < 72) ? (u16)0x3F80 : (u16)0;
    const int cp = tid & 63, t0 = 8 * w, ch = 2 * cp;
    float cwq[4][2], cwk[4][2], cbq[2], cbk[2];
#pragma unroll
    for (int j = 0; j < 4; ++j)
#pragma unroll
        for (int e = 0; e < 2; ++e) { cwq[j][e] = p.conv_w[j * 1024 + hh * 128 + ch + e]; cwk[j][e] = p.conv_w[j * 1024 + 512 + hh * 128 + ch + e]; }
#pragma unroll
    for (int e = 0; e < 2; ++e) { cbq[e] = p.conv_b[hh * 128 + ch + e]; cbk[e] = p.conv_b[512 + hh * 128 + ch + e]; }
    f32x4 Cacc[8], Cacc8 = {0.f, 0.f, 0.f, 0.f};
#pragma unroll
    for (int i = 0; i < 8; ++i) Cacc[i] = (f32x4){0.f, 0.f, 0.f, 0.f};
    for (int cc = w; cc < c0; cc += 8) {
        const size_t tk = tokb + (size_t)cc * 64 + lane;
        const float gi = gates[tk * 8 + hh], gf = gates[tk * 8 + 4 + hh];
        const float logf = fminf(gf, 0.f) - log1pf(expf(-fabsf(gf)));
        float bcs = logf;
#pragma unroll
        for (int o = 1; o < 64; o <<= 1) { const float u = __shfl_up(bcs, o); if (lane >= o) bcs += u; }
        const float a_tot = __shfl(bcs, 63);
        const float igb = gi - bcs;
        const float gg = a_tot + igb;
        const float m_loc = wave_max(gg);
        if (lane == 0) { a_s[cc] = a_tot; ml_s[cc] = m_loc; }
    }
    __syncthreads();
    float m_prev = 0.f;
    for (int cc = 0; cc < c0; ++cc) m_prev = fmaxf(a_s[cc] + m_prev, ml_s[cc]);
    float Pc = 1.f;
    const int et = tid >> 3, ec = (tid & 7) * 16;
    unsigned rq[11], rk[11], rv[8]; float gi_n, gf_n;
    {
        const size_t tokc = tokb + (size_t)c0 * 64;
#pragma unroll
        for (int i = 0; i < 11; ++i) { const int row = t0 - 3 + i; const bool ok = (c0 > 0) || (row >= 0); const size_t o = (size_t)((long)tokc + (ok ? row : 0)) * NP + hh * 128 + ch;
            rq[i] = ok ? *(const unsigned*)(P + o) : 0u; rk[i] = ok ? *(const unsigned*)(P + o + 512) : 0u; }
#pragma unroll
        for (int i = 0; i < 8; ++i) rv[i] = *(const unsigned*)(P + (tokc + t0 + i) * NP + 1024 + hh * 128 + ch);
        gi_n = gates[(tokc + lane) * 8 + hh]; gf_n = gates[(tokc + lane) * 8 + 4 + hh];
    }
    for (int c = c0; c < c0 + 16; ++c) {
        const size_t tokc = tokb + (size_t)c * 64;
        const size_t tq = (size_t)item * 4096 + (size_t)c * 64;
        const float gi = gi_n, gf = gf_n;
        const float logf = fminf(gf, 0.f) - log1pf(expf(-fabsf(gf)));
        float bcs = logf;
#pragma unroll
        for (int o = 1; o < 64; o <<= 1) { const float u = __shfl_up(bcs, o); if (lane >= o) bcs += u; }
        const float a_tot = __shfl(bcs, 63);
        const float igb = gi - bcs;
        const float gg = a_tot + igb;
        const float m_loc = wave_max(gg);
        const float m_new = fmaxf(a_tot + m_prev, m_loc);
        const float s_old = expf(a_tot + m_prev - m_new);
        const float wp = expf(gg - m_new);
        float mx = igb;
#pragma unroll
        for (int o = 1; o < 64; o <<= 1) { const float u = __shfl_up(mx, o); if (lane >= o) mx = fmaxf(mx, u); }
        const float m_t = bcs + fmaxf(m_prev, mx);
        const float iw = expf(bcs + m_prev - m_t);
        const float bm = bcs - m_t;
        {
            float kv0[8], kv1[8];
#pragma unroll
            for (int i = 0; i < 8; ++i) {
                float aq0 = cbq[0], aq1 = cbq[1], ak0 = cbk[0], ak1 = cbk[1];
#pragma unroll
                for (int j = 0; j < 4; ++j) { aq0 += cwq[j][0] * bflo(rq[i + j]); aq1 += cwq[j][1] * bfhi(rq[i + j]); ak0 += cwk[j][0] * bflo(rk[i + j]); ak1 += cwk[j][1] * bfhi(rk[i + j]); }
                const float q0 = aq0 * __builtin_amdgcn_rcpf(1.f + __expf(-aq0)), q1 = aq1 * __builtin_amdgcn_rcpf(1.f + __expf(-aq1));
                const float k0 = ak0 * __builtin_amdgcn_rcpf(1.f + __expf(-ak0)) * 0.08838834764831845f, k1 = ak1 * __builtin_amdgcn_rcpf(1.f + __expf(-ak1)) * 0.08838834764831845f;
                *(unsigned*)(q_s + (t0 + i) * 136 + ch) = pk2(q0, q1);
                *(unsigned*)(k_s + (t0 + i) * 136 + ch) = pk2(k0, k1);
                const float wpi = __shfl(wp, t0 + i);
                kv0[i] = k0 * wpi; kv1[i] = k1 * wpi;
            }
            u32x4 o0, o1;
            o0.x = pk2(kv0[0], kv0[1]); o0.y = pk2(kv0[2], kv0[3]); o0.z = pk2(kv0[4], kv0[5]); o0.w = pk2(kv0[6], kv0[7]);
            o1.x = pk2(kv1[0], kv1[1]); o1.y = pk2(kv1[2], kv1[3]); o1.z = pk2(kv1[4], kv1[5]); o1.w = pk2(kv1[6], kv1[7]);
            *(u32x4*)(wkT_s + ch * 72 + t0) = o0; *(u32x4*)(wkT_s + (ch + 1) * 72 + t0) = o1;
            u32x4 v0, v1;
            v0.x = (rv[0] & 0xffffu) | (rv[1] << 16); v0.y = (rv[2] & 0xffffu) | (rv[3] << 16); v0.z = (rv[4] & 0xffffu) | (rv[5] << 16); v0.w = (rv[6] & 0xffffu) | (rv[7] << 16);
            v1.x = (rv[0] >> 16) | (rv[1] & 0xffff0000u); v1.y = (rv[2] >> 16) | (rv[3] & 0xffff0000u); v1.z = (rv[4] >> 16) | (rv[5] & 0xffff0000u); v1.w = (rv[6] >> 16) | (rv[7] & 0xffff0000u);
            *(u32x4*)(vT_s + ch * 72 + t0) = v0; *(u32x4*)(vT_s + (ch + 1) * 72 + t0) = v1;
        }
        if (c + 1 < c0 + 16) {
            const size_t tn = tokc + 64;
#pragma unroll
            for (int i = 0; i < 11; ++i) { const size_t o = (tn + t0 - 3 + i) * NP + hh * 128 + ch; rq[i] = *(const unsigned*)(P + o); rk[i] = *(const unsigned*)(P + o + 512); }
#pragma unroll
            for (int i = 0; i < 8; ++i) rv[i] = *(const unsigned*)(P + (tn + t0 + i) * NP + 1024 + hh * 128 + ch);
            gi_n = gates[(tn + lane) * 8 + hh]; gf_n = gates[(tn + lane) * 8 + 4 + hh];
        }
        __syncthreads();
        {
            const u32x4 qa = *(const u32x4*)(q_s + et * 136 + ec), qb = *(const u32x4*)(q_s + et * 136 + ec + 8);
            u16* qd = Q2 + (tq + et) * 128 + ec; *(u32x4*)qd = qa; *(u32x4*)(qd + 8) = qb;
            if (w == 0) { AUX[(tq + lane) * 4 + 0] = iw * Pc; AUX[(tq + lane) * 4 + 1] = expf(-m_t); }
        }
        {
            const int ti = w >> 1;
#pragma unroll
            for (int sj = 0; sj < 2; ++sj) {
                const int si = 2 * (w & 1) + sj;
                f32x4 acc = {0.f, 0.f, 0.f, 0.f};
                if (si <= ti) {
#pragma unroll
                    for (int ks = 0; ks < 4; ++ks) {
                        const bf16x8 a = *(const bf16x8*)(q_s + (16 * ti + i16) * 136 + 32 * ks + 8 * g4);
                        const bf16x8 bb = *(const bf16x8*)(k_s + (16 * si + i16) * 136 + 32 * ks + 8 * g4);
                        acc = mfma16(a, bb, acc);
                    }
                }
                const int s = 16 * si + i16; const float igb_s = __shfl(igb, s);
#pragma unroll
                for (int r = 0; r < 4; ++r) {
                    const int t = 16 * ti + 4 * g4 + r; const float bm_t = __shfl(bm, t);
                    const float val = (s <= t) ? acc[r] * __expf(bm_t + igb_s) : 0.f;
                    S_s[t * 72 + s] = (u16)(pk2(val, 0.f) & 0xffffu);
                }
            }
        }
        f32x4 accO[4], accO8 = {0.f, 0.f, 0.f, 0.f};
#pragma unroll
        for (int ti = 0; ti < 4; ++ti) {
            f32x4 acc = {0.f, 0.f, 0.f, 0.f};
#pragma unroll
            for (int ks = 0; ks < 4; ++ks) {
                const bf16x8 a = *(const bf16x8*)(q_s + (16 * ti + i16) * 136 + 32 * ks + 8 * g4);
                const bf16x8 bb = *(const bf16x8*)(CT_s + (16 * w + i16) * 136 + 32 * ks + 8 * g4);
                acc = mfma16(a, bb, acc);
            }
#pragma unroll
            for (int r = 0; r < 4; ++r) acc[r] *= __shfl(iw, 16 * ti + 4 * g4 + r);
            accO[ti] = acc;
        }
        if (w < 4) {
            f32x4 acc = {0.f, 0.f, 0.f, 0.f};
#pragma unroll
            for (int ks = 0; ks < 4; ++ks) {
                const bf16x8 a = *(const bf16x8*)(q_s + (16 * w + i16) * 136 + 32 * ks + 8 * g4);
                const bf16x8 bb = *(const bf16x8*)(CT_s + (128 + i16) * 136 + 32 * ks + 8 * g4);
                acc = mfma16(a, bb, acc);
            }
#pragma unroll
            for (int r = 0; r < 4; ++r) acc[r] *= __shfl(iw, 16 * w + 4 * g4 + r);
            accO8 = acc;
        }
        __syncthreads();
#pragma unroll
        for (int ti = 0; ti < 4; ++ti)
#pragma unroll
            for (int ks = 0; ks < 2; ++ks) {
                const bf16x8 a = *(const bf16x8*)(S_s + (16 * ti + i16) * 72 + 32 * ks + 8 * g4);
                const bf16x8 bb = *(const bf16x8*)(vT_s + (16 * w + i16) * 72 + 32 * ks + 8 * g4);
                accO[ti] = mfma16(a, bb, accO[ti]);
            }
        if (w < 4) {
#pragma unroll
            for (int ks = 0; ks < 2; ++ks) {
                const bf16x8 a = *(const bf16x8*)(S_s + (16 * w + i16) * 72 + 32 * ks + 8 * g4);
                const bf16x8 bb = *(const bf16x8*)(vT_s + (128 + i16) * 72 + 32 * ks + 8 * g4);
                accO8 = mfma16(a, bb, accO8);
            }
        }
#pragma unroll
        for (int ti = 0; ti < 4; ++ti)
#pragma unroll
            for (int r = 0; r < 4; ++r) out_s[(16 * ti + 4 * g4 + r) * 132 + 16 * w + i16] = accO[ti][r];
        if (w < 4 && i16 == 0) {
#pragma unroll
            for (int r = 0; r < 4; ++r) den_s[16 * w + 4 * g4 + r] = accO8[r];
        }
        __syncthreads();
        {
            float nv[16];
#pragma unroll
            for (int j = 0; j < 16; ++j) nv[j] = out_s[et * 132 + ec + j];
            u32x4 s0, s1;
            s0.x = pk2(nv[0], nv[1]); s0.y = pk2(nv[2], nv[3]); s0.z = pk2(nv[4], nv[5]); s0.w = pk2(nv[6], nv[7]);
            s1.x = pk2(nv[8], nv[9]); s1.y = pk2(nv[10], nv[11]); s1.z = pk2(nv[12], nv[13]); s1.w = pk2(nv[14], nv[15]);
            u16* dst = NDn + (tq + et) * 128 + ec;
            *(u32x4*)dst = s0; *(u32x4*)(dst + 8) = s1;
            if ((tid & 7) == 0) AUX[(tq + et) * 4 + 2] = den_s[et];
        }
#pragma unroll
        for (int ki = 0; ki < 8; ++ki) {
            f32x4 acc = Cacc[ki] * s_old;
#pragma unroll
            for (int ks = 0; ks < 2; ++ks) {
                const bf16x8 a = *(const bf16x8*)(wkT_s + (16 * ki + i16) * 72 + 32 * ks + 8 * g4);
                const bf16x8 bb = *(const bf16x8*)(vT_s + (16 * w + i16) * 72 + 32 * ks + 8 * g4);
                acc = mfma16(a, bb, acc);
            }
            Cacc[ki] = acc;
            u32x2 pkd; pkd.x = pk2(acc[0], acc[1]); pkd.y = pk2(acc[2], acc[3]);
            *(u32x2*)(CT_s + (16 * w + i16) * 136 + 16 * ki + 4 * g4) = pkd;
        }
        {
            f32x4 acc = Cacc8 * s_old;
#pragma unroll
            for (int ks = 0; ks < 2; ++ks) {
                const bf16x8 a = *(const bf16x8*)(wkT_s + (16 * w + i16) * 72 + 32 * ks + 8 * g4);
                const bf16x8 bb = *(const bf16x8*)(vT_s + (128 + i16) * 72 + 32 * ks + 8 * g4);
                acc = mfma16(a, bb, acc);
            }
            Cacc8 = acc;
            u32x2 pkd; pkd.x = pk2(acc[0], acc[1]); pkd.y = pk2(acc[2], acc[3]);
            *(u32x2*)(CT_s + (128 + i16) * 136 + 16 * w + 4 * g4) = pkd;
        }
        m_prev = m_new; Pc *= s_old;
        __syncthreads();
    }
    {
        float* E = (float*)(p.ws + WS_E) + (size_t)(item * 4 + grp) * 144 * 128;
#pragma unroll
        for (int ki = 0; ki < 8; ++ki) *(f32x4*)(E + (16 * w + i16) * 128 + 16 * ki + 4 * g4) = Cacc[ki];
        *(f32x4*)(E + (128 + i16) * 128 + 16 * w + 4 * g4) = Cacc8;
        if (tid == 0) ((float*)(p.ws + WS_DG))[item * 4 + grp] = Pc;
    }
}

__device__ __forceinline__ void mlstm_pass2(const Params& p, const int item, const int grp) {
    extern __shared__ __attribute__((aligned(16))) unsigned char lds[];
    const int tid = opaque_tid(), lane = tid & 63, w = tid >> 6, i16 = lane & 15, g4 = lane >> 4;
    const int b = item >> 2, hh = item & 3;
    u16* q_s = (u16*)(lds + 0); float* o2_s = (float*)(lds + 17408); float* den2_s = (float*)(lds + 51200); u16* CT_s = (u16*)(lds + 83200);
    const u16* P = (const u16*)(p.ws + WS_P); u16* Hm = (u16*)(p.ws + WS_HMIX);
    const u16* NDn = (const u16*)(p.ws + WS_NDNUM); const u16* Q2 = (const u16*)(p.ws + WS_Q2); const float* AUX = (const float*)(p.ws + WS_AUX);
    const size_t tokb = (size_t)b * 4096;
    const int et = tid >> 3, ec = (tid & 7) * 16;
    if (grp > 0) {
        float cf[3] = {0.f, 0.f, 0.f}; float run = 1.f;
#pragma unroll
        for (int gp = 2; gp >= 0; --gp) if (gp < grp) { cf[gp] = run; run *= __hip_atomic_load((float*)(p.ws + WS_DG) + item * 4 + gp, __ATOMIC_RELAXED, __HIP_MEMORY_SCOPE_AGENT); }
        const float* E = (const float*)(p.ws + WS_E) + (size_t)(item * 4) * 144 * 128;
        for (int i4 = tid; i4 < 144 * 128 / 4; i4 += 512) {
            const int i = i4 * 4;
            f32x4 sacc = {0.f, 0.f, 0.f, 0.f};
#pragma unroll
            for (int gp = 0; gp < 3; ++gp) if (gp < grp) sacc += cf[gp] * *(const f32x4*)(E + (size_t)gp * 144 * 128 + i);
            u32x2 w; w.x = pk2(sacc[0], sacc[1]); w.y = pk2(sacc[2], sacc[3]);
            *(u32x2*)(CT_s + (i >> 7) * 136 + (i & 127)) = w;
        }
    }
    __syncthreads();
    float gml[16];
#pragma unroll
    for (int j = 0; j < 16; ++j) gml[j] = p.g_ml[hh * 128 + ec + j];
    u32x4 qa_n, qb_n, nd_n[2], ov_n[2], zv_n[2]; f32x4 ax_n;
    {
        const int c = grp * 16;
        const size_t tokc = tokb + (size_t)c * 64, tq = (size_t)item * 4096 + (size_t)c * 64;
        const u16* qsrc = Q2 + (tq + et) * 128 + ec; qa_n = *(const u32x4*)qsrc; qb_n = *(const u32x4*)(qsrc + 8);
        ax_n = *(const f32x4*)(AUX + (tq + lane) * 4);
        const u16* ns = NDn + (tq + et) * 128 + ec; nd_n[0] = *(const u32x4*)ns; nd_n[1] = *(const u32x4*)(ns + 8);
        const u16* po = P + (tokc + et) * NP + 1536 + hh * 128 + ec; ov_n[0] = *(const u32x4*)po; ov_n[1] = *(const u32x4*)(po + 8);
        zv_n[0] = *(const u32x4*)(po + 512); zv_n[1] = *(const u32x4*)(po + 520);
    }
    for (int cl = 0; cl < 16; ++cl) {
        const int c = grp * 16 + cl;
        const size_t tokc = tokb + (size_t)c * 64;
        *(u32x4*)(q_s + et * 136 + ec) = qa_n; *(u32x4*)(q_s + et * 136 + ec + 8) = qb_n;
        const f32x4 ax = ax_n;
        u32x4 nd[2], ov[2], zv[2];
        nd[0] = nd_n[0]; nd[1] = nd_n[1]; ov[0] = ov_n[0]; ov[1] = ov_n[1]; zv[0] = zv_n[0]; zv[1] = zv_n[1];
        __syncthreads();
        if (cl + 1 < 16) {
            const size_t tokn = tokc + 64, tqn = (size_t)item * 4096 + (size_t)(c + 1) * 64;
            const u16* qsrc = Q2 + (tqn + et) * 128 + ec; qa_n = *(const u32x4*)qsrc; qb_n = *(const u32x4*)(qsrc + 8);
            ax_n = *(const f32x4*)(AUX + (tqn + lane) * 4);
            const u16* ns = NDn + (tqn + et) * 128 + ec; nd_n[0] = *(const u32x4*)ns; nd_n[1] = *(const u32x4*)(ns + 8);
            const u16* po = P + (tokn + et) * NP + 1536 + hh * 128 + ec; ov_n[0] = *(const u32x4*)po; ov_n[1] = *(const u32x4*)(po + 8);
            zv_n[0] = *(const u32x4*)(po + 512); zv_n[1] = *(const u32x4*)(po + 520);
        }
        asm volatile("" ::: "memory");
        if (grp > 0) {
#pragma unroll
            for (int ti = 0; ti < 4; ++ti) {
                f32x4 acc = {0.f, 0.f, 0.f, 0.f};
#pragma unroll
                for (int ks = 0; ks < 4; ++ks) {
                    const bf16x8 a = *(const bf16x8*)(q_s + (16 * ti + i16) * 136 + 32 * ks + 8 * g4);
                    const bf16x8 bb = *(const bf16x8*)(CT_s + (16 * w + i16) * 136 + 32 * ks + 8 * g4);
                    acc = mfma16(a, bb, acc);
                }
#pragma unroll
                for (int r = 0; r < 4; ++r) o2_s[(16 * ti + 4 * g4 + r) * 132 + 16 * w + i16] = acc[r] * __shfl(ax.x, 16 * ti + 4 * g4 + r);
            }
            if (w < 4) {
                f32x4 acc = {0.f, 0.f, 0.f, 0.f};
#pragma unroll
                for (int ks = 0; ks < 4; ++ks) {
                    const bf16x8 a = *(const bf16x8*)(q_s + (16 * w + i16) * 136 + 32 * ks + 8 * g4);
                    const bf16x8 bb = *(const bf16x8*)(CT_s + (128 + i16) * 136 + 32 * ks + 8 * g4);
                    acc = mfma16(a, bb, acc);
                }
#pragma unroll
                for (int r = 0; r < 4; ++r) { const float v = acc[r] * __shfl(ax.x, 16 * w + 4 * g4 + r); if (i16 == 0) den2_s[16 * w + 4 * g4 + r] = v; }
            }
        }
        __syncthreads();
        {
            const float den = __shfl(ax.z, et) + (grp > 0 ? den2_s[et] : 0.f);
            const float inv = 1.f / fmaxf(fabsf(den), __shfl(ax.y, et));
            float ho[16]; float ss = 0.f;
#pragma unroll
            for (int j = 0; j < 16; ++j) {
                const unsigned wn = nd[j >> 3][(j >> 1) & 3]; float num = (j & 1) ? bfhi(wn) : bflo(wn);
                if (grp > 0) num += o2_s[et * 132 + ec + j];
                const unsigned wv = ov[j >> 3][(j >> 1) & 3]; const float o = (j & 1) ? bfhi(wv) : bflo(wv);
                ho[j] = num * inv * __builtin_amdgcn_rcpf(1.f + __expf(-o)); ss += ho[j] * ho[j];
            }
            ss += __shfl_xor(ss, 1); ss += __shfl_xor(ss, 2); ss += __shfl_xor(ss, 4);
            const float rr = rsqrtf(ss * (1.f / 128.f) + 1e-6f);
            float ob[16];
#pragma unroll
            for (int j = 0; j < 16; ++j) {
                const unsigned wv = zv[j >> 3][(j >> 1) & 3]; const float z = (j & 1) ? bfhi(wv) : bflo(wv);
                ob[j] = ho[j] * rr * gml[j] * (z * __builtin_amdgcn_rcpf(1.f + __expf(-z)));
            }
            u32x4 s0, s1;
            s0.x = pk2(ob[0], ob[1]); s0.y = pk2(ob[2], ob[3]); s0.z = pk2(ob[4], ob[5]); s0.w = pk2(ob[6], ob[7]);
            s1.x = pk2(ob[8], ob[9]); s1.y = pk2(ob[10], ob[11]); s1.z = pk2(ob[12], ob[13]); s1.w = pk2(ob[14], ob[15]);
            u16* dst = Hm + (tokc + et) * 1024 + hh * 128 + ec;
            *(u32x4*)dst = s0; *(u32x4*)(dst + 8) = s1;
        }
        __syncthreads();
    }
}

__device__ __forceinline__ void sb_unit(const Params& p, const int unit, u16* vT, const int lane) {
    const u16* P = (const u16*)(p.ws + WS_P); u16* Hm = (u16*)(p.ws + WS_HMIX);
    const int qt = unit & 127, hd = (unit >> 7) & 7, b = unit >> 10;
    const int r = lane & 31, h = lane >> 5;
    const size_t tokb = (size_t)b * 4096;
    bf16x8 qf[4];
    { const u16* qrow = P + (tokb + qt * 32 + r) * NP + 2560 + hd * 64 + 8 * h;
#pragma unroll
      for (int ks = 0; ks < 4; ++ks) qf[ks] = *(const bf16x8*)(qrow + 16 * ks); }
    u32x4 Tw[2];
#pragma unroll
    for (int st = 0; st < 2; ++st) {
        unsigned tw[4];
#pragma unroll
        for (int e = 0; e < 8; e += 2) {
            const int j0 = 16 * st + 8 * (e >> 2) + 4 * h + (e & 3), j1 = j0 + 1;
            tw[e >> 1] = ((j0 > r) ? 0x3C00u : 0u) | ((j1 > r) ? 0x3C000000u : 0u);
        }
        Tw[st].x = tw[0]; Tw[st].y = tw[1]; Tw[st].z = tw[2]; Tw[st].w = tw[3];
    }
    f32x16 O0, O1;
#pragma unroll
    for (int i = 0; i < 16; ++i) { O0[i] = 0.f; O1[i] = 0.f; }
    float R2 = 0.f;
    const float SC = 0.125f * 1.4426950408889634f;
    const size_t tok = tokb + qt * 32 + r;
    u32x2 zz8[8];
#pragma unroll
    for (int i = 0; i < 8; ++i) zz8[i] = *(const u32x2*)(P + tok * NP + 4096 + hd * 64 + 32 * (i >> 2) + 8 * (i & 3) + 4 * h);
    asm volatile("" ::: "memory");
    bf16x8 kfn[4]; u32x4 vvn[4];
    { const u16* krow = P + (tokb + qt * 32 + r) * NP + 3072 + hd * 64 + 8 * h;
#pragma unroll
      for (int ks = 0; ks < 4; ++ks) kfn[ks] = *(const bf16x8*)(krow + 16 * ks);
      const u16* vrow = P + (tokb + qt * 32 + (lane >> 1)) * NP + 3584 + hd * 64 + (lane & 1) * 32;
#pragma unroll
      for (int i = 0; i < 4; ++i) vvn[i] = *(const u32x4*)(vrow + 8 * i); }
    bool have = true;
    for (int kb = qt; kb >= 0; --kb) {
        if (!have) {
            const u16* krow = P + (tokb + kb * 32 + r) * NP + 3072 + hd * 64 + 8 * h;
#pragma unroll
            for (int ks = 0; ks < 4; ++ks) kfn[ks] = *(const bf16x8*)(krow + 16 * ks);
            const u16* vrow = P + (tokb + kb * 32 + (lane >> 1)) * NP + 3584 + hd * 64 + (lane & 1) * 32;
#pragma unroll
            for (int i = 0; i < 4; ++i) vvn[i] = *(const u32x4*)(vrow + 8 * i);
        }
        bf16x8 kf[4]; u32x4 vv[4];
#pragma unroll
        for (int i = 0; i < 4; ++i) { kf[i] = kfn[i]; vv[i] = vvn[i]; }
        asm volatile("" ::: "memory");
        have = (kb > 0) && __any(R2 > -30.f);
        if (have) {
            const int s1 = (kb - 1) * 32;
            const u16* krow = P + (tokb + s1 + r) * NP + 3072 + hd * 64 + 8 * h;
#pragma unroll
            for (int ks = 0; ks < 4; ++ks) kfn[ks] = *(const bf16x8*)(krow + 16 * ks);
            const u16* vrow = P + (tokb + s1 + (lane >> 1)) * NP + 3584 + hd * 64 + (lane & 1) * 32;
#pragma unroll
            for (int i = 0; i < 4; ++i) vvn[i] = *(const u32x4*)(vrow + 8 * i);
        }
        asm volatile("" ::: "memory");
        f32x16 Z;
#pragma unroll
        for (int i = 0; i < 16; ++i) Z[i] = 0.f;
#pragma unroll
        for (int ks = 0; ks < 4; ++ks) Z = mfma32(kf[ks], qf[ks], Z);
        float lbv[16], lkv[16];
#pragma unroll
        for (int reg = 0; reg < 16; ++reg) {
            const float u = Z[reg] * SC;
            const float sp = __builtin_amdgcn_logf(1.f + __builtin_amdgcn_exp2f(-fabsf(u)));
            lbv[reg] = fminf(u, 0.f) - sp;
            lkv[reg] = lbv[reg] - u;
        }
        if (kb == qt) {
#pragma unroll
            for (int reg = 0; reg < 16; ++reg) {
                const int sl = (reg & 3) + 8 * (reg >> 2) + 4 * h;
                const bool valid = sl < r;
                lbv[reg] = valid ? lbv[reg] : -1e30f;
                lkv[reg] = valid ? lkv[reg] : 0.f;
            }
        }
        u32x4 lw[2];
#pragma unroll
        for (int st = 0; st < 2; ++st) {
            lw[st].x = pkh2(lkv[8 * st + 0], lkv[8 * st + 1]); lw[st].y = pkh2(lkv[8 * st + 2], lkv[8 * st + 3]);
            lw[st].z = pkh2(lkv[8 * st + 4], lkv[8 * st + 5]); lw[st].w = pkh2(lkv[8 * st + 6], lkv[8 * st + 7]);
        }
        f32x16 aft;
#pragma unroll
        for (int i = 0; i < 16; ++i) aft[i] = 0.f;
        aft = __builtin_amdgcn_mfma_f32_32x32x16_f16(__builtin_bit_cast(f16x8, Tw[0]), __builtin_bit_cast(f16x8, lw[0]), aft, 0, 0, 0);
        aft = __builtin_amdgcn_mfma_f32_32x32x16_f16(__builtin_bit_cast(f16x8, Tw[1]), __builtin_bit_cast(f16x8, lw[1]), aft, 0, 0, 0);
        const float tot = __shfl(aft[0] + lkv[0], r);
        bf16x8 pf[2];
#pragma unroll
        for (int st = 0; st < 2; ++st) {
            u32x4 pw;
            pw.x = pk2(__builtin_amdgcn_exp2f(lbv[8 * st + 0] + R2 + aft[8 * st + 0]), __builtin_amdgcn_exp2f(lbv[8 * st + 1] + R2 + aft[8 * st + 1]));
            pw.y = pk2(__builtin_amdgcn_exp2f(lbv[8 * st + 2] + R2 + aft[8 * st + 2]), __builtin_amdgcn_exp2f(lbv[8 * st + 3] + R2 + aft[8 * st + 3]));
            pw.z = pk2(__builtin_amdgcn_exp2f(lbv[8 * st + 4] + R2 + aft[8 * st + 4]), __builtin_amdgcn_exp2f(lbv[8 * st + 5] + R2 + aft[8 * st + 5]));
            pw.w = pk2(__builtin_amdgcn_exp2f(lbv[8 * st + 6] + R2 + aft[8 * st + 6]), __builtin_amdgcn_exp2f(lbv[8 * st + 7] + R2 + aft[8 * st + 7]));
            pf[st] = __builtin_bit_cast(bf16x8, pw);
        }
        {
            const int sv = lane >> 1, db = (lane & 1) * 32;
#pragma unroll
            for (int i = 0; i < 4; ++i)
#pragma unroll
                for (int wq = 0; wq < 4; ++wq) {
                    const unsigned x = vv[i][wq]; const int d = db + 8 * i + 2 * wq;
                    vT[d * 40 + sv] = (u16)(x & 0xffffu); vT[(d + 1) * 40 + sv] = (u16)(x >> 16);
                }
        }
        asm volatile("s_waitcnt lgkmcnt(0)" ::: "memory");
#pragma unroll
        for (int st = 0; st < 2; ++st) {
            const u32x2 a0 = *(const u32x2*)(vT + r * 40 + 16 * st + 4 * h), a1 = *(const u32x2*)(vT + r * 40 + 16 * st + 8 + 4 * h);
            const u32x2 b0 = *(const u32x2*)(vT + (32 + r) * 40 + 16 * st + 4 * h), b1 = *(const u32x2*)(vT + (32 + r) * 40 + 16 * st + 8 + 4 * h);
            u32x4 fa, fb; fa.x = a0.x; fa.y = a0.y; fa.z = a1.x; fa.w = a1.y; fb.x = b0.x; fb.y = b0.y; fb.z = b1.x; fb.w = b1.y;
            O0 = mfma32(__builtin_bit_cast(bf16x8, fa), pf[st], O0);
            O1 = mfma32(__builtin_bit_cast(bf16x8, fb), pf[st], O1);
        }
        asm volatile("s_waitcnt lgkmcnt(0)" ::: "memory");
        R2 += tot;
        if (!__any(R2 > -64.f)) break;
    }
#pragma unroll
    for (int dt = 0; dt < 2; ++dt)
#pragma unroll
        for (int q4 = 0; q4 < 4; ++q4) {
            const int d0 = 32 * dt + 8 * q4 + 4 * h;
            const u32x2 zz = zz8[4 * dt + q4];
            float o[4];
#pragma unroll
            for (int e = 0; e < 4; ++e) {
                const float ov = dt ? O1[4 * q4 + e] : O0[4 * q4 + e];
                const unsigned wv = (e < 2) ? zz.x : zz.y; const float z = (e & 1) ? bfhi(wv) : bflo(wv);
                o[e] = ov * (z * __builtin_amdgcn_rcpf(1.f + __expf(-z)));
            }
            u32x2 st; st.x = pk2(o[0], o[1]); st.y = pk2(o[2], o[3]);
            *(u32x2*)(Hm + tok * 1024 + 512 + hd * 64 + d0) = st;
        }
}

__device__ __forceinline__ void phase2a(const Params& p) {
    for (int u = blockIdx.x; u < 256; u += gridDim.x) { mlstm_pass1(p, u >> 2, u & 3); __syncthreads(); }
}
__device__ __forceinline__ void phase2b(const Params& p) {
    extern __shared__ __attribute__((aligned(16))) unsigned char lds[];
    for (int u = blockIdx.x; u < 256; u += gridDim.x) { mlstm_pass2(p, u >> 2, u & 3); __syncthreads(); }
    const int tid2 = opaque_tid(), lane = tid2 & 63, wave = tid2 >> 6;
    u16* vT = (u16*)(lds + wave * 5120);
    for (int u = blockIdx.x * 8 + wave; u < 16384; u += gridDim.x * 8) sb_unit(p, u, vT, lane);
}

__device__ __forceinline__ void phase4(const Params& p) {
    const int tid = opaque_tid(), lane = tid & 63, wave = tid >> 6;
    const float* modp = (const float*)(p.ws + WS_MOD);
    const u16* Y = (const u16*)(p.ws + WS_Y);
    for (int tb = blockIdx.x * 8 + wave; tb < 2048; tb += gridDim.x * 8) {
        const int tok0 = tb * 32, b = tok0 >> 12;
        f32x4 gg[4];
#pragma unroll
        for (int j = 0; j < 4; ++j) { const int k = lane * 4 + 256 * j; gg[j] = *(const f32x4*)(modp + b * 3072 + 2048 + k) * *(const f32x4*)(p.g_post + k); }
        u32x2 yn[4]; f32x4 xn[4];
#pragma unroll
        for (int j = 0; j < 4; ++j) { yn[j] = *(const u32x2*)(Y + (size_t)tok0 * 1024 + lane * 4 + 256 * j); xn[j] = __builtin_nontemporal_load((const f32x4*)(p.x + (size_t)tok0 * 1024 + lane * 4 + 256 * j)); }
        for (int t = 0; t < 32; ++t) {
            const size_t tok = (size_t)tok0 + t;
            f32x4 y[4], xv[4]; float ss = 0.f;
#pragma unroll
            for (int j = 0; j < 4; ++j) { const u32x2 w = yn[j]; xv[j] = xn[j];
                y[j] = (f32x4){bflo(w.x), bfhi(w.x), bflo(w.y), bfhi(w.y)}; ss += (y[j].x * y[j].x + y[j].y * y[j].y) + (y[j].z * y[j].z + y[j].w * y[j].w); }
            if (t + 1 < 32) {
#pragma unroll
                for (int j = 0; j < 4; ++j) { yn[j] = *(const u32x2*)(Y + (tok + 1) * 1024 + lane * 4 + 256 * j); xn[j] = __builtin_nontemporal_load((const f32x4*)(p.x + (tok + 1) * 1024 + lane * 4 + 256 * j)); }
            }
            ss = wave_sum(ss); const float r = rsqrtf(ss * (1.f / 1024.f) + 1e-6f);
#pragma unroll
            for (int j = 0; j < 4; ++j) __builtin_nontemporal_store(xv[j] + gg[j] * (y[j] * r), (f32x4*)(p.out + tok * 1024 + lane * 4 + 256 * j));
        }
    }
}

DEVI unsigned bar_ld(unsigned* q) { return __hip_atomic_load(q, __ATOMIC_RELAXED, __HIP_MEMORY_SCOPE_AGENT); }
DEVI unsigned bar_add(unsigned* q, unsigned v) { return __hip_atomic_fetch_add(q, v, __ATOMIC_RELAXED, __HIP_MEMORY_SCOPE_AGENT); }
DEVI unsigned xcc_id() { return (unsigned)__builtin_amdgcn_s_getreg((3 << 11) | 20) & 0xFu; }
DEVI void grid_sync0(const Params& p, cg::grid_group& g) {
    asm volatile("s_waitcnt vmcnt(0) lgkmcnt(0)" ::: "memory");
    g.sync();
    if (threadIdx.x == 0) { __builtin_amdgcn_fence(__ATOMIC_ACQUIRE, "agent"); asm volatile("s_waitcnt vmcnt(0)" ::: "memory"); }
    __syncthreads();
}
DEVI void grid_sync(const Params& p, const int idx, const unsigned xcc, const unsigned nloc, const unsigned nxcc) {
    asm volatile("s_waitcnt vmcnt(0) lgkmcnt(0)" ::: "memory");
    __syncthreads();
    if (threadIdx.x == 0) {
        unsigned* bar = (unsigned*)(p.ws + WS_BAR);
        unsigned* xsub = bar + 1024 + (16 * idx + xcc) * 64; unsigned* top = bar + 9216 + 64 * idx;
        const unsigned old = bar_add(xsub, 1u);
        if (old == nloc - 1u) {
            __builtin_amdgcn_fence(__ATOMIC_RELEASE, "agent");
            asm volatile("s_waitcnt vmcnt(0)" ::: "memory");
            bar_add(top, 1u);
        }
        while (bar_ld(top) < nxcc) __builtin_amdgcn_s_sleep(1);
        __builtin_amdgcn_fence(__ATOMIC_ACQUIRE, "agent");
        asm volatile("s_waitcnt vmcnt(0)" ::: "memory");
    }
    __syncthreads();
}
__global__ void __launch_bounds__(512) hymba_fwd(Params p) {
    cg::grid_group grid = cg::this_grid();
    const unsigned xcc = xcc_id();
    if (threadIdx.x == 0) bar_add((unsigned*)(p.ws + WS_BAR) + 64 * xcc, 1u);
    phase0(p);
    if (gridDim.x == 0x7fffffffu) grid_sync0(p, grid);
    if (threadIdx.x == 0) {
        unsigned* bar = (unsigned*)(p.ws + WS_BAR);
        for (;;) { unsigned tot = 0; for (int j = 0; j < 16; ++j) tot += bar_ld(bar + 64 * j); if (tot >= gridDim.x) break; __builtin_amdgcn_s_sleep(1); }
    }
    __syncthreads();
    unsigned nloc, nxcc = 0;
    { unsigned* bar = (unsigned*)(p.ws + WS_BAR); nloc = bar_ld(bar + 64 * xcc);
      for (int j = 0; j < 16; ++j) nxcc += (bar_ld(bar + 64 * j) != 0u) ? 1u : 0u; }
    grid_sync(p, 0, xcc, nloc, nxcc);
    phase1a(p);
    grid_sync(p, 1, xcc, nloc, nxcc);
    gemm_phase((const u16*)(p.ws + WS_H), (const u16*)(p.ws + WS_WTIN), (u16*)(p.ws + WS_P), 18, NP);
    grid_sync(p, 2, xcc, nloc, nxcc);
    phase2a(p);
    grid_sync(p, 5, xcc, nloc, nxcc);
    phase2b(p);
    grid_sync(p, 3, xcc, nloc, nxcc);
    gemm_phase((const u16*)(p.ws + WS_HMIX), (const u16*)(p.ws + WS_WTOUT), (u16*)(p.ws + WS_Y), 4, 1024);
    grid_sync(p, 4, xcc, nloc, nxcc);
    phase4(p);
}

extern "C" void kernel_launch(void* const* d_in, const int* in_sizes, int n_in, void* d_out, int out_size, void* d_ws, size_t ws_size, hipStream_t stream) {
    static int grid_blocks = 0;
    if (!grid_blocks) {
        if (n_in != 13 || out_size != NTOK * DM || ws_size < WS_END) { fprintf(stderr, "kernel_launch: unexpected shapes (n_in %d out %d ws %zu)\n", n_in, out_size, ws_size); grid_blocks = -1; return; }
        int dev = 0, cus = 0, per_cu = 0;
        hipGetDevice(&dev);
        hipDeviceGetAttribute(&cus, hipDeviceAttributeMultiprocessorCount, dev);
        if (hipFuncSetAttribute((const void*)hymba_fwd, hipFuncAttributeMaxDynamicSharedMemorySize, LDS_BYTES) != hipSuccess) fprintf(stderr, "kernel_launch: hipFuncSetAttribute failed\n");
        if (hipOccupancyMaxActiveBlocksPerMultiprocessor(&per_cu, (const void*)hymba_fwd, 512, LDS_BYTES) != hipSuccess || per_cu < 1) { fprintf(stderr, "kernel_launch: occupancy query says %d\n", per_cu); per_cu = 1; }
        (void)hipGetLastError();
        grid_blocks = cus * 1;
    }
    if (grid_blocks < 0) return;
    Params p{};
    p.x = (const float*)d_in[0]; p.c = (const float*)d_in[1]; p.w_ada = (const float*)d_in[2]; p.b_ada = (const float*)d_in[3]; p.g_pre = (const float*)d_in[4];
    p.w_in = (const float*)d_in[5]; p.b_ig = (const float*)d_in[6]; p.b_fg = (const float*)d_in[7]; p.conv_w = (const float*)d_in[8]; p.conv_b = (const float*)d_in[9];
    p.g_ml = (const float*)d_in[10]; p.w_out = (const float*)d_in[11]; p.g_post = (const float*)d_in[12];
    p.out = (float*)d_out; p.ws = (unsigned char*)d_ws;
    if (hipMemsetAsync((unsigned char*)d_ws + WS_BAR, 0, 40960, stream) != hipSuccess) fprintf(stderr, "kernel_launch: memset of the barrier words failed\n");
    void* args[] = {&p};
    hipError_t e = hipLaunchCooperativeKernel((const void*)hymba_fwd, dim3(grid_blocks), dim3(512), args, LDS_BYTES, stream);
    if (e != hipSuccess) fprintf(stderr, "cooperative launch failed: %s (grid %d)\n", hipGetErrorString(e), grid_blocks);
}
```

```cpp
#include <hip/hip_runtime.h>
#include <hip/hip_cooperative_groups.h>
#include <cstdio>
#include <cstdint>
namespace cg = cooperative_groups;

typedef unsigned short u16;
typedef short bf16x8 __attribute__((ext_vector_type(8)));
typedef float f32x4 __attribute__((ext_vector_type(4)));
typedef float f32x16 __attribute__((ext_vector_type(16)));
typedef unsigned u32x4 __attribute__((ext_vector_type(4)));
typedef unsigned u32x2 __attribute__((ext_vector_type(2)));
#define DEVI __device__ __forceinline__

constexpr int NTOK = 65536, DM = 1024, NP = 4608;
constexpr size_t WS_WTIN = 0;
constexpr size_t WS_WTOUT = 9437184;
constexpr size_t WS_WG = 11534336;
constexpr size_t WS_MOD = 11567104;
constexpr size_t WS_BAR = 13860864;
constexpr size_t WS_GATES = 11763712;
constexpr size_t WS_H = 16777216;
constexpr size_t WS_P = WS_H + 134217728;
constexpr size_t WS_HMIX = WS_P + 603979776;
constexpr size_t WS_Y = WS_HMIX + 134217728;
constexpr size_t WS_END = WS_Y + 134217728;
constexpr size_t WS_NDNUM = WS_H;
constexpr size_t WS_Q2 = WS_H + 67108864;
constexpr size_t WS_E = WS_Y;
constexpr size_t WS_AUX = WS_Y + 33554432;
constexpr size_t WS_DG = WS_Y + 41943040;
constexpr int LDS_BYTES = 131072;

struct Params {
    const float *x, *c, *w_ada, *b_ada, *g_pre, *w_in, *b_ig, *b_fg, *conv_w, *conv_b, *g_ml, *w_out, *g_post;
    float* out;
    unsigned char* ws;
};

DEVI int opaque_tid() { int t = threadIdx.x; asm volatile("" : "+v"(t)); return t; }
typedef __bf16 bf16x2_t __attribute__((ext_vector_type(2)));
typedef _Float16 f16x2_t __attribute__((ext_vector_type(2)));
typedef _Float16 f16x8 __attribute__((ext_vector_type(8)));
typedef float f32x2_t __attribute__((ext_vector_type(2)));
DEVI unsigned pk2(float lo, float hi) { const f32x2_t v = {lo, hi}; const bf16x2_t b = __builtin_convertvector(v, bf16x2_t); return __builtin_bit_cast(unsigned, b); }
DEVI unsigned pkh2(float lo, float hi) { const f32x2_t v = {lo, hi}; const f16x2_t b = __builtin_convertvector(v, f16x2_t); return __builtin_bit_cast(unsigned, b); }
DEVI float bflo(unsigned w) { return __uint_as_float(w << 16); }
DEVI float bfhi(unsigned w) { return __uint_as_float(w & 0xffff0000u); }
DEVI float wave_sum(float v) {
#pragma unroll
    for (int o = 1; o < 64; o <<= 1) v += __shfl_xor(v, o);
    return v;
}
DEVI float wave_max(float v) {
#pragma unroll
    for (int o = 1; o < 64; o <<= 1) v = fmaxf(v, __shfl_xor(v, o));
    return v;
}
DEVI int perm32(int rho) { const int n = rho >> 4, i = rho & 15; return 8 * (i >> 2) + 4 * n + (i & 3); }
DEVI f32x4 mfma16(bf16x8 a, bf16x8 b, f32x4 c) { return __builtin_amdgcn_mfma_f32_16x16x32_bf16(a, b, c, 0, 0, 0); }
DEVI f32x16 mfma32(bf16x8 a, bf16x8 b, f32x16 c) { return __builtin_amdgcn_mfma_f32_32x32x16_bf16(a, b, c, 0, 0, 0); }

DEVI void p0_transpose_item(const float* __restrict__ W, const int ldw, const int srccol0, u16* __restrict__ dst, const int n0, const int k0, float* scr, const int lane) {
    { float tv[32];
#pragma unroll
      for (int i = 0; i < 32; ++i) tv[i] = W[(size_t)(k0 + 2 * i + (lane >> 5)) * ldw + srccol0 + (lane & 31)];
#pragma unroll
      for (int i = 0; i < 32; ++i) scr[(2 * i + (lane >> 5)) * 33 + (lane & 31)] = tv[i]; }
    asm volatile("s_waitcnt lgkmcnt(0)" ::: "memory");
    const int c = lane & 7;
#pragma unroll
    for (int j = 0; j < 4; ++j) {
        const int slot = (lane >> 3) + 8 * j, cl = perm32(slot);
        const float* sp = scr + (8 * c) * 33 + cl;
        u32x4 o; o.x = pk2(sp[0], sp[33]); o.y = pk2(sp[2 * 33], sp[3 * 33]); o.z = pk2(sp[4 * 33], sp[5 * 33]); o.w = pk2(sp[6 * 33], sp[7 * 33]);
        *(u32x4*)(dst + (size_t)(n0 + slot) * 1024 + k0 + 8 * c) = o;
    }
    asm volatile("s_waitcnt lgkmcnt(0)" ::: "memory");
}
__device__ __forceinline__ void phase0(const Params& p) {
    extern __shared__ __attribute__((aligned(16))) unsigned char lds[];
    const int tid = opaque_tid(), lane = tid & 63, wave = tid >> 6;
    float* modp = (float*)(p.ws + WS_MOD);
    for (int job = blockIdx.x; job < 96; job += gridDim.x) {
        float* sc = (float*)lds; float* red = (float*)(lds + 65536);
        for (int i = tid; i < 16384; i += 512) { const float v = p.c[i]; sc[i] = v / (1.f + expf(-v)); }
        __syncthreads();
        const int jl = tid & 31, kq = tid >> 5, j0 = job * 32;
        float acc[16];
#pragma unroll
        for (int b = 0; b < 16; ++b) acc[b] = 0.f;
#pragma unroll 1
        for (int kb = 0; kb < 64; kb += 16) {
            float wv[16];
#pragma unroll
            for (int kk = 0; kk < 16; ++kk) wv[kk] = p.w_ada[(size_t)(kq * 64 + kb + kk) * 3072 + j0 + jl];
#pragma unroll
            for (int kk = 0; kk < 16; ++kk) {
                const int k = kq * 64 + kb + kk;
#pragma unroll
                for (int b = 0; b < 16; ++b) acc[b] += sc[b * 1024 + k] * wv[kk];
            }
        }
#pragma unroll
        for (int b = 0; b < 16; ++b) red[(kq * 16 + b) * 32 + jl] = acc[b];
        __syncthreads();
        { const int b = tid >> 5; float sacc = p.b_ada[j0 + jl];
          for (int q = 0; q < 16; ++q) sacc += red[(q * 16 + b) * 32 + jl];
          modp[b * 3072 + j0 + jl] = sacc; }
        __syncthreads();
    }
    if (blockIdx.x == (gridDim.x > 100 ? 100 : 0)) {
        float* Wg = (float*)(p.ws + WS_WG);
        for (int i = tid; i < 8192; i += 512) { const int g = i & 7, k = i >> 3; Wg[g * 1024 + k] = p.w_in[(size_t)k * 4616 + 2560 + g]; }
    }
    {
        float* scr = (float*)(lds + wave * 8448);
        const int NW = gridDim.x * 8, gw = NW - 1 - (blockIdx.x * 8 + wave);
        for (int it = gw; it < 2816; it += NW) {
            if (it < 2304) { const int nb = it >> 4, kb = it & 15, n0 = nb * 32;
                p0_transpose_item(p.w_in, 4616, n0 < 2560 ? n0 : n0 + 8, (u16*)(p.ws + WS_WTIN), n0, kb * 64, scr, lane); }
            else { const int r2 = it - 2304, nb = r2 >> 4, kb = r2 & 15, n0 = nb * 32;
                p0_transpose_item(p.w_out, 1024, n0, (u16*)(p.ws + WS_WTOUT), n0, kb * 64, scr, lane); }
        }
    }
}

__device__ __forceinline__ void phase1a(const Params& p) {
    extern __shared__ __attribute__((aligned(16))) unsigned char lds[];
    const int tid = opaque_tid(), lane = tid & 63, wave = tid >> 6;
    float* wg_s = (float*)lds;
    { const float* Wg = (const float*)(p.ws + WS_WG); for (int i = tid; i < 8192; i += 512) wg_s[i] = Wg[i]; }
    __syncthreads();
    const float* modp = (const float*)(p.ws + WS_MOD);
    u16* H = (u16*)(p.ws + WS_H); float* gates = (float*)(p.ws + WS_GATES);
    for (int tb = blockIdx.x * 8 + wave; tb < 2048; tb += gridDim.x * 8) {
        const int tok0 = tb * 32, b = tok0 >> 12;
        f32x4 gs[4], sh[4];
#pragma unroll
        for (int j = 0; j < 4; ++j) { const int k = lane * 4 + 256 * j; const f32x4 g = *(const f32x4*)(p.g_pre + k); const f32x4 s = *(const f32x4*)(modp + b * 3072 + 1024 + k);
            sh[j] = *(const f32x4*)(modp + b * 3072 + k); gs[j] = g * (1.f + s); }
        float bias = 0.f; if (lane < 4) bias = p.b_ig[lane]; else if (lane < 8) bias = p.b_fg[lane - 4];
        f32x4 vn[4];
#pragma unroll
        for (int j = 0; j < 4; ++j) vn[j] = __builtin_nontemporal_load((const f32x4*)(p.x + (size_t)tok0 * 1024 + lane * 4 + 256 * j));
        for (int t = 0; t < 32; ++t) {
            const size_t tok = (size_t)tok0 + t;
            f32x4 v[4]; float ss = 0.f;
#pragma unroll
            for (int j = 0; j < 4; ++j) { v[j] = vn[j]; ss += (v[j].x * v[j].x + v[j].y * v[j].y) + (v[j].z * v[j].z + v[j].w * v[j].w); }
            if (t + 1 < 32) {
#pragma unroll
                for (int j = 0; j < 4; ++j) vn[j] = __builtin_nontemporal_load((const f32x4*)(p.x + (tok + 1) * 1024 + lane * 4 + 256 * j));
            }
            ss = wave_sum(ss); const float r = rsqrtf(ss * (1.f / 1024.f) + 1e-6f);
            float part[8];
#pragma unroll
            for (int g = 0; g < 8; ++g) part[g] = 0.f;
#pragma unroll
            for (int j = 0; j < 4; ++j) {
                const f32x4 hv = v[j] * r * gs[j] + sh[j];
                u32x2 o; o.x = pk2(hv.x, hv.y); o.y = pk2(hv.z, hv.w);
                *(u32x2*)(H + tok * 1024 + lane * 4 + 256 * j) = o;
#pragma unroll
                for (int g = 0; g < 8; ++g) { const f32x4 w = *(const f32x4*)(wg_s + g * 1024 + lane * 4 + 256 * j); part[g] += (hv.x * w.x + hv.y * w.y) + (hv.z * w.z + hv.w * w.w); }
            }
#pragma unroll
            for (int g = 0; g < 8; ++g) part[g] = wave_sum(part[g]);
            float ov = part[0];
#pragma unroll
            for (int g = 1; g < 8; ++g) if (lane == g) ov = part[g];
            if (lane < 8) gates[tok * 8 + lane] = ov + bias;
        }
    }
}

constexpr int BM = 256, BK = 64, HALF = 128, HT = HALF * BK;
DEVI int lds_byte(int r, int c) { const int st = (r >> 4) * 2 + (c >> 5), rr = r & 15, cc = c & 31, ob = rr * 64 + cc * 2; return st * 1024 + (ob ^ (((ob >> 9) & 1) << 5)); }
DEVI void stage_rc(int b, int& R, int& C) { const int st = b / 1024, sb = b % 1024, swz = sb ^ (((sb >> 9) & 1) << 5); R = (st >> 1) * 16 + swz / 64; C = (st & 1) * 32 + (swz % 64) / 2; }

DEVI void gemm_unit(const int L, const int nM, const int nN, const int nwg, int& pm, int& pn) {
    int wgid = L;
    { const int q = nwg / 8, r = nwg % 8, xcd = wgid % 8, off = wgid / 8; wgid = (xcd < r ? xcd * (q + 1) : r * (q + 1) + (xcd - r) * q) + off; }
    const int nig = 8 * nN, gid = wgid / nig, fm = gid * 8, gsz = min(nM - fm, 8);
    pm = fm + ((wgid % nig) % gsz); pn = (wgid % nig) / gsz;
}
template <bool NTST>
__device__ __forceinline__ void gemm_phase(const u16* __restrict__ A, const u16* __restrict__ Bt, u16* __restrict__ Out, const int nN, const int ldo) {
    extern __shared__ __attribute__((aligned(16))) unsigned char lds[];
    constexpr int K = 1024;
    const int tid = opaque_tid();
    u16* shm = (u16*)lds;
#define SA(b, h) (shm + ((b) * 2 + (h)) * HT)
#define SB(b, h) (shm + (4 + (b) * 2 + (h)) * HT)
#define STAGE(Pp, BASE, br, kt) do { const u16* _gb = (BASE) + ((size_t)(br) * K + (size_t)(kt) * BK); \
      __builtin_amdgcn_global_load_lds((const unsigned*)(_gb + so0), (unsigned*)((char*)(Pp) + tid * 16), 16, 0, 0); \
      __builtin_amdgcn_global_load_lds((const unsigned*)(_gb + 64 * K + so0), (unsigned*)((char*)(Pp) + tid * 16 + 8192), 16, 0, 0); } while (0)
#define LDA(dst, b, h) for (int m = 0; m < 4; ++m) for (int k = 0; k < 2; ++k) \
    dst[m][k] = *reinterpret_cast<const bf16x8*>((char*)SA(b, h) + lds_byte(wr * 64 + m * 16 + fr, k * 32 + fq * 8))
#define LDB(dst, b, h) for (int n = 0; n < 2; ++n) for (int k = 0; k < 2; ++k) \
    dst[n][k] = *reinterpret_cast<const bf16x8*>((char*)SB(b, h) + lds_byte(wc * 32 + n * 16 + fr, k * 32 + fq * 8))
#define MMA(ai, bj, At_, Bt_) do { __builtin_amdgcn_s_setprio(1); \
    for (int m = 0; m < 4; ++m) for (int n = 0; n < 2; ++n) for (int k = 0; k < 2; ++k) \
      acc[ai][bj][m][n] = __builtin_amdgcn_mfma_f32_16x16x32_bf16(Bt_[n][k], At_[m][k], acc[ai][bj][m][n], 0, 0, 0); \
    __builtin_amdgcn_s_setprio(0); } while (0)
#define WAIT_V(n) asm volatile("s_waitcnt vmcnt(" #n ")" ::: "memory")
#define WAIT_L(n) asm volatile("s_waitcnt lgkmcnt(" #n ")" ::: "memory")
#define BAR __builtin_amdgcn_s_barrier()
#define SCHED __builtin_amdgcn_sched_barrier(0)
#define EPILOGUE(ROW, COL) do { \
    _Pragma("unroll") for (int ai = 0; ai < 2; ++ai) \
    _Pragma("unroll") for (int m = 0; m < 4; ++m) { \
        u16* rowp = Out + (size_t)((ROW) + ai * HALF + wr * 64 + m * 16 + fr) * ldo + (COL) + wc * 32 + 8 * fq; \
        _Pragma("unroll") for (int bj = 0; bj < 2; ++bj) { \
            const f32x4 v0 = acc[ai][bj][m][0], v1 = acc[ai][bj][m][1]; \
            u32x4 w; w.x = pk2(v0[0], v0[1]); w.y = pk2(v0[2], v0[3]); w.z = pk2(v1[0], v1[1]); w.w = pk2(v1[2], v1[3]); \
            if (NTST) __builtin_nontemporal_store(w, (u32x4*)(rowp + bj * HALF)); else *(u32x4*)(rowp + bj * HALF) = w; \
        } } } while (0)
    const int wid = tid >> 6, lane = tid & 63, wr = wid >> 2, wc = wid & 3, fr = lane & 15, fq = lane >> 4;
    unsigned so0;
    { int r_, c_; stage_rc(tid * 16, r_, c_); so0 = (unsigned)(r_ * K + c_); }
    constexpr int nt = K / BK;
    const int nM = NTOK / BM, nwg = nM * nN, G = gridDim.x;
    int L = blockIdx.x;
    if (L < nwg) {
        int brow, bcol;
        { int pm, pn; gemm_unit(L, nM, nN, nwg, pm, pn); brow = pm * BM; bcol = pn * BM; }
        f32x4 acc[2][2][4][2] = {};
        bf16x8 At[4][2], B0[2][2], B1[2][2];
        STAGE(SB(0, 0), Bt, bcol, 0); STAGE(SA(0, 0), A, brow, 0);
        STAGE(SB(0, 1), Bt, bcol + HALF, 0); STAGE(SA(0, 1), A, brow + HALF, 0);
        if (wr == 1) BAR;
        WAIT_V(4); BAR;
        STAGE(SB(1, 0), Bt, bcol, 1); STAGE(SA(1, 0), A, brow, 1); STAGE(SB(1, 1), Bt, bcol + HALF, 1);
        WAIT_V(6); BAR;
        for (;;) {
            const bool last = (L + G >= nwg);
            int nbrow = brow, nbcol = bcol;
            if (!last) { int qm, qn; gemm_unit(L + G, nM, nN, nwg, qm, qn); nbrow = qm * BM; nbcol = qn * BM; }
            const int tend = last ? nt - 2 : nt;
            for (int t = 0; t < tend; t += 2) {
                const bool bnd = (t == nt - 2);
                const int r2 = bnd ? nbrow : brow, c2 = bnd ? nbcol : bcol, k2 = bnd ? 0 : t + 2, k3 = bnd ? 1 : t + 3;
                LDB(B0, 0, 0); SCHED; LDA(At, 0, 0); STAGE(SA(1, 1), A, brow + HALF, t + 1);
                WAIT_L(8); BAR; WAIT_L(0); MMA(0, 0, At, B0); BAR; SCHED;
                LDB(B1, 0, 1); STAGE(SB(0, 0), Bt, c2, k2);
                BAR; WAIT_L(0); MMA(0, 1, At, B1); BAR;
                LDA(At, 0, 1); STAGE(SA(0, 0), A, r2, k2);
                BAR; WAIT_L(0); MMA(1, 0, At, B0); BAR; SCHED;
                STAGE(SB(0, 1), Bt, c2 + HALF, k2);
                WAIT_V(6); BAR; MMA(1, 1, At, B1); BAR;
                LDB(B0, 1, 0); SCHED; LDA(At, 1, 0); STAGE(SA(0, 1), A, r2 + HALF, k2);
                WAIT_L(8); BAR; WAIT_L(0); MMA(0, 0, At, B0); BAR; SCHED;
                LDB(B1, 1, 1); STAGE(SB(1, 0), Bt, c2, k3);
                BAR; WAIT_L(0); MMA(0, 1, At, B1); BAR;
                LDA(At, 1, 1); STAGE(SA(1, 0), A, r2, k3);
                BAR; WAIT_L(0); MMA(1, 0, At, B0); BAR; SCHED;
                STAGE(SB(1, 1), Bt, c2 + HALF, k3);
                WAIT_V(6); BAR; MMA(1, 1, At, B1); BAR;
            }
            if (last) break;
            EPILOGUE(brow, bcol);
#pragma unroll
            for (int ai = 0; ai < 2; ++ai)
#pragma unroll
                for (int bj = 0; bj < 2; ++bj)
#pragma unroll
                    for (int m = 0; m < 4; ++m)
#pragma unroll
                        for (int n = 0; n < 2; ++n) acc[ai][bj][m][n] = (f32x4){0.f, 0.f, 0.f, 0.f};
            brow = nbrow; bcol = nbcol; L += G;
        }
        { LDB(B0, 0, 0); LDA(At, 0, 0); STAGE(SA(1, 1), A, brow + HALF, nt - 1);
          BAR; WAIT_L(0); MMA(0, 0, At, B0); BAR;
          LDB(B1, 0, 1); BAR; WAIT_L(0); MMA(0, 1, At, B1); BAR;
          LDA(At, 0, 1); WAIT_V(4); BAR; WAIT_L(0); MMA(1, 0, At, B0); MMA(1, 1, At, B1); BAR; }
        { LDB(B0, 1, 0); LDA(At, 1, 0); WAIT_V(2); BAR; WAIT_L(0); MMA(0, 0, At, B0); BAR;
          LDB(B1, 1, 1); WAIT_V(0); BAR; WAIT_L(0); MMA(0, 1, At, B1); BAR;
          LDA(At, 1, 1); BAR; WAIT_L(0); MMA(1, 0, At, B0); MMA(1, 1, At, B1); BAR; }
        if (wr == 0) BAR;
        EPILOGUE(brow, bcol);
    }
    __syncthreads();
#undef SA
#undef SB
#undef STAGE
#undef LDA
#undef LDB
#undef MMA
#undef EPILOGUE
}

__device__ __forceinline__ void mlstm_pass1(const Params& p, const int item, const int grp) {
    extern __shared__ __attribute__((aligned(16))) unsigned char lds[];
    const int tid = opaque_tid(), lane = tid & 63, w = tid >> 6, i16 = lane & 15, g4 = lane >> 4;
    const int b = item >> 2, hh = item & 3;
    u16* q_s = (u16*)(lds + 0); u16* k_s = (u16*)(lds + 17408); float* out_s = (float*)lds;
    u16* wkT_s = (u16*)(lds + 34816); u16* vT_s = (u16*)(lds + 53248); u16* S_s = (u16*)(lds + 73984);
    u16* CT_s = (u16*)(lds + 83200); float* den_s = (float*)(lds + 122368); float* a_s = (float*)(lds + 122368 + 256); float* ml_s = a_s + 64;
    const u16* P = (const u16*)(p.ws + WS_P); const float* gates = (const float*)(p.ws + WS_GATES);
    u16* NDn = (u16*)(p.ws + WS_NDNUM); u16* Q2 = (u16*)(p.ws + WS_Q2); float* AUX = (float*)(p.ws + WS_AUX);
    const int c0 = grp * 16;
    const size_t tokb = (size_t)b * 4096;
    for (int i = tid; i < 144 * 136 / 2; i += 512) ((unsigned*)CT_s)[i] = 0u;
    for (int i = tid; i < 16 * 72; i += 512) vT_s[128 * 72 + i] = (i < 72) ? (u16)0x3F80 : (u16)0;
    const int cp = tid & 63, t0 = 8 * w, ch = 2 * cp;
    float cwq[4][2], cwk[4][2], cbq[2], cbk[2];
#pragma unroll
    for (int j = 0; j < 4; ++j)
#pragma unroll
        for (int e = 0; e < 2; ++e) { cwq[j][e] = p.conv_w[j * 1024 + hh * 128 + ch + e]; cwk[j][e] = p.conv_w[j * 1024 + 512 + hh * 128 + ch + e]; }
#pragma unroll
    for (int e = 0; e < 2; ++e) { cbq[e] = p.conv_b[hh * 128 + ch + e]; cbk[e] = p.conv_b[512 + hh * 128 + ch + e]; }
    f32x4 Cacc[8], Cacc8 = {0.f, 0.f, 0.f, 0.f};
#pragma unroll
    for (int i = 0; i < 8; ++i) Cacc[i] = (f32x4){0.f, 0.f, 0.f, 0.f};
    for (int cc = w; cc < c0; cc += 8) {
        const size_t tk = tokb + (size_t)cc * 64 + lane;
        const float gi = gates[tk * 8 + hh], gf = gates[tk * 8 + 4 + hh];
        const float logf = fminf(gf, 0.f) - log1pf(expf(-fabsf(gf)));
        float bcs = logf;
#pragma unroll
        for (int o = 1; o < 64; o <<= 1) { const float u = __shfl_up(bcs, o); if (lane >= o) bcs += u; }
        const float a_tot = __shfl(bcs, 63);
        const float igb = gi - bcs;
        const float gg = a_tot + igb;
        const float m_loc = wave_max(gg);
        if (lane == 0) { a_s[cc] = a_tot; ml_s[cc] = m_loc; }
    }
    __syncthreads();
    float m_prev = 0.f;
    for (int cc = 0; cc < c0; ++cc) m_prev = fmaxf(a_s[cc] + m_prev, ml_s[cc]);
    float Pc = 1.f;
    const int et = tid >> 3, ec = (tid & 7) * 16;
    unsigned rq[11], rk[11], rv[8]; float gi_n, gf_n;
    {
        const size_t tokc = tokb + (size_t)c0 * 64;
#pragma unroll
        for (int i = 0; i < 11; ++i) { const int row = t0 - 3 + i; const bool ok = (c0 > 0) || (row >= 0); const size_t o = (size_t)((long)tokc + (ok ? row : 0)) * NP + hh * 128 + ch;
            rq[i] = ok ? *(const unsigned*)(P + o) : 0u; rk[i] = ok ? *(const unsigned*)(P + o + 512) : 0u; }
#pragma unroll
        for (int i = 0; i < 8; ++i) rv[i] = *(const unsigned*)(P + (tokc + t0 + i) * NP + 1024 + hh * 128 + ch);
        gi_n = gates[(tokc + lane) * 8 + hh]; gf_n = gates[(tokc + lane) * 8 + 4 + hh];
    }
    for (int c = c0; c < c0 + 16; ++c) {
        const size_t tokc = tokb + (size_t)c * 64;
        const size_t tq = (size_t)item * 4096 + (size_t)c * 64;
        const float gi = gi_n, gf = gf_n;
        const float logf = fminf(gf, 0.f) - log1pf(expf(-fabsf(gf)));
        float bcs = logf;
#pragma unroll
        for (int o = 1; o < 64; o <<= 1) { const float u = __shfl_up(bcs, o); if (lane >= o) bcs += u; }
        const float a_tot = __shfl(bcs, 63);
        const float igb = gi - bcs;
        const float gg = a_tot + igb;
        const float m_loc = wave_max(gg);
        const float m_new = fmaxf(a_tot + m_prev, m_loc);
        const float s_old = expf(a_tot + m_prev - m_new);
        const float wp = expf(gg - m_new);
        float mx = igb;
#pragma unroll
        for (int o = 1; o < 64; o <<= 1) { const float u = __shfl_up(mx, o); if (lane >= o) mx = fmaxf(mx, u); }
        const float m_t = bcs + fmaxf(m_prev, mx);
        const float iw = expf(bcs + m_prev - m_t);
        const float bm = bcs - m_t;
        {
            float kv0[8], kv1[8];
#pragma unroll
            for (int i = 0; i < 8; ++i) {
                float aq0 = cbq[0], aq1 = cbq[1], ak0 = cbk[0], ak1 = cbk[1];
#pragma unroll
                for (int j = 0; j < 4; ++j) { aq0 += cwq[j][0] * bflo(rq[i + j]); aq1 += cwq[j][1] * bfhi(rq[i + j]); ak0 += cwk[j][0] * bflo(rk[i + j]); ak1 += cwk[j][1] * bfhi(rk[i + j]); }
                const float q0 = aq0 * __builtin_amdgcn_rcpf(1.f + __expf(-aq0)), q1 = aq1 * __builtin_amdgcn_rcpf(1.f + __expf(-aq1));
                const float k0 = ak0 * __builtin_amdgcn_rcpf(1.f + __expf(-ak0)) * 0.08838834764831845f, k1 = ak1 * __builtin_amdgcn_rcpf(1.f + __expf(-ak1)) * 0.08838834764831845f;
                *(unsigned*)(q_s + (t0 + i) * 136 + ch) = pk2(q0, q1);
                *(unsigned*)(k_s + (t0 + i) * 136 + ch) = pk2(k0, k1);
                const float wpi = __shfl(wp, t0 + i);
                kv0[i] = k0 * wpi; kv1[i] = k1 * wpi;
            }
            u32x4 o0, o1;
            o0.x = pk2(kv0[0], kv0[1]); o0.y = pk2(kv0[2], kv0[3]); o0.z = pk2(kv0[4], kv0[5]); o0.w = pk2(kv0[6], kv0[7]);
            o1.x = pk2(kv1[0], kv1[1]); o1.y = pk2(kv1[2], kv1[3]); o1.z = pk2(kv1[4], kv1[5]); o1.w = pk2(kv1[6], kv1[7]);
            *(u32x4*)(wkT_s + ch * 72 + t0) = o0; *(u32x4*)(wkT_s + (ch + 1) * 72 + t0) = o1;
            u32x4 v0, v1;
            v0.x = (rv[0] & 0xffffu) | (rv[1] << 16); v0.y = (rv[2] & 0xffffu) | (rv[3] << 16); v0.z = (rv[4] & 0xffffu) | (rv[5] << 16); v0.w = (rv[6] & 0xffffu) | (rv[7] << 16);
            v1.x = (rv[0] >> 16) | (rv[1] & 0xffff0000u); v1.y = (rv[2] >> 16) | (rv[3] & 0xffff0000u); v1.z = (rv[4] >> 16) | (rv[5] & 0xffff0000u); v1.w = (rv[6] >> 16) | (rv[7] & 0xffff0000u);
            *(u32x4*)(vT_s + ch * 72 + t0) = v0; *(u32x4*)(vT_s + (ch + 1) * 72 + t0) = v1;
        }
        if (c + 1 < c0 + 16) {
            const size_t tn = tokc + 64;
#pragma unroll
            for (int i = 0; i < 11; ++i) { const size_t o = (tn + t0 - 3 + i) * NP + hh * 128 + ch; rq[i] = *(const unsigned*)(P + o); rk[i] = *(const unsigned*)(P + o + 512); }
#pragma unroll
            for (int i = 0; i < 8; ++i) rv[i] = *(const unsigned*)(P + (tn + t0 + i) * NP + 1024 + hh * 128 + ch);
            gi_n = gates[(tn + lane) * 8 + hh]; gf_n = gates[(tn + lane) * 8 + 4 + hh];
        }
        __syncthreads();
        {
            const u32x4 qa = *(const u32x4*)(q_s + et * 136 + ec), qb = *(const u32x4*)(q_s + et * 136 + ec + 8);
            u16* qd = Q2 + (tq + et) * 128 + ec; *(u32x4*)qd = qa; *(u32x4*)(qd + 8) = qb;
            if (w == 0) { AUX[(tq + lane) * 4 + 0] = iw * Pc; AUX[(tq + lane) * 4 + 1] = expf(-m_t); }
        }
        {
            const int ti = w >> 1;
#pragma unroll
            for (int sj = 0; sj < 2; ++sj) {
                const int si = 2 * (w & 1) + sj;
                f32x4 acc = {0.f, 0.f, 0.f, 0.f};
                if (si <= ti) {
#pragma unroll
                    for (int ks = 0; ks < 4; ++ks) {
                        const bf16x8 a = *(const bf16x8*)(q_s + (16 * ti + i16) * 136 + 32 * ks + 8 * g4);
                        const bf16x8 bb = *(const bf16x8*)(k_s + (16 * si + i16) * 136 + 32 * ks + 8 * g4);
                        acc = mfma16(a, bb, acc);
                    }
                }
                const int s = 16 * si + i16; const float igb_s = __shfl(igb, s);
#pragma unroll
                for (int r = 0; r < 4; ++r) {
                    const int t = 16 * ti + 4 * g4 + r; const float bm_t = __shfl(bm, t);
                    const float val = (s <= t) ? acc[r] * __expf(bm_t + igb_s) : 0.f;
                    S_s[t * 72 + s] = (u16)(pk2(val, 0.f) & 0xffffu);
                }
            }
        }
        f32x4 accO[4], accO8 = {0.f, 0.f, 0.f, 0.f};
#pragma unroll
        for (int ti = 0; ti < 4; ++ti) {
            f32x4 acc = {0.f, 0.f, 0.f, 0.f};
#pragma unroll
            for (int ks = 0; ks < 4; ++ks) {
                const bf16x8 a = *(const bf16x8*)(q_s + (16 * ti + i16) * 136 + 32 * ks + 8 * g4);
                const bf16x8 bb = *(const bf16x8*)(CT_s + (16 * w + i16) * 136 + 32 * ks + 8 * g4);
                acc = mfma16(a, bb, acc);
            }
#pragma unroll
            for (int r = 0; r < 4; ++r) acc[r] *= __shfl(iw, 16 * ti + 4 * g4 + r);
            accO[ti] = acc;
        }
        if (w < 4) {
            f32x4 acc = {0.f, 0.f, 0.f, 0.f};
#pragma unroll
            for (int ks = 0; ks < 4; ++ks) {
                const bf16x8 a = *(const bf16x8*)(q_s + (16 * w + i16) * 136 + 32 * ks + 8 * g4);
                const bf16x8 bb = *(const bf16x8*)(CT_s + (128 + i16) * 136 + 32 * ks + 8 * g4);
                acc = mfma16(a, bb, acc);
            }
#pragma unroll
            for (int r = 0; r < 4; ++r) acc[r] *= __shfl(iw, 16 * w + 4 * g4 + r);
            accO8 = acc;
        }
        __syncthreads();
#pragma unroll
        for (int ti = 0; ti < 4; ++ti)
#pragma unroll
            for (int ks = 0; ks < 2; ++ks) {
                const bf16x8 a = *(const bf16x8*)(S_s + (16 * ti + i16) * 72 + 32 * ks + 8 * g4);
                const bf16x8 bb = *(const bf16x8*)(vT_s + (16 * w + i16) * 72 + 32 * ks + 8 * g4);
                accO[ti] = mfma16(a, bb, accO[ti]);
            }
        if (w < 4) {
#pragma unroll
            for (int ks = 0; ks < 2; ++ks) {
                const bf16x8 a = *(const bf16x8*)(S_s + (16 * w + i16) * 72 + 32 * ks + 8 * g4);
                const bf16x8 bb = *(const bf16x8*)(vT_s + (128 + i16) * 72 + 32 * ks + 8 * g4);
                accO8 = mfma16(a, bb, accO8);
            }
        }
#pragma unroll
        for (int ti = 0; ti < 4; ++ti)
#pragma unroll
            for (int r = 0; r < 4; ++r) out_s[(16 * ti + 4 * g4 + r) * 132 + 16 * w + i16] = accO[ti][r];
        if (w < 4 && i16 == 0) {
#pragma unroll
            for (int r = 0; r < 4; ++r) den_s[16 * w + 4 * g4 + r] = accO8[r];
        }
        __syncthreads();
        {
            float nv[16];
#pragma unroll
            for (int j = 0; j < 16; ++j) nv[j] = out_s[et * 132 + ec + j];
            u32x4 s0, s1;
            s0.x = pk2(nv[0], nv[1]); s0.y = pk2(nv[2], nv[3]); s0.z = pk2(nv[4], nv[5]); s0.w = pk2(nv[6], nv[7]);
            s1.x = pk2(nv[8], nv[9]); s1.y = pk2(nv[10], nv[11]); s1.z = pk2(nv[12], nv[13]); s1.w = pk2(nv[14], nv[15]);
            u16* dst = NDn + (tq + et) * 128 + ec;
            *(u32x4*)dst = s0; *(u32x4*)(dst + 8) = s1;
            if ((tid & 7) == 0) AUX[(tq + et) * 4 + 2] = den_s[et];
        }
#pragma unroll
        for (int ki = 0; ki < 8; ++ki) {
            f32x4 acc = Cacc[ki] * s_old;
#pragma unroll
            for (int ks = 0; ks < 2; ++ks) {
                const bf16x8 a = *(const bf16x8*)(wkT_s + (16 * ki + i16) * 72 + 32 * ks + 8 * g4);
                const bf16x8 bb = *(const bf16x8*)(vT_s + (16 * w + i16) * 72 + 32 * ks + 8 * g4);
                acc = mfma16(a, bb, acc);
            }
            Cacc[ki] = acc;
            u32x2 pkd; pkd.x = pk2(acc[0], acc[1]); pkd.y = pk2(acc[2], acc[3]);
            *(u32x2*)(CT_s + (16 * w + i16) * 136 + 16 * ki + 4 * g4) = pkd;
        }
        {
            f32x4 acc = Cacc8 * s_old;
#pragma unroll
            for (int ks = 0; ks < 2; ++ks) {
                const bf16x8 a = *(const bf16x8*)(wkT_s + (16 * w + i16) * 72 + 32 * ks + 8 * g4);
                const bf16x8 bb = *(const bf16x8*)(vT_s + (128 + i16) * 72 + 32 * ks + 8 * g4);
                acc = mfma16(a, bb, acc);
            }
            Cacc8 = acc;
            u32x2 pkd; pkd.x = pk2(acc[0], acc[1]); pkd.y = pk2(acc[2], acc[3]);
            *(u32x2*)(CT_s + (128 + i16) * 136 + 16 * w + 4 * g4) = pkd;
        }
        m_prev = m_new; Pc *= s_old;
        __syncthreads();
    }
    {
        float* E = (float*)(p.ws + WS_E) + (size_t)(item * 4 + grp) * 144 * 128;
#pragma unroll
        for (int ki = 0; ki < 8; ++ki) *(f32x4*)(E + (16 * w + i16) * 128 + 16 * ki + 4 * g4) = Cacc[ki];
        *(f32x4*)(E + (128 + i16) * 128 + 16 * w + 4 * g4) = Cacc8;
        if (tid == 0) ((float*)(p.ws + WS_DG))[item * 4 + grp] = Pc;
    }
}

__device__ __forceinline__ void mlstm_pass2(const Params& p, const int item, const int grp) {
    extern __shared__ __attribute__((aligned(16))) unsigned char lds[];
    const int tid = opaque_tid(), lane = tid & 63, w = tid >> 6, i16 = lane & 15, g4 = lane >> 4;
    const int b = item >> 2, hh = item & 3;
    u16* q_s = (u16*)(lds + 0); float* o2_s = (float*)(lds + 17408); float* den2_s = (float*)(lds + 51200); u16* CT_s = (u16*)(lds + 83200);
    const u16* P = (const u16*)(p.ws + WS_P); u16* Hm = (u16*)(p.ws + WS_HMIX);
    const u16* NDn = (const u16*)(p.ws + WS_NDNUM); const u16* Q2 = (const u16*)(p.ws + WS_Q2); const float* AUX = (const float*)(p.ws + WS_AUX);
    const size_t tokb = (size_t)b * 4096;
    const int et = tid >> 3, ec = (tid & 7) * 16;
    if (grp > 0) {
        float cf[3] = {0.f, 0.f, 0.f}; float run = 1.f;
#pragma unroll
        for (int gp = 2; gp >= 0; --gp) if (gp < grp) { cf[gp] = run; run *= __hip_atomic_load((float*)(p.ws + WS_DG) + item * 4 + gp, __ATOMIC_RELAXED, __HIP_MEMORY_SCOPE_AGENT); }
        const float* E = (const float*)(p.ws + WS_E) + (size_t)(item * 4) * 144 * 128;
        for (int i4 = tid; i4 < 144 * 128 / 4; i4 += 512) {
            const int i = i4 * 4;
            f32x4 sacc = {0.f, 0.f, 0.f, 0.f};
#pragma unroll
            for (int gp = 0; gp < 3; ++gp) if (gp < grp) sacc += cf[gp] * *(const f32x4*)(E + (size_t)gp * 144 * 128 + i);
            u32x2 w; w.x = pk2(sacc[0], sacc[1]); w.y = pk2(sacc[2], sacc[3]);
            *(u32x2*)(CT_s + (i >> 7) * 136 + (i & 127)) = w;
        }
    }
    __syncthreads();
    float gml[16];
#pragma unroll
    for (int j = 0; j < 16; ++j) gml[j] = p.g_ml[hh * 128 + ec + j];
    u32x4 qa_n, qb_n, nd_n[2], ov_n[2], zv_n[2]; f32x4 ax_n;
    {
        const int c = grp * 16;
        const size_t tokc = tokb + (size_t)c * 64, tq = (size_t)item * 4096 + (size_t)c * 64;
        const u16* qsrc = Q2 + (tq + et) * 128 + ec; qa_n = *(const u32x4*)qsrc; qb_n = *(const u32x4*)(qsrc + 8);
        ax_n = *(const f32x4*)(AUX + (tq + lane) * 4);
        const u16* ns = NDn + (tq + et) * 128 + ec; nd_n[0] = *(const u32x4*)ns; nd_n[1] = *(const u32x4*)(ns + 8);
        const u16* po = P + (tokc + et) * NP + 1536 + hh * 128 + ec; ov_n[0] = *(const u32x4*)po; ov_n[1] = *(const u32x4*)(po + 8);
        zv_n[0] = *(const u32x4*)(po + 512); zv_n[1] = *(const u32x4*)(po + 520);
    }
    for (int cl = 0; cl < 16; ++cl) {
        const int c = grp * 16 + cl;
        const size_t tokc = tokb + (size_t)c * 64;
        *(u32x4*)(q_s + et * 136 + ec) = qa_n; *(u32x4*)(q_s + et * 136 + ec + 8) = qb_n;
        const f32x4 ax = ax_n;
        u32x4 nd[2], ov[2], zv[2];
        nd[0] = nd_n[0]; nd[1] = nd_n[1]; ov[0] = ov_n[0]; ov[1] = ov_n[1]; zv[0] = zv_n[0]; zv[1] = zv_n[1];
        __syncthreads();
        if (cl + 1 < 16) {
            const size_t tokn = tokc + 64, tqn = (size_t)item * 4096 + (size_t)(c + 1) * 64;
            const u16* qsrc = Q2 + (tqn + et) * 128 + ec; qa_n = *(const u32x4*)qsrc; qb_n = *(const u32x4*)(qsrc + 8);
            ax_n = *(const f32x4*)(AUX + (tqn + lane) * 4);
            const u16* ns = NDn + (tqn + et) * 128 + ec; nd_n[0] = *(const u32x4*)ns; nd_n[1] = *(const u32x4*)(ns + 8);
            const u16* po = P + (tokn + et) * NP + 1536 + hh * 128 + ec; ov_n[0] = *(const u32x4*)po; ov_n[1] = *(const u32x4*)(po + 8);
            zv_n[0] = *(const u32x4*)(po + 512); zv_n[1] = *(const u32x4*)(po + 520);
        }
        asm volatile("" ::: "memory");
        if (grp > 0) {
#pragma unroll
            for (int ti = 0; ti < 4; ++ti) {
                f32x4 acc = {0.f, 0.f, 0.f, 0.f};
#pragma unroll
                for (int ks = 0; ks < 4; ++ks) {
                    const bf16x8 a = *(const bf16x8*)(q_s + (16 * ti + i16) * 136 + 32 * ks + 8 * g4);
                    const bf16x8 bb = *(const bf16x8*)(CT_s + (16 * w + i16) * 136 + 32 * ks + 8 * g4);
                    acc = mfma16(a, bb, acc);
                }
#pragma unroll
                for (int r = 0; r < 4; ++r) o2_s[(16 * ti + 4 * g4 + r) * 132 + 16 * w + i16] = acc[r] * __shfl(ax.x, 16 * ti + 4 * g4 + r);
            }
            if (w < 4) {
                f32x4 acc = {0.f, 0.f, 0.f, 0.f};
#pragma unroll
                for (int ks = 0; ks < 4; ++ks) {
                    const bf16x8 a = *(const bf16x8*)(q_s + (16 * w + i16) * 136 + 32 * ks + 8 * g4);
                    const bf16x8 bb = *(const bf16x8*)(CT_s + (128 + i16) * 136 + 32 * ks + 8 * g4);
                    acc = mfma16(a, bb, acc);
                }
#pragma unroll
                for (int r = 0; r < 4; ++r) { const float v = acc[r] * __shfl(ax.x, 16 * w + 4 * g4 + r); if (i16 == 0) den2_s[16 * w + 4 * g4 + r] = v; }
            }
        }
        __syncthreads();
        {
            const float den = __shfl(ax.z, et) + (grp > 0 ? den2_s[et] : 0.f);
            const float inv = 1.f / fmaxf(fabsf(den), __shfl(ax.y, et));
            float ho[16]; float ss = 0.f;
#pragma unroll
            for (int j = 0; j < 16; ++j) {
                const unsigned wn = nd[j >> 3][(j >> 1) & 3]; float num = (j & 1) ? bfhi(wn) : bflo(wn);
                if (grp > 0) num += o2_s[et * 132 + ec + j];
                const unsigned wv = ov[j >> 3][(j >> 1) & 3]; const float o = (j & 1) ? bfhi(wv) : bflo(wv);
                ho[j] = num * inv * __builtin_amdgcn_rcpf(1.f + __expf(-o)); ss += ho[j] * ho[j];
            }
            ss += __shfl_xor(ss, 1); ss += __shfl_xor(ss, 2); ss += __shfl_xor(ss, 4);
            const float rr = rsqrtf(ss * (1.f / 128.f) + 1e-6f);
            float ob[16];
#pragma unroll
            for (int j = 0; j < 16; ++j) {
                const unsigned wv = zv[j >> 3][(j >> 1) & 3]; const float z = (j & 1) ? bfhi(wv) : bflo(wv);
                ob[j] = ho[j] * rr * gml[j] * (z * __builtin_amdgcn_rcpf(1.f + __expf(-z)));
            }
            u32x4 s0, s1;
            s0.x = pk2(ob[0], ob[1]); s0.y = pk2(ob[2], ob[3]); s0.z = pk2(ob[4], ob[5]); s0.w = pk2(ob[6], ob[7]);
            s1.x = pk2(ob[8], ob[9]); s1.y = pk2(ob[10], ob[11]); s1.z = pk2(ob[12], ob[13]); s1.w = pk2(ob[14], ob[15]);
            u16* dst = Hm + (tokc + et) * 1024 + hh * 128 + ec;
            *(u32x4*)dst = s0; *(u32x4*)(dst + 8) = s1;
        }
        __syncthreads();
    }
}

__device__ __forceinline__ void sb_unit(const Params& p, const int unit, u16* vT, const int lane) {
    const u16* P = (const u16*)(p.ws + WS_P); u16* Hm = (u16*)(p.ws + WS_HMIX);
    const int qt = unit & 127, hd = (unit >> 7) & 7, b = unit >> 10;
    const int r = lane & 31, h = lane >> 5;
    const size_t tokb = (size_t)b * 4096;
    bf16x8 qf[4];
    { const u16* qrow = P + (tokb + qt * 32 + r) * NP + 2560 + hd * 64 + 8 * h;
#pragma unroll
      for (int ks = 0; ks < 4; ++ks) qf[ks] = *(const bf16x8*)(qrow + 16 * ks); }
    u32x4 Tw[2];
#pragma unroll
    for (int st = 0; st < 2; ++st) {
        unsigned tw[4];
#pragma unroll
        for (int e = 0; e < 8; e += 2) {
            const int j0 = 16 * st + 8 * (e >> 2) + 4 * h + (e & 3), j1 = j0 + 1;
            tw[e >> 1] = ((j0 > r) ? 0x3C00u : 0u) | ((j1 > r) ? 0x3C000000u : 0u);
        }
        Tw[st].x = tw[0]; Tw[st].y = tw[1]; Tw[st].z = tw[2]; Tw[st].w = tw[3];
    }
    f32x16 O0, O1;
#pragma unroll
    for (int i = 0; i < 16; ++i) { O0[i] = 0.f; O1[i] = 0.f; }
    float R2 = 0.f;
    const float SC = 0.125f * 1.4426950408889634f;
    const size_t tok = tokb + qt * 32 + r;
    u32x2 zz8[8];
#pragma unroll
    for (int i = 0; i < 8; ++i) zz8[i] = *(const u32x2*)(P + tok * NP + 4096 + hd * 64 + 32 * (i >> 2) + 8 * (i & 3) + 4 * h);
    asm volatile("" ::: "memory");
    bf16x8 kfn[4]; u32x4 vvn[4];
    { const u16* krow = P + (tokb + qt * 32 + r) * NP + 3072 + hd * 64 + 8 * h;
#pragma unroll
      for (int ks = 0; ks < 4; ++ks) kfn[ks] = *(const bf16x8*)(krow + 16 * ks);
      const u16* vrow = P + (tokb + qt * 32 + (lane >> 1)) * NP + 3584 + hd * 64 + (lane & 1) * 32;
#pragma unroll
      for (int i = 0; i < 4; ++i) vvn[i] = *(const u32x4*)(vrow + 8 * i); }
    bool have = true;
    for (int kb = qt; kb >= 0; --kb) {
        if (!have) {
            const u16* krow = P + (tokb + kb * 32 + r) * NP + 3072 + hd * 64 + 8 * h;
#pragma unroll
            for (int ks = 0; ks < 4; ++ks) kfn[ks] = *(const bf16x8*)(krow + 16 * ks);
            const u16* vrow = P + (tokb + kb * 32 + (lane >> 1)) * NP + 3584 + hd * 64 + (lane & 1) * 32;
#pragma unroll
            for (int i = 0; i < 4; ++i) vvn[i] = *(const u32x4*)(vrow + 8 * i);
        }
        bf16x8 kf[4]; u32x4 vv[4];
#pragma unroll
        for (int i = 0; i < 4; ++i) { kf[i] = kfn[i]; vv[i] = vvn[i]; }
        asm volatile("" ::: "memory");
        have = (kb > 0) && __any(R2 > -30.f);
        if (have) {
            const int s1 = (kb - 1) * 32;
            const u16* krow = P + (tokb + s1 + r) * NP + 3072 + hd * 64 + 8 * h;
#pragma unroll
            for (int ks = 0; ks < 4; ++ks) kfn[ks] = *(const bf16x8*)(krow + 16 * ks);
            const u16* vrow = P + (tokb + s1 + (lane >> 1)) * NP + 3584 + hd * 64 + (lane & 1) * 32;
#pragma unroll
            for (int i = 0; i < 4; ++i) vvn[i] = *(const u32x4*)(vrow + 8 * i);
        }
        asm volatile("" ::: "memory");
        f32x16 Z;
#pragma unroll
        for (int i = 0; i < 16; ++i) Z[i] = 0.f;
#pragma unroll
        for (int ks = 0; ks < 4; ++ks) Z = mfma32(kf[ks], qf[ks], Z);
        float lbv[16], lkv[16];
#pragma unroll
        for (int reg = 0; reg < 16; ++reg) {
            const float u = Z[reg] * SC;
            const float sp = __builtin_amdgcn_logf(1.f + __builtin_amdgcn_exp2f(-fabsf(u)));
            lbv[reg] = fminf(u, 0.f) - sp;
            lkv[reg] = lbv[reg] - u;
        }
        if (kb == qt) {
#pragma unroll
            for (int reg = 0; reg < 16; ++reg) {
                const int sl = (reg & 3) + 8 * (reg >> 2) + 4 * h;
                const bool valid = sl < r;
                lbv[reg] = valid ? lbv[reg] : -1e30f;
                lkv[reg] = valid ? lkv[reg] : 0.f;
            }
        }
        u32x4 lw[2];
#pragma unroll
        for (int st = 0; st < 2; ++st) {
            lw[st].x = pkh2(lkv[8 * st + 0], lkv[8 * st + 1]); lw[st].y = pkh2(lkv[8 * st + 2], lkv[8 * st + 3]);
            lw[st].z = pkh2(lkv[8 * st + 4], lkv[8 * st + 5]); lw[st].w = pkh2(lkv[8 * st + 6], lkv[8 * st + 7]);
        }
        f32x16 aft;
#pragma unroll
        for (int i = 0; i < 16; ++i) aft[i] = 0.f;
        aft = __builtin_amdgcn_mfma_f32_32x32x16_f16(__builtin_bit_cast(f16x8, Tw[0]), __builtin_bit_cast(f16x8, lw[0]), aft, 0, 0, 0);
        aft = __builtin_amdgcn_mfma_f32_32x32x16_f16(__builtin_bit_cast(f16x8, Tw[1]), __builtin_bit_cast(f16x8, lw[1]), aft, 0, 0, 0);
        const float tot = __shfl(aft[0] + lkv[0], r);
        bf16x8 pf[2];
#pragma unroll
        for (int st = 0; st < 2; ++st) {
            u32x4 pw;
            pw.x = pk2(__builtin_amdgcn_exp2f(lbv[8 * st + 0] + R2 + aft[8 * st + 0]), __builtin_amdgcn_exp2f(lbv[8 * st + 1] + R2 + aft[8 * st + 1]));
            pw.y = pk2(__builtin_amdgcn_exp2f(lbv[8 * st + 2] + R2 + aft[8 * st + 2]), __builtin_amdgcn_exp2f(lbv[8 * st + 3] + R2 + aft[8 * st + 3]));
            pw.z = pk2(__builtin_amdgcn_exp2f(lbv[8 * st + 4] + R2 + aft[8 * st + 4]), __builtin_amdgcn_exp2f(lbv[8 * st + 5] + R2 + aft[8 * st + 5]));
            pw.w = pk2(__builtin_amdgcn_exp2f(lbv[8 * st + 6] + R2 + aft[8 * st + 6]), __builtin_amdgcn_exp2f(lbv[8 * st + 7] + R2 + aft[8 * st + 7]));
            pf[st] = __builtin_bit_cast(bf16x8, pw);
        }
        {
            const int sv = lane >> 1, db = (lane & 1) * 32;
#pragma unroll
            for (int i = 0; i < 4; ++i)
#pragma unroll
                for (int wq = 0; wq < 4; ++wq) {
                    const unsigned x = vv[i][wq]; const int d = db + 8 * i + 2 * wq;
                    vT[d * 40 + sv] = (u16)(x & 0xffffu); vT[(d + 1) * 40 + sv] = (u16)(x >> 16);
                }
        }
        asm volatile("s_waitcnt lgkmcnt(0)" ::: "memory");
#pragma unroll
        for (int st = 0; st < 2; ++st) {
            const u32x2 a0 = *(const u32x2*)(vT + r * 40 + 16 * st + 4 * h), a1 = *(const u32x2*)(vT + r * 40 + 16 * st + 8 + 4 * h);
            const u32x2 b0 = *(const u32x2*)(vT + (32 + r) * 40 + 16 * st + 4 * h), b1 = *(const u32x2*)(vT + (32 + r) * 40 + 16 * st + 8 + 4 * h);
            u32x4 fa, fb; fa.x = a0.x; fa.y = a0.y; fa.z = a1.x; fa.w = a1.y; fb.x = b0.x; fb.y = b0.y; fb.z = b1.x; fb.w = b1.y;
            O0 = mfma32(__builtin_bit_cast(bf16x8, fa), pf[st], O0);
            O1 = mfma32(__builtin_bit_cast(bf16x8, fb), pf[st], O1);
        }
        asm volatile("s_waitcnt lgkmcnt(0)" ::: "memory");
        R2 += tot;
        if (!__any(R2 > -64.f)) break;
    }
#pragma unroll
    for (int dt = 0; dt < 2; ++dt)
#pragma unroll
        for (int q4 = 0; q4 < 4; ++q4) {
            const int d0 = 32 * dt + 8 * q4 + 4 * h;
            const u32x2 zz = zz8[4 * dt + q4];
            float o[4];
#pragma unroll
            for (int e = 0; e < 4; ++e) {
                const float ov = dt ? O1[4 * q4 + e] : O0[4 * q4 + e];
                const unsigned wv = (e < 2) ? zz.x : zz.y; const float z = (e & 1) ? bfhi(wv) : bflo(wv);
                o[e] = ov * (z * __builtin_amdgcn_rcpf(1.f + __expf(-z)));
            }
            u32x2 st; st.x = pk2(o[0], o[1]); st.y = pk2(o[2], o[3]);
            *(u32x2*)(Hm + tok * 1024 + 512 + hd * 64 + d0) = st;
        }
}

__device__ __forceinline__ void phase2a(const Params& p) {
    for (int u = blockIdx.x; u < 256; u += gridDim.x) { mlstm_pass1(p, u >> 2, u & 3); __syncthreads(); }
}
__device__ __forceinline__ void phase2b(const Params& p) {
    extern __shared__ __attribute__((aligned(16))) unsigned char lds[];
    for (int u = blockIdx.x; u < 256; u += gridDim.x) { mlstm_pass2(p, u >> 2, u & 3); __syncthreads(); }
    const int tid2 = opaque_tid(), lane = tid2 & 63, wave = tid2 >> 6;
    u16* vT = (u16*)(lds + wave * 5120);
    for (int u = blockIdx.x * 8 + wave; u < 16384; u += gridDim.x * 8) sb_unit(p, u, vT, lane);
}

__device__ __forceinline__ void phase4(const Params& p) {
    const int tid = opaque_tid(), lane = tid & 63, wave = tid >> 6;
    const float* modp = (const float*)(p.ws + WS_MOD);
    const u16* Y = (const u16*)(p.ws + WS_Y);
    for (int tb = blockIdx.x * 8 + wave; tb < 2048; tb += gridDim.x * 8) {
        const int tok0 = tb * 32, b = tok0 >> 12;
        f32x4 gg[4];
#pragma unroll
        for (int j = 0; j < 4; ++j) { const int k = lane * 4 + 256 * j; gg[j] = *(const f32x4*)(modp + b * 3072 + 2048 + k) * *(const f32x4*)(p.g_post + k); }
        u32x2 yn[4]; f32x4 xn[4];
#pragma unroll
        for (int j = 0; j < 4; ++j) { yn[j] = *(const u32x2*)(Y + (size_t)tok0 * 1024 + lane * 4 + 256 * j); xn[j] = __builtin_nontemporal_load((const f32x4*)(p.x + (size_t)tok0 * 1024 + lane * 4 + 256 * j)); }
        for (int t = 0; t < 32; ++t) {
            const size_t tok = (size_t)tok0 + t;
            f32x4 y[4], xv[4]; float ss = 0.f;
#pragma unroll
            for (int j = 0; j < 4; ++j) { const u32x2 w = yn[j]; xv[j] = xn[j];
                y[j] = (f32x4){bflo(w.x), bfhi(w.x), bflo(w.y), bfhi(w.y)}; ss += (y[j].x * y[j].x + y[j].y * y[j].y) + (y[j].z * y[j].z + y[j].w * y[j].w); }
            if (t + 1 < 32) {
#pragma unroll
                for (int j = 0; j < 4; ++j) { yn[j] = *(const u32x2*)(Y + (tok + 1) * 1024 + lane * 4 + 256 * j); xn[j] = __builtin_nontemporal_load((const f32x4*)(p.x + (tok + 1) * 1024 + lane * 4 + 256 * j)); }
            }
            ss = wave_sum(ss); const float r = rsqrtf(ss * (1.f / 1024.f) + 1e-6f);
#pragma unroll
            for (int j = 0; j < 4; ++j) __builtin_nontemporal_store(xv[j] + gg[j] * (y[j] * r), (f32x4*)(p.out + tok * 1024 + lane * 4 + 256 * j));
        }
    }
}

DEVI unsigned bar_ld(unsigned* q) { return __hip_atomic_load(q, __ATOMIC_RELAXED, __HIP_MEMORY_SCOPE_AGENT); }
DEVI unsigned bar_add(unsigned* q, unsigned v) { return __hip_atomic_fetch_add(q, v, __ATOMIC_RELAXED, __HIP_MEMORY_SCOPE_AGENT); }
DEVI unsigned xcc_id() { return (unsigned)__builtin_amdgcn_s_getreg((3 << 11) | 20) & 0xFu; }
DEVI void grid_sync0(const Params& p, cg::grid_group& g) {
    asm volatile("s_waitcnt vmcnt(0) lgkmcnt(0)" ::: "memory");
    g.sync();
    if (threadIdx.x == 0) { __builtin_amdgcn_fence(__ATOMIC_ACQUIRE, "agent"); asm volatile("s_waitcnt vmcnt(0)" ::: "memory"); }
    __syncthreads();
}
DEVI void grid_sync(const Params& p, const int idx, const unsigned xcc, const unsigned nloc, const unsigned nxcc) {
    asm volatile("s_waitcnt vmcnt(0) lgkmcnt(0)" ::: "memory");
    __syncthreads();
    if (threadIdx.x == 0) {
        unsigned* bar = (unsigned*)(p.ws + WS_BAR);
        unsigned* xsub = bar + 1024 + (16 * idx + xcc) * 64; unsigned* top = bar + 9216 + 64 * idx;
        const unsigned old = bar_add(xsub, 1u);
        if (old == nloc - 1u) {
            __builtin_amdgcn_fence(__ATOMIC_RELEASE, "agent");
            asm volatile("s_waitcnt vmcnt(0)" ::: "memory");
            bar_add(top, 1u);
        }
        while (bar_ld(top) < nxcc) __builtin_amdgcn_s_sleep(1);
        __builtin_amdgcn_fence(__ATOMIC_ACQUIRE, "agent");
        asm volatile("s_waitcnt vmcnt(0)" ::: "memory");
    }
    __syncthreads();
}
__global__ void __launch_bounds__(512) hymba_fwd(Params p) {
    cg::grid_group grid = cg::this_grid();
    const unsigned xcc = xcc_id();
    if (threadIdx.x == 0) bar_add((unsigned*)(p.ws + WS_BAR) + 64 * xcc, 1u);
    phase0(p);
    if (gridDim.x == 0x7fffffffu) grid_sync0(p, grid);
    if (threadIdx.x == 0) {
        unsigned* bar = (unsigned*)(p.ws + WS_BAR);
        for (;;) { unsigned tot = 0; for (int j = 0; j < 16; ++j) tot += bar_ld(bar + 64 * j); if (tot >= gridDim.x) break; __builtin_amdgcn_s_sleep(1); }
    }
    __syncthreads();
    unsigned nloc, nxcc = 0;
    { unsigned* bar = (unsigned*)(p.ws + WS_BAR); nloc = bar_ld(bar + 64 * xcc);
      for (int j = 0; j < 16; ++j) nxcc += (bar_ld(bar + 64 * j) != 0u) ? 1u : 0u; }
    grid_sync(p, 0, xcc, nloc, nxcc);
    phase1a(p);
    grid_sync(p, 1, xcc, nloc, nxcc);
    gemm_phase<true>((const u16*)(p.ws + WS_H), (const u16*)(p.ws + WS_WTIN), (u16*)(p.ws + WS_P), 18, NP);
    grid_sync(p, 2, xcc, nloc, nxcc);
    phase2a(p);
    grid_sync(p, 5, xcc, nloc, nxcc);
    phase2b(p);
    grid_sync(p, 3, xcc, nloc, nxcc);
    gemm_phase<false>((const u16*)(p.ws + WS_HMIX), (const u16*)(p.ws + WS_WTOUT), (u16*)(p.ws + WS_Y), 4, 1024);
    grid_sync(p, 4, xcc, nloc, nxcc);
    phase4(p);
}

extern "C" void kernel_launch(void* const* d_in, const int* in_sizes, int n_in, void* d_out, int out_size, void* d_ws, size_t ws_size, hipStream_t stream) {
    static int grid_blocks = 0;
    if (!grid_blocks) {
        if (n_in != 13 || out_size != NTOK * DM || ws_size < WS_END) { fprintf(stderr, "kernel_launch: unexpected shapes (n_in %d out %d ws %zu)\n", n_in, out_size, ws_size); grid_blocks = -1; return; }
        int dev = 0, cus = 0, per_cu = 0;
        hipGetDevice(&dev);
        hipDeviceGetAttribute(&cus, hipDeviceAttributeMultiprocessorCount, dev);
        if (hipFuncSetAttribute((const void*)hymba_fwd, hipFuncAttributeMaxDynamicSharedMemorySize, LDS_BYTES) != hipSuccess) fprintf(stderr, "kernel_launch: hipFuncSetAttribute failed\n");
        if (hipOccupancyMaxActiveBlocksPerMultiprocessor(&per_cu, (const void*)hymba_fwd, 512, LDS_BYTES) != hipSuccess || per_cu < 1) { fprintf(stderr, "kernel_launch: occupancy query says %d\n", per_cu); per_cu = 1; }
        (void)hipGetLastError();
        grid_blocks = cus * 1;
    }
    if (grid_blocks < 0) return;
    Params p{};
    p.x = (const float*)d_in[0]; p.c = (const float*)d_in[1]; p.w_ada = (const float*)d_in[2]; p.b_ada = (const float*)d_in[3]; p.g_pre = (const float*)d_in[4];
    p.w_in = (const float*)d_in[5]; p.b_ig = (const float*)d_in[6]; p.b_fg = (const float*)d_in[7]; p.conv_w = (const float*)d_in[8]; p.conv_b = (const float*)d_in[9];
    p.g_ml = (const float*)d_in[10]; p.w_out = (const float*)d_in[11]; p.g_post = (const float*)d_in[12];
    p.out = (float*)d_out; p.ws = (unsigned char*)d_ws;
    if (hipMemsetAsync((unsigned char*)d_ws + WS_BAR, 0, 40960, stream) != hipSuccess) fprintf(stderr, "kernel_launch: memset of the barrier words failed\n");
    void* args[] = {&p};
    hipError_t e = hipLaunchCooperativeKernel((const void*)hymba_fwd, dim3(grid_blocks), dim3(512), args, LDS_BYTES, stream);
    if (e != hipSuccess) fprintf(stderr, "cooperative launch failed: %s (grid %d)\n", hipGetErrorString(e), grid_blocks);
}
```

```cpp
#include <hip/hip_runtime.h>
#include <hip/hip_cooperative_groups.h>
#include <cstdio>
#include <cstdint>
namespace cg = cooperative_groups;

typedef unsigned short u16;
typedef short bf16x8 __attribute__((ext_vector_type(8)));
typedef float f32x4 __attribute__((ext_vector_type(4)));
typedef float f32x16 __attribute__((ext_vector_type(16)));
typedef unsigned u32x4 __attribute__((ext_vector_type(4)));
typedef unsigned u32x2 __attribute__((ext_vector_type(2)));
#define DEVI __device__ __forceinline__

constexpr int NTOK = 65536, DM = 1024, NP = 4608;
constexpr size_t WS_WTIN = 0;
constexpr size_t WS_WTOUT = 9437184;
constexpr size_t WS_WG = 11534336;
constexpr size_t WS_MOD = 11567104;
constexpr size_t WS_BAR = 13860864;
constexpr size_t WS_GATES = 11763712;
constexpr size_t WS_H = 16777216;
constexpr size_t WS_P = WS_H + 134217728;
constexpr size_t WS_HMIX = WS_P + 603979776;
constexpr size_t WS_Y = WS_HMIX + 134217728;
constexpr size_t WS_END = WS_Y + 134217728;
constexpr size_t WS_NDNUM = WS_H;
constexpr size_t WS_Q2 = WS_H + 67108864;
constexpr size_t WS_E = WS_Y;
constexpr size_t WS_AUX = WS_Y + 33554432;
constexpr size_t WS_DG = WS_Y + 41943040;
constexpr int LDS_BYTES = 131072;

#define PIX(tok, col) ((((size_t)((col) >> 6)) * (size_t)NTOK + (size_t)(tok)) * 64 + (size_t)((col) & 63))
constexpr size_t PBLK8 = (size_t)8 * NTOK * 64;
struct Params {
    const float *x, *c, *w_ada, *b_ada, *g_pre, *w_in, *b_ig, *b_fg, *conv_w, *conv_b, *g_ml, *w_out, *g_post;
    float* out;
    unsigned char* ws;
};

DEVI int opaque_tid() { int t = threadIdx.x; asm volatile("" : "+v"(t)); return t; }
typedef __bf16 bf16x2_t __attribute__((ext_vector_type(2)));
typedef _Float16 f16x2_t __attribute__((ext_vector_type(2)));
typedef _Float16 f16x8 __attribute__((ext_vector_type(8)));
typedef float f32x2_t __attribute__((ext_vector_type(2)));
DEVI unsigned pk2(float lo, float hi) { const f32x2_t v = {lo, hi}; const bf16x2_t b = __builtin_convertvector(v, bf16x2_t); return __builtin_bit_cast(unsigned, b); }
DEVI unsigned pkh2(float lo, float hi) { const f32x2_t v = {lo, hi}; const f16x2_t b = __builtin_convertvector(v, f16x2_t); return __builtin_bit_cast(unsigned, b); }
DEVI float bflo(unsigned w) { return __uint_as_float(w << 16); }
DEVI float bfhi(unsigned w) { return __uint_as_float(w & 0xffff0000u); }
DEVI float wave_sum(float v) {
#pragma unroll
    for (int o = 1; o < 64; o <<= 1) v += __shfl_xor(v, o);
    return v;
}
DEVI float wave_max(float v) {
#pragma unroll
    for (int o = 1; o < 64; o <<= 1) v = fmaxf(v, __shfl_xor(v, o));
    return v;
}
DEVI int perm32(int rho) { const int n = rho >> 4, i = rho & 15; return 8 * (i >> 2) + 4 * n + (i & 3); }
DEVI f32x4 mfma16(bf16x8 a, bf16x8 b, f32x4 c) { return __builtin_amdgcn_mfma_f32_16x16x32_bf16(a, b, c, 0, 0, 0); }
DEVI f32x16 mfma32(bf16x8 a, bf16x8 b, f32x16 c) { return __builtin_amdgcn_mfma_f32_32x32x16_bf16(a, b, c, 0, 0, 0); }

DEVI void p0_transpose_item(const float* __restrict__ W, const int ldw, const int srccol0, u16* __restrict__ dst, const int n0, const int k0, float* scr, const int lane) {
    { float tv[32];
#pragma unroll
      for (int i = 0; i < 32; ++i) tv[i] = W[(size_t)(k0 + 2 * i + (lane >> 5)) * ldw + srccol0 + (lane & 31)];
#pragma unroll
      for (int i = 0; i < 32; ++i) scr[(2 * i + (lane >> 5)) * 33 + (lane & 31)] = tv[i]; }
    asm volatile("s_waitcnt lgkmcnt(0)" ::: "memory");
    const int c = lane & 7;
#pragma unroll
    for (int j = 0; j < 4; ++j) {
        const int slot = (lane >> 3) + 8 * j, cl = perm32(slot);
        const float* sp = scr + (8 * c) * 33 + cl;
        u32x4 o; o.x = pk2(sp[0], sp[33]); o.y = pk2(sp[2 * 33], sp[3 * 33]); o.z = pk2(sp[4 * 33], sp[5 * 33]); o.w = pk2(sp[6 * 33], sp[7 * 33]);
        *(u32x4*)(dst + (size_t)(n0 + slot) * 1024 + k0 + 8 * c) = o;
    }
    asm volatile("s_waitcnt lgkmcnt(0)" ::: "memory");
}
__device__ __forceinline__ void phase0(const Params& p) {
    extern __shared__ __attribute__((aligned(16))) unsigned char lds[];
    const int tid = opaque_tid(), lane = tid & 63, wave = tid >> 6;
    float* modp = (float*)(p.ws + WS_MOD);
    for (int job = blockIdx.x; job < 96; job += gridDim.x) {
        float* sc = (float*)lds; float* red = (float*)(lds + 65536);
        for (int i = tid; i < 16384; i += 512) { const float v = p.c[i]; sc[i] = v / (1.f + expf(-v)); }
        __syncthreads();
        const int jl = tid & 31, kq = tid >> 5, j0 = job * 32;
        float acc[16];
#pragma unroll
        for (int b = 0; b < 16; ++b) acc[b] = 0.f;
#pragma unroll 1
        for (int kb = 0; kb < 64; kb += 16) {
            float wv[16];
#pragma unroll
            for (int kk = 0; kk < 16; ++kk) wv[kk] = p.w_ada[(size_t)(kq * 64 + kb + kk) * 3072 + j0 + jl];
#pragma unroll
            for (int kk = 0; kk < 16; ++kk) {
                const int k = kq * 64 + kb + kk;
#pragma unroll
                for (int b = 0; b < 16; ++b) acc[b] += sc[b * 1024 + k] * wv[kk];
            }
        }
#pragma unroll
        for (int b = 0; b < 16; ++b) red[(kq * 16 + b) * 32 + jl] = acc[b];
        __syncthreads();
        { const int b = tid >> 5; float sacc = p.b_ada[j0 + jl];
          for (int q = 0; q < 16; ++q) sacc += red[(q * 16 + b) * 32 + jl];
          modp[b * 3072 + j0 + jl] = sacc; }
        __syncthreads();
    }
    if (blockIdx.x == (gridDim.x > 100 ? 100 : 0)) {
        float* Wg = (float*)(p.ws + WS_WG);
        for (int i = tid; i < 8192; i += 512) { const int g = i & 7, k = i >> 3; Wg[g * 1024 + k] = p.w_in[(size_t)k * 4616 + 2560 + g]; }
    }
    {
        float* scr = (float*)(lds + wave * 8448);
        const int NW = gridDim.x * 8, gw = NW - 1 - (blockIdx.x * 8 + wave);
        for (int it = gw; it < 2816; it += NW) {
            if (it < 2304) { const int nb = it >> 4, kb = it & 15, n0 = nb * 32;
                p0_transpose_item(p.w_in, 4616, n0 < 2560 ? n0 : n0 + 8, (u16*)(p.ws + WS_WTIN), n0, kb * 64, scr, lane); }
            else { const int r2 = it - 2304, nb = r2 >> 4, kb = r2 & 15, n0 = nb * 32;
                p0_transpose_item(p.w_out, 1024, n0, (u16*)(p.ws + WS_WTOUT), n0, kb * 64, scr, lane); }
        }
    }
}

__device__ __forceinline__ void phase1a(const Params& p) {
    extern __shared__ __attribute__((aligned(16))) unsigned char lds[];
    const int tid = opaque_tid(), lane = tid & 63, wave = tid >> 6;
    float* wg_s = (float*)lds;
    { const float* Wg = (const float*)(p.ws + WS_WG); for (int i = tid; i < 8192; i += 512) wg_s[i] = Wg[i]; }
    __syncthreads();
    const float* modp = (const float*)(p.ws + WS_MOD);
    u16* H = (u16*)(p.ws + WS_H); float* gates = (float*)(p.ws + WS_GATES);
    for (int tb = blockIdx.x * 8 + wave; tb < 2048; tb += gridDim.x * 8) {
        const int tok0 = tb * 32, b = tok0 >> 12;
        f32x4 gs[4], sh[4];
#pragma unroll
        for (int j = 0; j < 4; ++j) { const int k = lane * 4 + 256 * j; const f32x4 g = *(const f32x4*)(p.g_pre + k); const f32x4 s = *(const f32x4*)(modp + b * 3072 + 1024 + k);
            sh[j] = *(const f32x4*)(modp + b * 3072 + k); gs[j] = g * (1.f + s); }
        float bias = 0.f; if (lane < 4) bias = p.b_ig[lane]; else if (lane < 8) bias = p.b_fg[lane - 4];
        f32x4 vn[4];
#pragma unroll
        for (int j = 0; j < 4; ++j) vn[j] = __builtin_nontemporal_load((const f32x4*)(p.x + (size_t)tok0 * 1024 + lane * 4 + 256 * j));
        for (int t = 0; t < 32; ++t) {
            const size_t tok = (size_t)tok0 + t;
            f32x4 v[4]; float ss = 0.f;
#pragma unroll
            for (int j = 0; j < 4; ++j) { v[j] = vn[j]; ss += (v[j].x * v[j].x + v[j].y * v[j].y) + (v[j].z * v[j].z + v[j].w * v[j].w); }
            if (t + 1 < 32) {
#pragma unroll
                for (int j = 0; j < 4; ++j) vn[j] = __builtin_nontemporal_load((const f32x4*)(p.x + (tok + 1) * 1024 + lane * 4 + 256 * j));
            }
            ss = wave_sum(ss); const float r = rsqrtf(ss * (1.f / 1024.f) + 1e-6f);
            float part[8];
#pragma unroll
            for (int g = 0; g < 8; ++g) part[g] = 0.f;
#pragma unroll
            for (int j = 0; j < 4; ++j) {
                const f32x4 hv = v[j] * r * gs[j] + sh[j];
                u32x2 o; o.x = pk2(hv.x, hv.y); o.y = pk2(hv.z, hv.w);
                *(u32x2*)(H + tok * 1024 + lane * 4 + 256 * j) = o;
#pragma unroll
                for (int g = 0; g < 8; ++g) { const f32x4 w = *(const f32x4*)(wg_s + g * 1024 + lane * 4 + 256 * j); part[g] += (hv.x * w.x + hv.y * w.y) + (hv.z * w.z + hv.w * w.w); }
            }
#pragma unroll
            for (int g = 0; g < 8; ++g) part[g] = wave_sum(part[g]);
            float ov = part[0];
#pragma unroll
            for (int g = 1; g < 8; ++g) if (lane == g) ov = part[g];
            if (lane < 8) gates[tok * 8 + lane] = ov + bias;
        }
    }
}

constexpr int BM = 256, BK = 64, HALF = 128, HT = HALF * BK;
DEVI int lds_byte(int r, int c) { const int st = (r >> 4) * 2 + (c >> 5), rr = r & 15, cc = c & 31, ob = rr * 64 + cc * 2; return st * 1024 + (ob ^ (((ob >> 9) & 1) << 5)); }
DEVI void stage_rc(int b, int& R, int& C) { const int st = b / 1024, sb = b % 1024, swz = sb ^ (((sb >> 9) & 1) << 5); R = (st >> 1) * 16 + swz / 64; C = (st & 1) * 32 + (swz % 64) / 2; }

DEVI void gemm_unit(const int L, const int nM, const int nN, const int nwg, int& pm, int& pn) {
    int wgid = L;
    { const int q = nwg / 8, r = nwg % 8, xcd = wgid % 8, off = wgid / 8; wgid = (xcd < r ? xcd * (q + 1) : r * (q + 1) + (xcd - r) * q) + off; }
    const int nig = 8 * nN, gid = wgid / nig, fm = gid * 8, gsz = min(nM - fm, 8);
    pm = fm + ((wgid % nig) % gsz); pn = (wgid % nig) / gsz;
}
template <bool NTST>
__device__ __forceinline__ void gemm_phase(const u16* __restrict__ A, const u16* __restrict__ Bt, u16* __restrict__ Out, const int nN, const int ldo) {
    extern __shared__ __attribute__((aligned(16))) unsigned char lds[];
    constexpr int K = 1024;
    const int tid = opaque_tid();
    u16* shm = (u16*)lds;
#define SA(b, h) (shm + ((b) * 2 + (h)) * HT)
#define SB(b, h) (shm + (4 + (b) * 2 + (h)) * HT)
#define STAGE(Pp, BASE, br, kt) do { const u16* _gb = (BASE) + ((size_t)(br) * K + (size_t)(kt) * BK); \
      __builtin_amdgcn_global_load_lds((const unsigned*)(_gb + so0), (unsigned*)((char*)(Pp) + tid * 16), 16, 0, 0); \
      __builtin_amdgcn_global_load_lds((const unsigned*)(_gb + 64 * K + so0), (unsigned*)((char*)(Pp) + tid * 16 + 8192), 16, 0, 0); } while (0)
#define LDA(dst, b, h) for (int m = 0; m < 4; ++m) for (int k = 0; k < 2; ++k) \
    dst[m][k] = *reinterpret_cast<const bf16x8*>((char*)SA(b, h) + lds_byte(wr * 64 + m * 16 + fr, k * 32 + fq * 8))
#define LDB(dst, b, h) for (int n = 0; n < 2; ++n) for (int k = 0; k < 2; ++k) \
    dst[n][k] = *reinterpret_cast<const bf16x8*>((char*)SB(b, h) + lds_byte(wc * 32 + n * 16 + fr, k * 32 + fq * 8))
#define MMA(ai, bj, At_, Bt_) do { __builtin_amdgcn_s_setprio(1); \
    for (int m = 0; m < 4; ++m) for (int n = 0; n < 2; ++n) for (int k = 0; k < 2; ++k) \
      acc[ai][bj][m][n] = __builtin_amdgcn_mfma_f32_16x16x32_bf16(Bt_[n][k], At_[m][k], acc[ai][bj][m][n], 0, 0, 0); \
    __builtin_amdgcn_s_setprio(0); } while (0)
#define WAIT_V(n) asm volatile("s_waitcnt vmcnt(" #n ")" ::: "memory")
#define WAIT_L(n) asm volatile("s_waitcnt lgkmcnt(" #n ")" ::: "memory")
#define BAR __builtin_amdgcn_s_barrier()
#define SCHED __builtin_amdgcn_sched_barrier(0)
#define EPILOGUE(ROW, COL) do { \
    _Pragma("unroll") for (int ai = 0; ai < 2; ++ai) \
    _Pragma("unroll") for (int m = 0; m < 4; ++m) { \
        u16* rowp = NTST ? Out + PIX((ROW) + ai * HALF + wr * 64 + m * 16 + fr, (COL) + wc * 32 + 8 * fq) \
                         : Out + (size_t)((ROW) + ai * HALF + wr * 64 + m * 16 + fr) * ldo + (COL) + wc * 32 + 8 * fq; \
        _Pragma("unroll") for (int bj = 0; bj < 2; ++bj) { \
            const f32x4 v0 = acc[ai][bj][m][0], v1 = acc[ai][bj][m][1]; \
            u32x4 w; w.x = pk2(v0[0], v0[1]); w.y = pk2(v0[2], v0[3]); w.z = pk2(v1[0], v1[1]); w.w = pk2(v1[2], v1[3]); \
            if (NTST) __builtin_nontemporal_store(w, (u32x4*)(rowp + (size_t)bj * 2 * NTOK * 64)); else *(u32x4*)(rowp + bj * HALF) = w; \
        } } } while (0)
    const int wid = tid >> 6, lane = tid & 63, wr = wid >> 2, wc = wid & 3, fr = lane & 15, fq = lane >> 4;
    unsigned so0;
    { int r_, c_; stage_rc(tid * 16, r_, c_); so0 = (unsigned)(r_ * K + c_); }
    constexpr int nt = K / BK;
    const int nM = NTOK / BM, nwg = nM * nN, G = gridDim.x;
    int L = blockIdx.x;
    if (L < nwg) {
        int brow, bcol;
        { int pm, pn; gemm_unit(L, nM, nN, nwg, pm, pn); brow = pm * BM; bcol = pn * BM; }
        f32x4 acc[2][2][4][2] = {};
        bf16x8 At[4][2], B0[2][2], B1[2][2];
        STAGE(SB(0, 0), Bt, bcol, 0); STAGE(SA(0, 0), A, brow, 0);
        STAGE(SB(0, 1), Bt, bcol + HALF, 0); STAGE(SA(0, 1), A, brow + HALF, 0);
        if (wr == 1) BAR;
        WAIT_V(4); BAR;
        STAGE(SB(1, 0), Bt, bcol, 1); STAGE(SA(1, 0), A, brow, 1); STAGE(SB(1, 1), Bt, bcol + HALF, 1);
        WAIT_V(6); BAR;
        for (;;) {
            const bool last = (L + G >= nwg);
            int nbrow = brow, nbcol = bcol;
            if (!last) { int qm, qn; gemm_unit(L + G, nM, nN, nwg, qm, qn); nbrow = qm * BM; nbcol = qn * BM; }
            const int tend = last ? nt - 2 : nt;
            for (int t = 0; t < tend; t += 2) {
                const bool bnd = (t == nt - 2);
                const int r2 = bnd ? nbrow : brow, c2 = bnd ? nbcol : bcol, k2 = bnd ? 0 : t + 2, k3 = bnd ? 1 : t + 3;
                LDB(B0, 0, 0); SCHED; LDA(At, 0, 0); STAGE(SA(1, 1), A, brow + HALF, t + 1);
                WAIT_L(8); BAR; WAIT_L(0); MMA(0, 0, At, B0); BAR; SCHED;
                LDB(B1, 0, 1); STAGE(SB(0, 0), Bt, c2, k2);
                BAR; WAIT_L(0); MMA(0, 1, At, B1); BAR;
                LDA(At, 0, 1); STAGE(SA(0, 0), A, r2, k2);
                BAR; WAIT_L(0); MMA(1, 0, At, B0); BAR; SCHED;
                STAGE(SB(0, 1), Bt, c2 + HALF, k2);
                WAIT_V(6); BAR; MMA(1, 1, At, B1); BAR;
                LDB(B0, 1, 0); SCHED; LDA(At, 1, 0); STAGE(SA(0, 1), A, r2 + HALF, k2);
                WAIT_L(8); BAR; WAIT_L(0); MMA(0, 0, At, B0); BAR; SCHED;
                LDB(B1, 1, 1); STAGE(SB(1, 0), Bt, c2, k3);
                BAR; WAIT_L(0); MMA(0, 1, At, B1); BAR;
                LDA(At, 1, 1); STAGE(SA(1, 0), A, r2, k3);
                BAR; WAIT_L(0); MMA(1, 0, At, B0); BAR; SCHED;
                STAGE(SB(1, 1), Bt, c2 + HALF, k3);
                WAIT_V(6); BAR; MMA(1, 1, At, B1); BAR;
            }
            if (last) break;
            EPILOGUE(brow, bcol);
#pragma unroll
            for (int ai = 0; ai < 2; ++ai)
#pragma unroll
                for (int bj = 0; bj < 2; ++bj)
#pragma unroll
                    for (int m = 0; m < 4; ++m)
#pragma unroll
                        for (int n = 0; n < 2; ++n) acc[ai][bj][m][n] = (f32x4){0.f, 0.f, 0.f, 0.f};
            brow = nbrow; bcol = nbcol; L += G;
        }
        { LDB(B0, 0, 0); LDA(At, 0, 0); STAGE(SA(1, 1), A, brow + HALF, nt - 1);
          BAR; WAIT_L(0); MMA(0, 0, At, B0); BAR;
          LDB(B1, 0, 1); BAR; WAIT_L(0); MMA(0, 1, At, B1); BAR;
          LDA(At, 0, 1); WAIT_V(4); BAR; WAIT_L(0); MMA(1, 0, At, B0); MMA(1, 1, At, B1); BAR; }
        { LDB(B0, 1, 0); LDA(At, 1, 0); WAIT_V(2); BAR; WAIT_L(0); MMA(0, 0, At, B0); BAR;
          LDB(B1, 1, 1); WAIT_V(0); BAR; WAIT_L(0); MMA(0, 1, At, B1); BAR;
          LDA(At, 1, 1); BAR; WAIT_L(0); MMA(1, 0, At, B0); MMA(1, 1, At, B1); BAR; }
        if (wr == 0) BAR;
        EPILOGUE(brow, bcol);
    }
    __syncthreads();
#undef SA
#undef SB
#undef STAGE
#undef LDA
#undef LDB
#undef MMA
#undef EPILOGUE
}

__device__ __forceinline__ void mlstm_pass1(const Params& p, const int item, const int grp) {
    extern __shared__ __attribute__((aligned(16))) unsigned char lds[];
    const int tid = opaque_tid(), lane = tid & 63, w = tid >> 6, i16 = lane & 15, g4 = lane >> 4;
    const int b = item >> 2, hh = item & 3;
    u16* q_s = (u16*)(lds + 0); u16* k_s = (u16*)(lds + 17408); float* out_s = (float*)lds;
    u16* wkT_s = (u16*)(lds + 34816); u16* vT_s = (u16*)(lds + 53248); u16* S_s = (u16*)(lds + 73984);
    u16* CT_s = (u16*)(lds + 83200); float* den_s = (float*)(lds + 122368); float* a_s = (float*)(lds + 122368 + 256); float* ml_s = a_s + 64;
    const u16* P = (const u16*)(p.ws + WS_P); const float* gates = (const float*)(p.ws + WS_GATES);
    u16* NDn = (u16*)(p.ws + WS_NDNUM); u16* Q2 = (u16*)(p.ws + WS_Q2); float* AUX = (float*)(p.ws + WS_AUX);
    const int c0 = grp * 16;
    const size_t tokb = (size_t)b * 4096;
    for (int i = tid; i < 144 * 136 / 2; i += 512) ((unsigned*)CT_s)[i] = 0u;
    for (int i = tid; i < 16 * 72; i += 512) vT_s[128 * 72 + i] = (i < 72) ? (u16)0x3F80 : (u16)0;
    const int cp = tid & 63, t0 = 8 * w, ch = 2 * cp;
    float cwq[4][2], cwk[4][2], cbq[2], cbk[2];
#pragma unroll
    for (int j = 0; j < 4; ++j)
#pragma unroll
        for (int e = 0; e < 2; ++e) { cwq[j][e] = p.conv_w[j * 1024 + hh * 128 + ch + e]; cwk[j][e] = p.conv_w[j * 1024 + 512 + hh * 128 + ch + e]; }
#pragma unroll
    for (int e = 0; e < 2; ++e) { cbq[e] = p.conv_b[hh * 128 + ch + e]; cbk[e] = p.conv_b[512 + hh * 128 + ch + e]; }
    f32x4 Cacc[8], Cacc8 = {0.f, 0.f, 0.f, 0.f};
#pragma unroll
    for (int i = 0; i < 8; ++i) Cacc[i] = (f32x4){0.f, 0.f, 0.f, 0.f};
    for (int cc = w; cc < c0; cc += 8) {
        const size_t tk = tokb + (size_t)cc * 64 + lane;
        const float gi = gates[tk * 8 + hh], gf = gates[tk * 8 + 4 + hh];
        const float logf = fminf(gf, 0.f) - log1pf(expf(-fabsf(gf)));
        float bcs = logf;
#pragma unroll
        for (int o = 1; o < 64; o <<= 1) { const float u = __shfl_up(bcs, o); if (lane >= o) bcs += u; }
        const float a_tot = __shfl(bcs, 63);
        const float igb = gi - bcs;
        const float gg = a_tot + igb;
        const float m_loc = wave_max(gg);
        if (lane == 0) { a_s[cc] = a_tot; ml_s[cc] = m_loc; }
    }
    __syncthreads();
    float m_prev = 0.f;
    for (int cc = 0; cc < c0; ++cc) m_prev = fmaxf(a_s[cc] + m_prev, ml_s[cc]);
    float Pc = 1.f;
    const int et = tid >> 3, ec = (tid & 7) * 16;
    unsigned rq[11], rk[11], rv[8]; float gi_n, gf_n;
    {
        const size_t tokc = tokb + (size_t)c0 * 64;
#pragma unroll
        for (int i = 0; i < 11; ++i) { const int row = t0 - 3 + i; const bool ok = (c0 > 0) || (row >= 0); const size_t o = PIX((size_t)((long)tokc + (ok ? row : 0)), hh * 128 + ch);
            rq[i] = ok ? *(const unsigned*)(P + o) : 0u; rk[i] = ok ? *(const unsigned*)(P + o + PBLK8) : 0u; }
#pragma unroll
        for (int i = 0; i < 8; ++i) rv[i] = *(const unsigned*)(P + PIX(tokc + t0 + i, 1024 + hh * 128 + ch));
        gi_n = gates[(tokc + lane) * 8 + hh]; gf_n = gates[(tokc + lane) * 8 + 4 + hh];
    }
    for (int c = c0; c < c0 + 16; ++c) {
        const size_t tokc = tokb + (size_t)c * 64;
        const size_t tq = (size_t)item * 4096 + (size_t)c * 64;
        const float gi = gi_n, gf = gf_n;
        const float logf = fminf(gf, 0.f) - log1pf(expf(-fabsf(gf)));
        float bcs = logf;
#pragma unroll
        for (int o = 1; o < 64; o <<= 1) { const float u = __shfl_up(bcs, o); if (lane >= o) bcs += u; }
        const float a_tot = __shfl(bcs, 63);
        const float igb = gi - bcs;
        const float gg = a_tot + igb;
        const float m_loc = wave_max(gg);
        const float m_new = fmaxf(a_tot + m_prev, m_loc);
        const float s_old = expf(a_tot + m_prev - m_new);
        const float wp = expf(gg - m_new);
        float mx = igb;
#pragma unroll
        for (int o = 1; o < 64; o <<= 1) { const float u = __shfl_up(mx, o); if (lane >= o) mx = fmaxf(mx, u); }
        const float m_t = bcs + fmaxf(m_prev, mx);
        const float iw = expf(bcs + m_prev - m_t);
        const float bm = bcs - m_t;
        {
            float kv0[8], kv1[8];
#pragma unroll
            for (int i = 0; i < 8; ++i) {
                float aq0 = cbq[0], aq1 = cbq[1], ak0 = cbk[0], ak1 = cbk[1];
#pragma unroll
                for (int j = 0; j < 4; ++j) { aq0 += cwq[j][0] * bflo(rq[i + j]); aq1 += cwq[j][1] * bfhi(rq[i + j]); ak0 += cwk[j][0] * bflo(rk[i + j]); ak1 += cwk[j][1] * bfhi(rk[i + j]); }
                const float q0 = aq0 * __builtin_amdgcn_rcpf(1.f + __expf(-aq0)), q1 = aq1 * __builtin_amdgcn_rcpf(1.f + __expf(-aq1));
                const float k0 = ak0 * __builtin_amdgcn_rcpf(1.f + __expf(-ak0)) * 0.08838834764831845f, k1 = ak1 * __builtin_amdgcn_rcpf(1.f + __expf(-ak1)) * 0.08838834764831845f;
                *(unsigned*)(q_s + (t0 + i) * 136 + ch) = pk2(q0, q1);
                *(unsigned*)(k_s + (t0 + i) * 136 + ch) = pk2(k0, k1);
                const float wpi = __shfl(wp, t0 + i);
                kv0[i] = k0 * wpi; kv1[i] = k1 * wpi;
            }
            u32x4 o0, o1;
            o0.x = pk2(kv0[0], kv0[1]); o0.y = pk2(kv0[2], kv0[3]); o0.z = pk2(kv0[4], kv0[5]); o0.w = pk2(kv0[6], kv0[7]);
            o1.x = pk2(kv1[0], kv1[1]); o1.y = pk2(kv1[2], kv1[3]); o1.z = pk2(kv1[4], kv1[5]); o1.w = pk2(kv1[6], kv1[7]);
            *(u32x4*)(wkT_s + ch * 72 + t0) = o0; *(u32x4*)(wkT_s + (ch + 1) * 72 + t0) = o1;
            u32x4 v0, v1;
            v0.x = (rv[0] & 0xffffu) | (rv[1] << 16); v0.y = (rv[2] & 0xffffu) | (rv[3] << 16); v0.z = (rv[4] & 0xffffu) | (rv[5] << 16); v0.w = (rv[6] & 0xffffu) | (rv[7] << 16);
            v1.x = (rv[0] >> 16) | (rv[1] & 0xffff0000u); v1.y = (rv[2] >> 16) | (rv[3] & 0xffff0000u); v1.z = (rv[4] >> 16) | (rv[5] & 0xffff0000u); v1.w = (rv[6] >> 16) | (rv[7] & 0xffff0000u);
            *(u32x4*)(vT_s + ch * 72 + t0) = v0; *(u32x4*)(vT_s + (ch + 1) * 72 + t0) = v1;
        }
        if (c + 1 < c0 + 16) {
            const size_t tn = tokc + 64;
#pragma unroll
            for (int i = 0; i < 11; ++i) { const size_t o = PIX(tn + t0 - 3 + i, hh * 128 + ch); rq[i] = *(const unsigned*)(P + o); rk[i] = *(const unsigned*)(P + o + PBLK8); }
#pragma unroll
            for (int i = 0; i < 8; ++i) rv[i] = *(const unsigned*)(P + PIX(tn + t0 + i, 1024 + hh * 128 + ch));
            gi_n = gates[(tn + lane) * 8 + hh]; gf_n = gates[(tn + lane) * 8 + 4 + hh];
        }
        __syncthreads();
        {
            const u32x4 qa = *(const u32x4*)(q_s + et * 136 + ec), qb = *(const u32x4*)(q_s + et * 136 + ec + 8);
            u16* qd = Q2 + (tq + et) * 128 + ec; *(u32x4*)qd = qa; *(u32x4*)(qd + 8) = qb;
            if (w == 0) { AUX[(tq + lane) * 4 + 0] = iw * Pc; AUX[(tq + lane) * 4 + 1] = expf(-m_t); }
        }
        {
            const int ti = w >> 1;
#pragma unroll
            for (int sj = 0; sj < 2; ++sj) {
                const int si = 2 * (w & 1) + sj;
                f32x4 acc = {0.f, 0.f, 0.f, 0.f};
                if (si <= ti) {
#pragma unroll
                    for (int ks = 0; ks < 4; ++ks) {
                        const bf16x8 a = *(const bf16x8*)(q_s + (16 * ti + i16) * 136 + 32 * ks + 8 * g4);
                        const bf16x8 bb = *(const bf16x8*)(k_s + (16 * si + i16) * 136 + 32 * ks + 8 * g4);
                        acc = mfma16(a, bb, acc);
                    }
                }
                const int s = 16 * si + i16; const float igb_s = __shfl(igb, s);
#pragma unroll
                for (int r = 0; r < 4; ++r) {
                    const int t = 16 * ti + 4 * g4 + r; const float bm_t = __shfl(bm, t);
                    const float val = (s <= t) ? acc[r] * __expf(bm_t + igb_s) : 0.f;
                    S_s[t * 72 + s] = (u16)(pk2(val, 0.f) & 0xffffu);
                }
            }
        }
        f32x4 accO[4], accO8 = {0.f, 0.f, 0.f, 0.f};
#pragma unroll
        for (int ti = 0; ti < 4; ++ti) {
            f32x4 acc = {0.f, 0.f, 0.f, 0.f};
#pragma unroll
            for (int ks = 0; ks < 4; ++ks) {
                const bf16x8 a = *(const bf16x8*)(q_s + (16 * ti + i16) * 136 + 32 * ks + 8 * g4);
                const bf16x8 bb = *(const bf16x8*)(CT_s + (16 * w + i16) * 136 + 32 * ks + 8 * g4);
                acc = mfma16(a, bb, acc);
            }
#pragma unroll
            for (int r = 0; r < 4; ++r) acc[r] *= __shfl(iw, 16 * ti + 4 * g4 + r);
            accO[ti] = acc;
        }
        if (w < 4) {
            f32x4 acc = {0.f, 0.f, 0.f, 0.f};
#pragma unroll
            for (int ks = 0; ks < 4; ++ks) {
                const bf16x8 a = *(const bf16x8*)(q_s + (16 * w + i16) * 136 + 32 * ks + 8 * g4);
                const bf16x8 bb = *(const bf16x8*)(CT_s + (128 + i16) * 136 + 32 * ks + 8 * g4);
                acc = mfma16(a, bb, acc);
            }
#pragma unroll
            for (int r = 0; r < 4; ++r) acc[r] *= __shfl(iw, 16 * w + 4 * g4 + r);
            accO8 = acc;
        }
        __syncthreads();
#pragma unroll
        for (int ti = 0; ti < 4; ++ti)
#pragma unroll
            for (int ks = 0; ks < 2; ++ks) {
                const bf16x8 a = *(const bf16x8*)(S_s + (16 * ti + i16) * 72 + 32 * ks + 8 * g4);
                const bf16x8 bb = *(const bf16x8*)(vT_s + (16 * w + i16) * 72 + 32 * ks + 8 * g4);
                accO[ti] = mfma16(a, bb, accO[ti]);
            }
        if (w < 4) {
#pragma unroll
            for (int ks = 0; ks < 2; ++ks) {
                const bf16x8 a = *(const bf16x8*)(S_s + (16 * w + i16) * 72 + 32 * ks + 8 * g4);
                const bf16x8 bb = *(const bf16x8*)(vT_s + (128 + i16) * 72 + 32 * ks + 8 * g4);
                accO8 = mfma16(a, bb, accO8);
            }
        }
#pragma unroll
        for (int ti = 0; ti < 4; ++ti)
#pragma unroll
            for (int r = 0; r < 4; ++r) out_s[(16 * ti + 4 * g4 + r) * 132 + 16 * w + i16] = accO[ti][r];
        if (w < 4 && i16 == 0) {
#pragma unroll
            for (int r = 0; r < 4; ++r) den_s[16 * w + 4 * g4 + r] = accO8[r];
        }
        __syncthreads();
        {
            float nv[16];
#pragma unroll
            for (int j = 0; j < 16; ++j) nv[j] = out_s[et * 132 + ec + j];
            u32x4 s0, s1;
            s0.x = pk2(nv[0], nv[1]); s0.y = pk2(nv[2], nv[3]); s0.z = pk2(nv[4], nv[5]); s0.w = pk2(nv[6], nv[7]);
            s1.x = pk2(nv[8], nv[9]); s1.y = pk2(nv[10], nv[11]); s1.z = pk2(nv[12], nv[13]); s1.w = pk2(nv[14], nv[15]);
            u16* dst = NDn + (tq + et) * 128 + ec;
            *(u32x4*)dst = s0; *(u32x4*)(dst + 8) = s1;
            if ((tid & 7) == 0) AUX[(tq + et) * 4 + 2] = den_s[et];
        }
#pragma unroll
        for (int ki = 0; ki < 8; ++ki) {
            f32x4 acc = Cacc[ki] * s_old;
#pragma unroll
            for (int ks = 0; ks < 2; ++ks) {
                const bf16x8 a = *(const bf16x8*)(wkT_s + (16 * ki + i16) * 72 + 32 * ks + 8 * g4);
                const bf16x8 bb = *(const bf16x8*)(vT_s + (16 * w + i16) * 72 + 32 * ks + 8 * g4);
                acc = mfma16(a, bb, acc);
            }
            Cacc[ki] = acc;
            u32x2 pkd; pkd.x = pk2(acc[0], acc[1]); pkd.y = pk2(acc[2], acc[3]);
            *(u32x2*)(CT_s + (16 * w + i16) * 136 + 16 * ki + 4 * g4) = pkd;
        }
        {
            f32x4 acc = Cacc8 * s_old;
#pragma unroll
            for (int ks = 0; ks < 2; ++ks) {
                const bf16x8 a = *(const bf16x8*)(wkT_s + (16 * w + i16) * 72 + 32 * ks + 8 * g4);
                const bf16x8 bb = *(const bf16x8*)(vT_s + (128 + i16) * 72 + 32 * ks + 8 * g4);
                acc = mfma16(a, bb, acc);
            }
            Cacc8 = acc;
            u32x2 pkd; pkd.x = pk2(acc[0], acc[1]); pkd.y = pk2(acc[2], acc[3]);
            *(u32x2*)(CT_s + (128 + i16) * 136 + 16 * w + 4 * g4) = pkd;
        }
        m_prev = m_new; Pc *= s_old;
        __syncthreads();
    }
    {
        float* E = (float*)(p.ws + WS_E) + (size_t)(item * 4 + grp) * 144 * 128;
#pragma unroll
        for (int ki = 0; ki < 8; ++ki) *(f32x4*)(E + (16 * w + i16) * 128 + 16 * ki + 4 * g4) = Cacc[ki];
        *(f32x4*)(E + (128 + i16) * 128 + 16 * w + 4 * g4) = Cacc8;
        if (tid == 0) ((float*)(p.ws + WS_DG))[item * 4 + grp] = Pc;
    }
}

__device__ __forceinline__ void mlstm_pass2(const Params& p, const int item, const int grp) {
    extern __shared__ __attribute__((aligned(16))) unsigned char lds[];
    const int tid = opaque_tid(), lane = tid & 63, w = tid >> 6, i16 = lane & 15, g4 = lane >> 4;
    const int b = item >> 2, hh = item & 3;
    u16* q_s = (u16*)(lds + 0); float* o2_s = (float*)(lds + 17408); float* den2_s = (float*)(lds + 51200); u16* CT_s = (u16*)(lds + 83200);
    const u16* P = (const u16*)(p.ws + WS_P); u16* Hm = (u16*)(p.ws + WS_HMIX);
    const u16* NDn = (const u16*)(p.ws + WS_NDNUM); const u16* Q2 = (const u16*)(p.ws + WS_Q2); const float* AUX = (const float*)(p.ws + WS_AUX);
    const size_t tokb = (size_t)b * 4096;
    const int et = tid >> 3, ec = (tid & 7) * 16;
    if (grp > 0) {
        float cf[3] = {0.f, 0.f, 0.f}; float run = 1.f;
#pragma unroll
        for (int gp = 2; gp >= 0; --gp) if (gp < grp) { cf[gp] = run; run *= __hip_atomic_load((float*)(p.ws + WS_DG) + item * 4 + gp, __ATOMIC_RELAXED, __HIP_MEMORY_SCOPE_AGENT); }
        const float* E = (const float*)(p.ws + WS_E) + (size_t)(item * 4) * 144 * 128;
        for (int i4 = tid; i4 < 144 * 128 / 4; i4 += 512) {
            const int i = i4 * 4;
            f32x4 sacc = {0.f, 0.f, 0.f, 0.f};
#pragma unroll
            for (int gp = 0; gp < 3; ++gp) if (gp < grp) sacc += cf[gp] * *(const f32x4*)(E + (size_t)gp * 144 * 128 + i);
            u32x2 w; w.x = pk2(sacc[0], sacc[1]); w.y = pk2(sacc[2], sacc[3]);
            *(u32x2*)(CT_s + (i >> 7) * 136 + (i & 127)) = w;
        }
    }
    __syncthreads();
    float gml[16];
#pragma unroll
    for (int j = 0; j < 16; ++j) gml[j] = p.g_ml[hh * 128 + ec + j];
    u32x4 qa_n, qb_n, nd_n[2], ov_n[2], zv_n[2]; f32x4 ax_n;
    {
        const int c = grp * 16;
        const size_t tokc = tokb + (size_t)c * 64, tq = (size_t)item * 4096 + (size_t)c * 64;
        const u16* qsrc = Q2 + (tq + et) * 128 + ec; qa_n = *(const u32x4*)qsrc; qb_n = *(const u32x4*)(qsrc + 8);
        ax_n = *(const f32x4*)(AUX + (tq + lane) * 4);
        const u16* ns = NDn + (tq + et) * 128 + ec; nd_n[0] = *(const u32x4*)ns; nd_n[1] = *(const u32x4*)(ns + 8);
        const u16* po = P + PIX(tokc + et, 1536 + hh * 128 + ec); ov_n[0] = *(const u32x4*)po; ov_n[1] = *(const u32x4*)(po + 8);
        zv_n[0] = *(const u32x4*)(po + PBLK8); zv_n[1] = *(const u32x4*)(po + PBLK8 + 8);
    }
    for (int cl = 0; cl < 16; ++cl) {
        const int c = grp * 16 + cl;
        const size_t tokc = tokb + (size_t)c * 64;
        *(u32x4*)(q_s + et * 136 + ec) = qa_n; *(u32x4*)(q_s + et * 136 + ec + 8) = qb_n;
        const f32x4 ax = ax_n;
        u32x4 nd[2], ov[2], zv[2];
        nd[0] = nd_n[0]; nd[1] = nd_n[1]; ov[0] = ov_n[0]; ov[1] = ov_n[1]; zv[0] = zv_n[0]; zv[1] = zv_n[1];
        __syncthreads();
        if (cl + 1 < 16) {
            const size_t tokn = tokc + 64, tqn = (size_t)item * 4096 + (size_t)(c + 1) * 64;
            const u16* qsrc = Q2 + (tqn + et) * 128 + ec; qa_n = *(const u32x4*)qsrc; qb_n = *(const u32x4*)(qsrc + 8);
            ax_n = *(const f32x4*)(AUX + (tqn + lane) * 4);
            const u16* ns = NDn + (tqn + et) * 128 + ec; nd_n[0] = *(const u32x4*)ns; nd_n[1] = *(const u32x4*)(ns + 8);
            const u16* po = P + PIX(tokn + et, 1536 + hh * 128 + ec); ov_n[0] = *(const u32x4*)po; ov_n[1] = *(const u32x4*)(po + 8);
            zv_n[0] = *(const u32x4*)(po + PBLK8); zv_n[1] = *(const u32x4*)(po + PBLK8 + 8);
        }
        asm volatile("" ::: "memory");
        if (grp > 0) {
#pragma unroll
            for (int ti = 0; ti < 4; ++ti) {
                f32x4 acc = {0.f, 0.f, 0.f, 0.f};
#pragma unroll
                for (int ks = 0; ks < 4; ++ks) {
                    const bf16x8 a = *(const bf16x8*)(q_s + (16 * ti + i16) * 136 + 32 * ks + 8 * g4);
                    const bf16x8 bb = *(const bf16x8*)(CT_s + (16 * w + i16) * 136 + 32 * ks + 8 * g4);
                    acc = mfma16(a, bb, acc);
                }
#pragma unroll
                for (int r = 0; r < 4; ++r) o2_s[(16 * ti + 4 * g4 + r) * 132 + 16 * w + i16] = acc[r] * __shfl(ax.x, 16 * ti + 4 * g4 + r);
            }
            if (w < 4) {
                f32x4 acc = {0.f, 0.f, 0.f, 0.f};
#pragma unroll
                for (int ks = 0; ks < 4; ++ks) {
                    const bf16x8 a = *(const bf16x8*)(q_s + (16 * w + i16) * 136 + 32 * ks + 8 * g4);
                    const bf16x8 bb = *(const bf16x8*)(CT_s + (128 + i16) * 136 + 32 * ks + 8 * g4);
                    acc = mfma16(a, bb, acc);
                }
#pragma unroll
                for (int r = 0; r < 4; ++r) { const float v = acc[r] * __shfl(ax.x, 16 * w + 4 * g4 + r); if (i16 == 0) den2_s[16 * w + 4 * g4 + r] = v; }
            }
        }
        __syncthreads();
        {
            const float den = __shfl(ax.z, et) + (grp > 0 ? den2_s[et] : 0.f);
            const float inv = 1.f / fmaxf(fabsf(den), __shfl(ax.y, et));
            float ho[16]; float ss = 0.f;
#pragma unroll
            for (int j = 0; j < 16; ++j) {
                const unsigned wn = nd[j >> 3][(j >> 1) & 3]; float num = (j & 1) ? bfhi(wn) : bflo(wn);
                if (grp > 0) num += o2_s[et * 132 + ec + j];
                const unsigned wv = ov[j >> 3][(j >> 1) & 3]; const float o = (j & 1) ? bfhi(wv) : bflo(wv);
                ho[j] = num * inv * __builtin_amdgcn_rcpf(1.f + __expf(-o)); ss += ho[j] * ho[j];
            }
            ss += __shfl_xor(ss, 1); ss += __shfl_xor(ss, 2); ss += __shfl_xor(ss, 4);
            const float rr = rsqrtf(ss * (1.f / 128.f) + 1e-6f);
            float ob[16];
#pragma unroll
            for (int j = 0; j < 16; ++j) {
                const unsigned wv = zv[j >> 3][(j >> 1) & 3]; const float z = (j & 1) ? bfhi(wv) : bflo(wv);
                ob[j] = ho[j] * rr * gml[j] * (z * __builtin_amdgcn_rcpf(1.f + __expf(-z)));
            }
            u32x4 s0, s1;
            s0.x = pk2(ob[0], ob[1]); s0.y = pk2(ob[2], ob[3]); s0.z = pk2(ob[4], ob[5]); s0.w = pk2(ob[6], ob[7]);
            s1.x = pk2(ob[8], ob[9]); s1.y = pk2(ob[10], ob[11]); s1.z = pk2(ob[12], ob[13]); s1.w = pk2(ob[14], ob[15]);
            u16* dst = Hm + (tokc + et) * 1024 + hh * 128 + ec;
            *(u32x4*)dst = s0; *(u32x4*)(dst + 8) = s1;
        }
        __syncthreads();
    }
}

__device__ __forceinline__ void sb_unit(const Params& p, const int unit, u16* vT, const int lane) {
    const u16* P = (const u16*)(p.ws + WS_P); u16* Hm = (u16*)(p.ws + WS_HMIX);
    const int qt = unit & 127, hd = (unit >> 7) & 7, b = unit >> 10;
    const int r = lane & 31, h = lane >> 5;
    const size_t tokb = (size_t)b * 4096;
    bf16x8 qf[4];
    { const u16* qrow = P + PIX(tokb + qt * 32 + r, 2560 + hd * 64 + 8 * h);
#pragma unroll
      for (int ks = 0; ks < 4; ++ks) qf[ks] = *(const bf16x8*)(qrow + 16 * ks); }
    u32x4 Tw[2];
#pragma unroll
    for (int st = 0; st < 2; ++st) {
        unsigned tw[4];
#pragma unroll
        for (int e = 0; e < 8; e += 2) {
            const int j0 = 16 * st + 8 * (e >> 2) + 4 * h + (e & 3), j1 = j0 + 1;
            tw[e >> 1] = ((j0 > r) ? 0x3C00u : 0u) | ((j1 > r) ? 0x3C000000u : 0u);
        }
        Tw[st].x = tw[0]; Tw[st].y = tw[1]; Tw[st].z = tw[2]; Tw[st].w = tw[3];
    }
    f32x16 O0, O1;
#pragma unroll
    for (int i = 0; i < 16; ++i) { O0[i] = 0.f; O1[i] = 0.f; }
    float R2 = 0.f;
    const float SC = 0.125f * 1.4426950408889634f;
    const size_t tok = tokb + qt * 32 + r;
    u32x2 zz8[8];
#pragma unroll
    for (int i = 0; i < 8; ++i) zz8[i] = *(const u32x2*)(P + PIX(tok, 4096 + hd * 64 + 32 * (i >> 2) + 8 * (i & 3) + 4 * h));
    asm volatile("" ::: "memory");
    bf16x8 kfn[4]; u32x4 vvn[4];
    { const u16* krow = P + PIX(tokb + qt * 32 + r, 3072 + hd * 64 + 8 * h);
#pragma unroll
      for (int ks = 0; ks < 4; ++ks) kfn[ks] = *(const bf16x8*)(krow + 16 * ks);
      const u16* vrow = P + PIX(tokb + qt * 32 + (lane >> 1), 3584 + hd * 64 + (lane & 1) * 32);
#pragma unroll
      for (int i = 0; i < 4; ++i) vvn[i] = *(const u32x4*)(vrow + 8 * i); }
    bool have = true;
    for (int kb = qt; kb >= 0; --kb) {
        if (!have) {
            const u16* krow = P + PIX(tokb + kb * 32 + r, 3072 + hd * 64 + 8 * h);
#pragma unroll
            for (int ks = 0; ks < 4; ++ks) kfn[ks] = *(const bf16x8*)(krow + 16 * ks);
            const u16* vrow = P + PIX(tokb + kb * 32 + (lane >> 1), 3584 + hd * 64 + (lane & 1) * 32);
#pragma unroll
            for (int i = 0; i < 4; ++i) vvn[i] = *(const u32x4*)(vrow + 8 * i);
        }
        bf16x8 kf[4]; u32x4 vv[4];
#pragma unroll
        for (int i = 0; i < 4; ++i) { kf[i] = kfn[i]; vv[i] = vvn[i]; }
        asm volatile("" ::: "memory");
        have = (kb > 0) && __any(R2 > -30.f);
        if (have) {
            const int s1 = (kb - 1) * 32;
            const u16* krow = P + PIX(tokb + s1 + r, 3072 + hd * 64 + 8 * h);
#pragma unroll
            for (int ks = 0; ks < 4; ++ks) kfn[ks] = *(const bf16x8*)(krow + 16 * ks);
            const u16* vrow = P + PIX(tokb + s1 + (lane >> 1), 3584 + hd * 64 + (lane & 1) * 32);
#pragma unroll
            for (int i = 0; i < 4; ++i) vvn[i] = *(const u32x4*)(vrow + 8 * i);
        }
        asm volatile("" ::: "memory");
        f32x16 Z;
#pragma unroll
        for (int i = 0; i < 16; ++i) Z[i] = 0.f;
#pragma unroll
        for (int ks = 0; ks < 4; ++ks) Z = mfma32(kf[ks], qf[ks], Z);
        float lbv[16], lkv[16];
#pragma unroll
        for (int reg = 0; reg < 16; ++reg) {
            const float u = Z[reg] * SC;
            const float sp = __builtin_amdgcn_logf(1.f + __builtin_amdgcn_exp2f(-fabsf(u)));
            lbv[reg] = fminf(u, 0.f) - sp;
            lkv[reg] = lbv[reg] - u;
        }
        if (kb == qt) {
#pragma unroll
            for (int reg = 0; reg < 16; ++reg) {
                const int sl = (reg & 3) + 8 * (reg >> 2) + 4 * h;
                const bool valid = sl < r;
                lbv[reg] = valid ? lbv[reg] : -1e30f;
                lkv[reg] = valid ? lkv[reg] : 0.f;
            }
        }
        u32x4 lw[2];
#pragma unroll
        for (int st = 0; st < 2; ++st) {
            lw[st].x = pkh2(lkv[8 * st + 0], lkv[8 * st + 1]); lw[st].y = pkh2(lkv[8 * st + 2], lkv[8 * st + 3]);
            lw[st].z = pkh2(lkv[8 * st + 4], lkv[8 * st + 5]); lw[st].w = pkh2(lkv[8 * st + 6], lkv[8 * st + 7]);
        }
        f32x16 aft;
#pragma unroll
        for (int i = 0; i < 16; ++i) aft[i] = 0.f;
        aft = __builtin_amdgcn_mfma_f32_32x32x16_f16(__builtin_bit_cast(f16x8, Tw[0]), __builtin_bit_cast(f16x8, lw[0]), aft, 0, 0, 0);
        aft = __builtin_amdgcn_mfma_f32_32x32x16_f16(__builtin_bit_cast(f16x8, Tw[1]), __builtin_bit_cast(f16x8, lw[1]), aft, 0, 0, 0);
        const float tot = __shfl(aft[0] + lkv[0], r);
        bf16x8 pf[2];
#pragma unroll
        for (int st = 0; st < 2; ++st) {
            u32x4 pw;
            pw.x = pk2(__builtin_amdgcn_exp2f(lbv[8 * st + 0] + R2 + aft[8 * st + 0]), __builtin_amdgcn_exp2f(lbv[8 * st + 1] + R2 + aft[8 * st + 1]));
            pw.y = pk2(__builtin_amdgcn_exp2f(lbv[8 * st + 2] + R2 + aft[8 * st + 2]), __builtin_amdgcn_exp2f(lbv[8 * st + 3] + R2 + aft[8 * st + 3]));
            pw.z = pk2(__builtin_amdgcn_exp2f(lbv[8 * st + 4] + R2 + aft[8 * st + 4]), __builtin_amdgcn_exp2f(lbv[8 * st + 5] + R2 + aft[8 * st + 5]));
            pw.w = pk2(__builtin_amdgcn_exp2f(lbv[8 * st + 6] + R2 + aft[8 * st + 6]), __builtin_amdgcn_exp2f(lbv[8 * st + 7] + R2 + aft[8 * st + 7]));
            pf[st] = __builtin_bit_cast(bf16x8, pw);
        }
        {
            const int sv = lane >> 1, db = (lane & 1) * 32;
#pragma unroll
            for (int i = 0; i < 4; ++i)
#pragma unroll
                for (int wq = 0; wq < 4; ++wq) {
                    const unsigned x = vv[i][wq]; const int d = db + 8 * i + 2 * wq;
                    vT[d * 40 + sv] = (u16)(x & 0xffffu); vT[(d + 1) * 40 + sv] = (u16)(x >> 16);
                }
        }
        asm volatile("s_waitcnt lgkmcnt(0)" ::: "memory");
#pragma unroll
        for (int st = 0; st < 2; ++st) {
            const u32x2 a0 = *(const u32x2*)(vT + r * 40 + 16 * st + 4 * h), a1 = *(const u32x2*)(vT + r * 40 + 16 * st + 8 + 4 * h);
            const u32x2 b0 = *(const u32x2*)(vT + (32 + r) * 40 + 16 * st + 4 * h), b1 = *(const u32x2*)(vT + (32 + r) * 40 + 16 * st + 8 + 4 * h);
            u32x4 fa, fb; fa.x = a0.x; fa.y = a0.y; fa.z = a1.x; fa.w = a1.y; fb.x = b0.x; fb.y = b0.y; fb.z = b1.x; fb.w = b1.y;
            O0 = mfma32(__builtin_bit_cast(bf16x8, fa), pf[st], O0);
            O1 = mfma32(__builtin_bit_cast(bf16x8, fb), pf[st], O1);
        }
        asm volatile("s_waitcnt lgkmcnt(0)" ::: "memory");
        R2 += tot;
        if (!__any(R2 > -64.f)) break;
    }
#pragma unroll
    for (int dt = 0; dt < 2; ++dt)
#pragma unroll
        for (int q4 = 0; q4 < 4; ++q4) {
            const int d0 = 32 * dt + 8 * q4 + 4 * h;
            const u32x2 zz = zz8[4 * dt + q4];
            float o[4];
#pragma unroll
            for (int e = 0; e < 4; ++e) {
                const float ov = dt ? O1[4 * q4 + e] : O0[4 * q4 + e];
                const unsigned wv = (e < 2) ? zz.x : zz.y; const float z = (e & 1) ? bfhi(wv) : bflo(wv);
                o[e] = ov * (z * __builtin_amdgcn_rcpf(1.f + __expf(-z)));
            }
            u32x2 st; st.x = pk2(o[0], o[1]); st.y = pk2(o[2], o[3]);
            *(u32x2*)(Hm + tok * 1024 + 512 + hd * 64 + d0) = st;
        }
}

__device__ __forceinline__ void phase2a(const Params& p) {
    for (int u = blockIdx.x; u < 256; u += gridDim.x) { mlstm_pass1(p, u >> 2, u & 3); __syncthreads(); }
}
__device__ __forceinline__ void phase2b(const Params& p) {
    extern __shared__ __attribute__((aligned(16))) unsigned char lds[];
    for (int u = blockIdx.x; u < 256; u += gridDim.x) { mlstm_pass2(p, u >> 2, u & 3); __syncthreads(); }
    const int tid2 = opaque_tid(), lane = tid2 & 63, wave = tid2 >> 6;
    u16* vT = (u16*)(lds + wave * 5120);
    for (int u = blockIdx.x * 8 + wave; u < 16384; u += gridDim.x * 8) sb_unit(p, u, vT, lane);
}

__device__ __forceinline__ void phase4(const Params& p) {
    const int tid = opaque_tid(), lane = tid & 63, wave = tid >> 6;
    const float* modp = (const float*)(p.ws + WS_MOD);
    const u16* Y = (const u16*)(p.ws + WS_Y);
    for (int tb = blockIdx.x * 8 + wave; tb < 2048; tb += gridDim.x * 8) {
        const int tok0 = tb * 32, b = tok0 >> 12;
        f32x4 gg[4];
#pragma unroll
        for (int j = 0; j < 4; ++j) { const int k = lane * 4 + 256 * j; gg[j] = *(const f32x4*)(modp + b * 3072 + 2048 + k) * *(const f32x4*)(p.g_post + k); }
        u32x2 yn[4]; f32x4 xn[4];
#pragma unroll
        for (int j = 0; j < 4; ++j) { yn[j] = *(const u32x2*)(Y + (size_t)tok0 * 1024 + lane * 4 + 256 * j); xn[j] = __builtin_nontemporal_load((const f32x4*)(p.x + (size_t)tok0 * 1024 + lane * 4 + 256 * j)); }
        for (int t = 0; t < 32; ++t) {
            const size_t tok = (size_t)tok0 + t;
            f32x4 y[4], xv[4]; float ss = 0.f;
#pragma unroll
            for (int j = 0; j < 4; ++j) { const u32x2 w = yn[j]; xv[j] = xn[j];
                y[j] = (f32x4){bflo(w.x), bfhi(w.x), bflo(w.y), bfhi(w.y)}; ss += (y[j].x * y[j].x + y[j].y * y[j].y) + (y[j].z * y[j].z + y[j].w * y[j].w); }
            if (t + 1 < 32) {
#pragma unroll
                for (int j = 0; j < 4; ++j) { yn[j] = *(const u32x2*)(Y + (tok + 1) * 1024 + lane * 4 + 256 * j); xn[j] = __builtin_nontemporal_load((const f32x4*)(p.x + (tok + 1) * 1024 + lane * 4 + 256 * j)); }
            }
            ss = wave_sum(ss); const float r = rsqrtf(ss * (1.f / 1024.f) + 1e-6f);
#pragma unroll
            for (int j = 0; j < 4; ++j) __builtin_nontemporal_store(xv[j] + gg[j] * (y[j] * r), (f32x4*)(p.out + tok * 1024 + lane * 4 + 256 * j));
        }
    }
}

DEVI unsigned bar_ld(unsigned* q) { return __hip_atomic_load(q, __ATOMIC_RELAXED, __HIP_MEMORY_SCOPE_AGENT); }
DEVI unsigned bar_add(unsigned* q, unsigned v) { return __hip_atomic_fetch_add(q, v, __ATOMIC_RELAXED, __HIP_MEMORY_SCOPE_AGENT); }
DEVI unsigned xcc_id() { return (unsigned)__builtin_amdgcn_s_getreg((3 << 11) | 20) & 0xFu; }
DEVI void grid_sync0(const Params& p, cg::grid_group& g) {
    asm volatile("s_waitcnt vmcnt(0) lgkmcnt(0)" ::: "memory");
    g.sync();
    if (threadIdx.x == 0) { __builtin_amdgcn_fence(__ATOMIC_ACQUIRE, "agent"); asm volatile("s_waitcnt vmcnt(0)" ::: "memory"); }
    __syncthreads();
}
DEVI void grid_sync(const Params& p, const int idx, const unsigned xcc, const unsigned nloc, const unsigned nxcc) {
    asm volatile("s_waitcnt vmcnt(0) lgkmcnt(0)" ::: "memory");
    __syncthreads();
    if (threadIdx.x == 0) {
        unsigned* bar = (unsigned*)(p.ws + WS_BAR);
        unsigned* xsub = bar + 1024 + (16 * idx + xcc) * 64; unsigned* top = bar + 9216 + 64 * idx;
        const unsigned old = bar_add(xsub, 1u);
        if (old == nloc - 1u) {
            __builtin_amdgcn_fence(__ATOMIC_RELEASE, "agent");
            asm volatile("s_waitcnt vmcnt(0)" ::: "memory");
            bar_add(top, 1u);
        }
        while (bar_ld(top) < nxcc) __builtin_amdgcn_s_sleep(1);
        __builtin_amdgcn_fence(__ATOMIC_ACQUIRE, "agent");
        asm volatile("s_waitcnt vmcnt(0)" ::: "memory");
    }
    __syncthreads();
}
__global__ void __launch_bounds__(512) hymba_fwd(Params p) {
    cg::grid_group grid = cg::this_grid();
    const unsigned xcc = xcc_id();
    if (threadIdx.x == 0) bar_add((unsigned*)(p.ws + WS_BAR) + 64 * xcc, 1u);
    phase0(p);
    if (gridDim.x == 0x7fffffffu) grid_sync0(p, grid);
    if (threadIdx.x == 0) {
        unsigned* bar = (unsigned*)(p.ws + WS_BAR);
        for (;;) { unsigned tot = 0; for (int j = 0; j < 16; ++j) tot += bar_ld(bar + 64 * j); if (tot >= gridDim.x) break; __builtin_amdgcn_s_sleep(1); }
    }
    __syncthreads();
    unsigned nloc, nxcc = 0;
    { unsigned* bar = (unsigned*)(p.ws + WS_BAR); nloc = bar_ld(bar + 64 * xcc);
      for (int j = 0; j < 16; ++j) nxcc += (bar_ld(bar + 64 * j) != 0u) ? 1u : 0u; }
    grid_sync(p, 0, xcc, nloc, nxcc);
    phase1a(p);
    grid_sync(p, 1, xcc, nloc, nxcc);
    gemm_phase<true>((const u16*)(p.ws + WS_H), (const u16*)(p.ws + WS_WTIN), (u16*)(p.ws + WS_P), 18, NP);
    grid_sync(p, 2, xcc, nloc, nxcc);
    phase2a(p);
    grid_sync(p, 5, xcc, nloc, nxcc);
    phase2b(p);
    grid_sync(p, 3, xcc, nloc, nxcc);
    gemm_phase<false>((const u16*)(p.ws + WS_HMIX), (const u16*)(p.ws + WS_WTOUT), (u16*)(p.ws + WS_Y), 4, 1024);
    grid_sync(p, 4, xcc, nloc, nxcc);
    phase4(p);
}

extern "C" void kernel_launch(void* const* d_in, const int* in_sizes, int n_in, void* d_out, int out_size, void* d_ws, size_t ws_size, hipStream_t stream) {
    static int grid_blocks = 0;
    if (!grid_blocks) {
        if (n_in != 13 || out_size != NTOK * DM || ws_size < WS_END) { fprintf(stderr, "kernel_launch: unexpected shapes (n_in %d out %d ws %zu)\n", n_in, out_size, ws_size); grid_blocks = -1; return; }
        int dev = 0, cus = 0, per_cu = 0;
        hipGetDevice(&dev);
        hipDeviceGetAttribute(&cus, hipDeviceAttributeMultiprocessorCount, dev);
        if (hipFuncSetAttribute((const void*)hymba_fwd, hipFuncAttributeMaxDynamicSharedMemorySize, LDS_BYTES) != hipSuccess) fprintf(stderr, "kernel_launch: hipFuncSetAttribute failed\n");
        if (hipOccupancyMaxActiveBlocksPerMultiprocessor(&per_cu, (const void*)hymba_fwd, 512, LDS_BYTES) != hipSuccess || per_cu < 1) { fprintf(stderr, "kernel_launch: occupancy query says %d\n", per_cu); per_cu = 1; }
        (void)hipGetLastError();
        grid_blocks = cus * 1;
    }
    if (grid_blocks < 0) return;
    Params p{};
    p.x = (const float*)d_in[0]; p.c = (const float*)d_in[1]; p.w_ada = (const float*)d_in[2]; p.b_ada = (const float*)d_in[3]; p.g_pre = (const float*)d_in[4];
    p.w_in = (const float*)d_in[5]; p.b_ig = (const float*)d_in[6]; p.b_fg = (const float*)d_in[7]; p.conv_w = (const float*)d_in[8]; p.conv_b = (const float*)d_in[9];
    p.g_ml = (const float*)d_in[10]; p.w_out = (const float*)d_in[11]; p.g_post = (const float*)d_in[12];
    p.out = (float*)d_out; p.ws = (unsigned char*)d_ws;
    if (hipMemsetAsync((unsigned char*)d_ws + WS_BAR, 0, 40960, stream) != hipSuccess) fprintf(stderr, "kernel_launch: memset of the barrier words failed\n");
    void* args[] = {&p};
    hipError_t e = hipLaunchCooperativeKernel((const void*)hymba_fwd, dim3(grid_blocks), dim3(512), args, LDS_BYTES, stream);
    if (e != hipSuccess) fprintf(stderr, "cooperative launch failed: %s (grid %d)\n", hipGetErrorString(e), grid_blocks);
}
```

```cpp
#include <hip/hip_runtime.h>
#include <hip/hip_cooperative_groups.h>
#include <cstdio>
#include <cstdint>
namespace cg = cooperative_groups;

typedef unsigned short u16;
typedef short bf16x8 __attribute__((ext_vector_type(8)));
typedef float f32x4 __attribute__((ext_vector_type(4)));
typedef float f32x16 __attribute__((ext_vector_type(16)));
typedef unsigned u32x4 __attribute__((ext_vector_type(4)));
typedef unsigned u32x2 __attribute__((ext_vector_type(2)));
#define DEVI __device__ __forceinline__

constexpr int NTOK = 65536, DM = 1024, NP = 4608;
constexpr size_t WS_WTIN = 0;
constexpr size_t WS_WTOUT = 9437184;
constexpr size_t WS_WG = 11534336;
constexpr size_t WS_MOD = 11567104;
constexpr size_t WS_BAR = 13860864;
constexpr size_t WS_GATES = 11763712;
constexpr size_t WS_H = 16777216;
constexpr size_t WS_P = WS_H + 134217728;
constexpr size_t WS_HMIX = WS_P + 603979776;
constexpr size_t WS_Y = WS_HMIX + 134217728;
constexpr size_t WS_END = WS_Y + 134217728;
constexpr size_t WS_NDNUM = WS_H;
constexpr size_t WS_Q2 = WS_H + 67108864;
constexpr size_t WS_E = WS_Y;
constexpr size_t WS_AUX = WS_Y + 33554432;
constexpr size_t WS_DG = WS_Y + 41943040;
constexpr int LDS_BYTES = 131072;

#define PIX(tok, col) ((((size_t)((col) >> 6)) * (size_t)NTOK + (size_t)(tok)) * 64 + (size_t)((col) & 63))
constexpr size_t PBLK8 = (size_t)8 * NTOK * 64;
struct Params {
    const float *x, *c, *w_ada, *b_ada, *g_pre, *w_in, *b_ig, *b_fg, *conv_w, *conv_b, *g_ml, *w_out, *g_post;
    float* out;
    unsigned char* ws;
};

DEVI int opaque_tid() { int t = threadIdx.x; asm volatile("" : "+v"(t)); return t; }
typedef __bf16 bf16x2_t __attribute__((ext_vector_type(2)));
typedef _Float16 f16x2_t __attribute__((ext_vector_type(2)));
typedef _Float16 f16x8 __attribute__((ext_vector_type(8)));
typedef float f32x2_t __attribute__((ext_vector_type(2)));
DEVI unsigned pk2(float lo, float hi) { const f32x2_t v = {lo, hi}; const bf16x2_t b = __builtin_convertvector(v, bf16x2_t); return __builtin_bit_cast(unsigned, b); }
DEVI unsigned pkh2(float lo, float hi) { const f32x2_t v = {lo, hi}; const f16x2_t b = __builtin_convertvector(v, f16x2_t); return __builtin_bit_cast(unsigned, b); }
DEVI float bflo(unsigned w) { return __uint_as_float(w << 16); }
DEVI float bfhi(unsigned w) { return __uint_as_float(w & 0xffff0000u); }
DEVI float wave_sum(float v) {
#pragma unroll
    for (int o = 1; o < 64; o <<= 1) v += __shfl_xor(v, o);
    return v;
}
DEVI float wave_max(float v) {
#pragma unroll
    for (int o = 1; o < 64; o <<= 1) v = fmaxf(v, __shfl_xor(v, o));
    return v;
}
DEVI int perm32(int rho) { const int n = rho >> 4, i = rho & 15; return 8 * (i >> 2) + 4 * n + (i & 3); }
DEVI f32x4 mfma16(bf16x8 a, bf16x8 b, f32x4 c) { return __builtin_amdgcn_mfma_f32_16x16x32_bf16(a, b, c, 0, 0, 0); }
DEVI f32x16 mfma32(bf16x8 a, bf16x8 b, f32x16 c) { return __builtin_amdgcn_mfma_f32_32x32x16_bf16(a, b, c, 0, 0, 0); }

DEVI void p0_transpose_item(const float* __restrict__ W, const int ldw, const int srccol0, u16* __restrict__ dst, const int n0, const int k0, float* scr, const int lane) {
    { float tv[32];
#pragma unroll
      for (int i = 0; i < 32; ++i) tv[i] = W[(size_t)(k0 + 2 * i + (lane >> 5)) * ldw + srccol0 + (lane & 31)];
#pragma unroll
      for (int i = 0; i < 32; ++i) scr[(2 * i + (lane >> 5)) * 33 + (lane & 31)] = tv[i]; }
    asm volatile("s_waitcnt lgkmcnt(0)" ::: "memory");
    const int c = lane & 7;
#pragma unroll
    for (int j = 0; j < 4; ++j) {
        const int slot = (lane >> 3) + 8 * j, cl = perm32(slot);
        const float* sp = scr + (8 * c) * 33 + cl;
        u32x4 o; o.x = pk2(sp[0], sp[33]); o.y = pk2(sp[2 * 33], sp[3 * 33]); o.z = pk2(sp[4 * 33], sp[5 * 33]); o.w = pk2(sp[6 * 33], sp[7 * 33]);
        *(u32x4*)(dst + (size_t)(n0 + slot) * 1024 + k0 + 8 * c) = o;
    }
    asm volatile("s_waitcnt lgkmcnt(0)" ::: "memory");
}
__device__ __forceinline__ void phase0(const Params& p) {
    extern __shared__ __attribute__((aligned(16))) unsigned char lds[];
    const int tid = opaque_tid(), lane = tid & 63, wave = tid >> 6;
    float* modp = (float*)(p.ws + WS_MOD);
    for (int job = blockIdx.x; job < 96; job += gridDim.x) {
        float* sc = (float*)lds; float* red = (float*)(lds + 65536);
        for (int i = tid; i < 16384; i += 512) { const float v = p.c[i]; sc[i] = v / (1.f + expf(-v)); }
        __syncthreads();
        const int jl = tid & 31, kq = tid >> 5, j0 = job * 32;
        float acc[16];
#pragma unroll
        for (int b = 0; b < 16; ++b) acc[b] = 0.f;
#pragma unroll 1
        for (int kb = 0; kb < 64; kb += 16) {
            float wv[16];
#pragma unroll
            for (int kk = 0; kk < 16; ++kk) wv[kk] = p.w_ada[(size_t)(kq * 64 + kb + kk) * 3072 + j0 + jl];
#pragma unroll
            for (int kk = 0; kk < 16; ++kk) {
                const int k = kq * 64 + kb + kk;
#pragma unroll
                for (int b = 0; b < 16; ++b) acc[b] += sc[b * 1024 + k] * wv[kk];
            }
        }
#pragma unroll
        for (int b = 0; b < 16; ++b) red[(kq * 16 + b) * 32 + jl] = acc[b];
        __syncthreads();
        { const int b = tid >> 5; float sacc = p.b_ada[j0 + jl];
          for (int q = 0; q < 16; ++q) sacc += red[(q * 16 + b) * 32 + jl];
          modp[b * 3072 + j0 + jl] = sacc; }
        __syncthreads();
    }
    if (blockIdx.x == (gridDim.x > 100 ? 100 : 0)) {
        float* Wg = (float*)(p.ws + WS_WG);
        for (int i = tid; i < 8192; i += 512) { const int g = i & 7, k = i >> 3; Wg[g * 1024 + k] = p.w_in[(size_t)k * 4616 + 2560 + g]; }
    }
    {
        float* scr = (float*)(lds + wave * 8448);
        const int NW = gridDim.x * 8, gw = NW - 1 - (blockIdx.x * 8 + wave);
        for (int it = gw; it < 2816; it += NW) {
            if (it < 2304) { const int nb = it >> 4, kb = it & 15, n0 = nb * 32;
                p0_transpose_item(p.w_in, 4616, n0 < 2560 ? n0 : n0 + 8, (u16*)(p.ws + WS_WTIN), n0, kb * 64, scr, lane); }
            else { const int r2 = it - 2304, nb = r2 >> 4, kb = r2 & 15, n0 = nb * 32;
                p0_transpose_item(p.w_out, 1024, n0, (u16*)(p.ws + WS_WTOUT), n0, kb * 64, scr, lane); }
        }
    }
}

__device__ __forceinline__ void phase1a(const Params& p) {
    extern __shared__ __attribute__((aligned(16))) unsigned char lds[];
    const int tid = opaque_tid(), lane = tid & 63, wave = tid >> 6;
    float* wg_s = (float*)lds;
    { const float* Wg = (const float*)(p.ws + WS_WG); for (int i = tid; i < 8192; i += 512) wg_s[i] = Wg[i]; }
    __syncthreads();
    const float* modp = (const float*)(p.ws + WS_MOD);
    u16* H = (u16*)(p.ws + WS_H); float* gates = (float*)(p.ws + WS_GATES);
    for (int tb = blockIdx.x * 8 + wave; tb < 2048; tb += gridDim.x * 8) {
        const int tok0 = tb * 32, b = tok0 >> 12;
        f32x4 gs[4], sh[4];
#pragma unroll
        for (int j = 0; j < 4; ++j) { const int k = lane * 4 + 256 * j; const f32x4 g = *(const f32x4*)(p.g_pre + k); const f32x4 s = *(const f32x4*)(modp + b * 3072 + 1024 + k);
            sh[j] = *(const f32x4*)(modp + b * 3072 + k); gs[j] = g * (1.f + s); }
        float bias = 0.f; if (lane < 4) bias = p.b_ig[lane]; else if (lane < 8) bias = p.b_fg[lane - 4];
        f32x4 vn[4];
#pragma unroll
        for (int j = 0; j < 4; ++j) vn[j] = __builtin_nontemporal_load((const f32x4*)(p.x + (size_t)tok0 * 1024 + lane * 4 + 256 * j));
        for (int t = 0; t < 32; ++t) {
            const size_t tok = (size_t)tok0 + t;
            f32x4 v[4]; float ss = 0.f;
#pragma unroll
            for (int j = 0; j < 4; ++j) { v[j] = vn[j]; ss += (v[j].x * v[j].x + v[j].y * v[j].y) + (v[j].z * v[j].z + v[j].w * v[j].w); }
            if (t + 1 < 32) {
#pragma unroll
                for (int j = 0; j < 4; ++j) vn[j] = __builtin_nontemporal_load((const f32x4*)(p.x + (tok + 1) * 1024 + lane * 4 + 256 * j));
            }
            ss = wave_sum(ss); const float r = rsqrtf(ss * (1.f / 1024.f) + 1e-6f);
            float part[8];
#pragma unroll
            for (int g = 0; g < 8; ++g) part[g] = 0.f;
#pragma unroll
            for (int j = 0; j < 4; ++j) {
                const f32x4 hv = v[j] * r * gs[j] + sh[j];
                u32x2 o; o.x = pk2(hv.x, hv.y); o.y = pk2(hv.z, hv.w);
                *(u32x2*)(H + tok * 1024 + lane * 4 + 256 * j) = o;
#pragma unroll
                for (int g = 0; g < 8; ++g) { const f32x4 w = *(const f32x4*)(wg_s + g * 1024 + lane * 4 + 256 * j); part[g] += (hv.x * w.x + hv.y * w.y) + (hv.z * w.z + hv.w * w.w); }
            }
#pragma unroll
            for (int g = 0; g < 8; ++g) part[g] = wave_sum(part[g]);
            float ov = part[0];
#pragma unroll
            for (int g = 1; g < 8; ++g) if (lane == g) ov = part[g];
            if (lane < 8) gates[tok * 8 + lane] = ov + bias;
        }
    }
}

constexpr int BM = 256, BK = 64, HALF = 128, HT = HALF * BK;
DEVI int lds_byte(int r, int c) { const int st = (r >> 4) * 2 + (c >> 5), rr = r & 15, cc = c & 31, ob = rr * 64 + cc * 2; return st * 1024 + (ob ^ (((ob >> 9) & 1) << 5)); }
DEVI void stage_rc(int b, int& R, int& C) { const int st = b / 1024, sb = b % 1024, swz = sb ^ (((sb >> 9) & 1) << 5); R = (st >> 1) * 16 + swz / 64; C = (st & 1) * 32 + (swz % 64) / 2; }

DEVI void gemm_unit(const int L, const int nM, const int nN, const int nwg, int& pm, int& pn) {
    int wgid = L;
    { const int q = nwg / 8, r = nwg % 8, xcd = wgid % 8, off = wgid / 8; wgid = (xcd < r ? xcd * (q + 1) : r * (q + 1) + (xcd - r) * q) + off; }
    const int nig = 8 * nN, gid = wgid / nig, fm = gid * 8, gsz = min(nM - fm, 8);
    pm = fm + ((wgid % nig) % gsz); pn = (wgid % nig) / gsz;
}
template <bool NTST>
__device__ __forceinline__ void gemm_phase(const u16* __restrict__ A, const u16* __restrict__ Bt, u16* __restrict__ Out, const int nN, const int ldo) {
    extern __shared__ __attribute__((aligned(16))) unsigned char lds[];
    constexpr int K = 1024;
    const int tid = opaque_tid();
    u16* shm = (u16*)lds;
#define SA(b, h) (shm + ((b) * 2 + (h)) * HT)
#define SB(b, h) (shm + (4 + (b) * 2 + (h)) * HT)
#define STAGE(Pp, BASE, br, kt) do { const u16* _gb = (BASE) + ((size_t)(br) * K + (size_t)(kt) * BK); \
      __builtin_amdgcn_global_load_lds((const unsigned*)(_gb + so0), (unsigned*)((char*)(Pp) + tid * 16), 16, 0, 0); \
      __builtin_amdgcn_global_load_lds((const unsigned*)(_gb + 64 * K + so0), (unsigned*)((char*)(Pp) + tid * 16 + 8192), 16, 0, 0); } while (0)
#define LDA(dst, b, h) for (int m = 0; m < 4; ++m) for (int k = 0; k < 2; ++k) \
    dst[m][k] = *reinterpret_cast<const bf16x8*>((char*)SA(b, h) + lds_byte(wr * 64 + m * 16 + fr, k * 32 + fq * 8))
#define LDB(dst, b, h) for (int n = 0; n < 2; ++n) for (int k = 0; k < 2; ++k) \
    dst[n][k] = *reinterpret_cast<const bf16x8*>((char*)SB(b, h) + lds_byte(wc * 32 + n * 16 + fr, k * 32 + fq * 8))
#define MMA(ai, bj, At_, Bt_) do { __builtin_amdgcn_s_setprio(1); \
    for (int m = 0; m < 4; ++m) for (int n = 0; n < 2; ++n) for (int k = 0; k < 2; ++k) \
      acc[ai][bj][m][n] = __builtin_amdgcn_mfma_f32_16x16x32_bf16(Bt_[n][k], At_[m][k], acc[ai][bj][m][n], 0, 0, 0); \
    __builtin_amdgcn_s_setprio(0); } while (0)
#define WAIT_V(n) asm volatile("s_waitcnt vmcnt(" #n ")" ::: "memory")
#define WAIT_L(n) asm volatile("s_waitcnt lgkmcnt(" #n ")" ::: "memory")
#define BAR __builtin_amdgcn_s_barrier()
#define SCHED __builtin_amdgcn_sched_barrier(0)
#define EPILOGUE(ROW, COL) do { \
    _Pragma("unroll") for (int ai = 0; ai < 2; ++ai) \
    _Pragma("unroll") for (int m = 0; m < 4; ++m) { \
        u16* rowp = NTST ? Out + PIX((ROW) + ai * HALF + wr * 64 + m * 16 + fr, (COL) + wc * 32 + 8 * fq) \
                         : Out + (size_t)((ROW) + ai * HALF + wr * 64 + m * 16 + fr) * ldo + (COL) + wc * 32 + 8 * fq; \
        _Pragma("unroll") for (int bj = 0; bj < 2; ++bj) { \
            const f32x4 v0 = acc[ai][bj][m][0], v1 = acc[ai][bj][m][1]; \
            u32x4 w; w.x = pk2(v0[0], v0[1]); w.y = pk2(v0[2], v0[3]); w.z = pk2(v1[0], v1[1]); w.w = pk2(v1[2], v1[3]); \
            if (NTST) __builtin_nontemporal_store(w, (u32x4*)(rowp + (size_t)bj * 2 * NTOK * 64)); else *(u32x4*)(rowp + bj * HALF) = w; \
        } } } while (0)
    const int wid = tid >> 6, lane = tid & 63, wr = wid >> 2, wc = wid & 3, fr = lane & 15, fq = lane >> 4;
    unsigned so0;
    { int r_, c_; stage_rc(tid * 16, r_, c_); so0 = (unsigned)(r_ * K + c_); }
    constexpr int nt = K / BK;
    const int nM = NTOK / BM, nwg = nM * nN, G = gridDim.x;
    int L = blockIdx.x;
    if (L < nwg) {
        int brow, bcol;
        { int pm, pn; gemm_unit(L, nM, nN, nwg, pm, pn); brow = pm * BM; bcol = pn * BM; }
        f32x4 acc[2][2][4][2] = {};
        bf16x8 At[4][2], B0[2][2], B1[2][2];
        STAGE(SB(0, 0), Bt, bcol, 0); STAGE(SA(0, 0), A, brow, 0);
        STAGE(SB(0, 1), Bt, bcol + HALF, 0); STAGE(SA(0, 1), A, brow + HALF, 0);
        if (wr == 1) BAR;
        WAIT_V(4); BAR;
        STAGE(SB(1, 0), Bt, bcol, 1); STAGE(SA(1, 0), A, brow, 1); STAGE(SB(1, 1), Bt, bcol + HALF, 1);
        WAIT_V(6); BAR;
        for (;;) {
            const bool last = (L + G >= nwg);
            int nbrow = brow, nbcol = bcol;
            if (!last) { int qm, qn; gemm_unit(L + G, nM, nN, nwg, qm, qn); nbrow = qm * BM; nbcol = qn * BM; }
            const int tend = last ? nt - 2 : nt;
            for (int t = 0; t < tend; t += 2) {
                const bool bnd = (t == nt - 2);
                const int r2 = bnd ? nbrow : brow, c2 = bnd ? nbcol : bcol, k2 = bnd ? 0 : t + 2, k3 = bnd ? 1 : t + 3;
                LDB(B0, 0, 0); SCHED; LDA(At, 0, 0); STAGE(SA(1, 1), A, brow + HALF, t + 1);
                WAIT_L(8); BAR; WAIT_L(0); MMA(0, 0, At, B0); BAR; SCHED;
                LDB(B1, 0, 1); STAGE(SB(0, 0), Bt, c2, k2);
                BAR; WAIT_L(0); MMA(0, 1, At, B1); BAR;
                LDA(At, 0, 1); STAGE(SA(0, 0), A, r2, k2);
                BAR; WAIT_L(0); MMA(1, 0, At, B0); BAR; SCHED;
                STAGE(SB(0, 1), Bt, c2 + HALF, k2);
                WAIT_V(6); BAR; MMA(1, 1, At, B1); BAR;
                LDB(B0, 1, 0); SCHED; LDA(At, 1, 0); STAGE(SA(0, 1), A, r2 + HALF, k2);
                WAIT_L(8); BAR; WAIT_L(0); MMA(0, 0, At, B0); BAR; SCHED;
                LDB(B1, 1, 1); STAGE(SB(1, 0), Bt, c2, k3);
                BAR; WAIT_L(0); MMA(0, 1, At, B1); BAR;
                LDA(At, 1, 1); STAGE(SA(1, 0), A, r2, k3);
                BAR; WAIT_L(0); MMA(1, 0, At, B0); BAR; SCHED;
                STAGE(SB(1, 1), Bt, c2 + HALF, k3);
                WAIT_V(6); BAR; MMA(1, 1, At, B1); BAR;
            }
            if (last) break;
            EPILOGUE(brow, bcol);
#pragma unroll
            for (int ai = 0; ai < 2; ++ai)
#pragma unroll
                for (int bj = 0; bj < 2; ++bj)
#pragma unroll
                    for (int m = 0; m < 4; ++m)
#pragma unroll
                        for (int n = 0; n < 2; ++n) acc[ai][bj][m][n] = (f32x4){0.f, 0.f, 0.f, 0.f};
            brow = nbrow; bcol = nbcol; L += G;
        }
        { LDB(B0, 0, 0); LDA(At, 0, 0); STAGE(SA(1, 1), A, brow + HALF, nt - 1);
          BAR; WAIT_L(0); MMA(0, 0, At, B0); BAR;
          LDB(B1, 0, 1); BAR; WAIT_L(0); MMA(0, 1, At, B1); BAR;
          LDA(At, 0, 1); WAIT_V(4); BAR; WAIT_L(0); MMA(1, 0, At, B0); MMA(1, 1, At, B1); BAR; }
        { LDB(B0, 1, 0); LDA(At, 1, 0); WAIT_V(2); BAR; WAIT_L(0); MMA(0, 0, At, B0); BAR;
          LDB(B1, 1, 1); WAIT_V(0); BAR; WAIT_L(0); MMA(0, 1, At, B1); BAR;
          LDA(At, 1, 1); BAR; WAIT_L(0); MMA(1, 0, At, B0); MMA(1, 1, At, B1); BAR; }
        if (wr == 0) BAR;
        EPILOGUE(brow, bcol);
    }
    __syncthreads();
#undef SA
#undef SB
#undef STAGE
#undef LDA
#undef LDB
#undef MMA
#undef EPILOGUE
}

__device__ __forceinline__ void mlstm_pass1(const Params& p, const int item, const int grp) {
    extern __shared__ __attribute__((aligned(16))) unsigned char lds[];
    const int tid = opaque_tid(), lane = tid & 63, w = tid >> 6, i16 = lane & 15, g4 = lane >> 4;
    const int b = item >> 2, hh = item & 3;
    u16* q_s = (u16*)(lds + 0); u16* k_s = (u16*)(lds + 17408); float* out_s = (float*)lds;
    u16* wkT_s = (u16*)(lds + 34816); u16* vT_s = (u16*)(lds + 53248); u16* S_s = (u16*)(lds + 73984);
    u16* CT_s = (u16*)(lds + 83200); float* den_s = (float*)(lds + 122368); float* a_s = (float*)(lds + 122368 + 256); float* ml_s = a_s + 64;
    const u16* P = (const u16*)(p.ws + WS_P); const float* gates = (const float*)(p.ws + WS_GATES);
    u16* NDn = (u16*)(p.ws + WS_NDNUM); u16* Q2 = (u16*)(p.ws + WS_Q2); float* AUX = (float*)(p.ws + WS_AUX);
    const int c0 = grp * 16;
    const size_t tokb = (size_t)b * 4096;
    for (int i = tid; i < 144 * 136 / 2; i += 512) ((unsigned*)CT_s)[i] = 0u;
    for (int i = tid; i < 16 * 72; i += 512) vT_s[128 * 72 + i] = (i < 72) ? (u16)0x3F80 : (u16)0;
    const int cp = tid & 63, t0 = 8 * w, ch = 2 * cp;
    float cwq[4][2], cwk[4][2], cbq[2], cbk[2];
#pragma unroll
    for (int j = 0; j < 4; ++j)
#pragma unroll
        for (int e = 0; e < 2; ++e) { cwq[j][e] = p.conv_w[j * 1024 + hh * 128 + ch + e]; cwk[j][e] = p.conv_w[j * 1024 + 512 + hh * 128 + ch + e]; }
#pragma unroll
    for (int e = 0; e < 2; ++e) { cbq[e] = p.conv_b[hh * 128 + ch + e]; cbk[e] = p.conv_b[512 + hh * 128 + ch + e]; }
    f32x4 Cacc[8], Cacc8 = {0.f, 0.f, 0.f, 0.f};
#pragma unroll
    for (int i = 0; i < 8; ++i) Cacc[i] = (f32x4){0.f, 0.f, 0.f, 0.f};
    for (int cc = w; cc < c0; cc += 8) {
        const size_t tk = tokb + (size_t)cc * 64 + lane;
        const float gi = gates[tk * 8 + hh], gf = gates[tk * 8 + 4 + hh];
        const float logf = fminf(gf, 0.f) - log1pf(expf(-fabsf(gf)));
        float bcs = logf;
#pragma unroll
        for (int o = 1; o < 64; o <<= 1) { const float u = __shfl_up(bcs, o); if (lane >= o) bcs += u; }
        const float a_tot = __shfl(bcs, 63);
        const float igb = gi - bcs;
        const float gg = a_tot + igb;
        const float m_loc = wave_max(gg);
        if (lane == 0) { a_s[cc] = a_tot; ml_s[cc] = m_loc; }
    }
    __syncthreads();
    float m_prev = 0.f;
    for (int cc = 0; cc < c0; ++cc) m_prev = fmaxf(a_s[cc] + m_prev, ml_s[cc]);
    float Pc = 1.f;
    const int et = tid >> 3, ec = (tid & 7) * 16;
    unsigned rq[11], rk[11], rv[8]; float gi_n, gf_n;
    {
        const size_t tokc = tokb + (size_t)c0 * 64;
#pragma unroll
        for (int i = 0; i < 11; ++i) { const int row = t0 - 3 + i; const bool ok = (c0 > 0) || (row >= 0); const size_t o = PIX((size_t)((long)tokc + (ok ? row : 0)), hh * 128 + ch);
            rq[i] = ok ? __builtin_nontemporal_load((const unsigned*)(P + o)) : 0u; rk[i] = ok ? __builtin_nontemporal_load((const unsigned*)(P + o + PBLK8)) : 0u; }
#pragma unroll
        for (int i = 0; i < 8; ++i) rv[i] = __builtin_nontemporal_load((const unsigned*)(P + PIX(tokc + t0 + i, 1024 + hh * 128 + ch)));
        gi_n = gates[(tokc + lane) * 8 + hh]; gf_n = gates[(tokc + lane) * 8 + 4 + hh];
    }
    for (int c = c0; c < c0 + 16; ++c) {
        const size_t tokc = tokb + (size_t)c * 64;
        const size_t tq = (size_t)item * 4096 + (size_t)c * 64;
        const float gi = gi_n, gf = gf_n;
        const float logf = fminf(gf, 0.f) - log1pf(expf(-fabsf(gf)));
        float bcs = logf;
#pragma unroll
        for (int o = 1; o < 64; o <<= 1) { const float u = __shfl_up(bcs, o); if (lane >= o) bcs += u; }
        const float a_tot = __shfl(bcs, 63);
        const float igb = gi - bcs;
        const float gg = a_tot + igb;
        const float m_loc = wave_max(gg);
        const float m_new = fmaxf(a_tot + m_prev, m_loc);
        const float s_old = expf(a_tot + m_prev - m_new);
        const float wp = expf(gg - m_new);
        float mx = igb;
#pragma unroll
        for (int o = 1; o < 64; o <<= 1) { const float u = __shfl_up(mx, o); if (lane >= o) mx = fmaxf(mx, u); }
        const float m_t = bcs + fmaxf(m_prev, mx);
        const float iw = expf(bcs + m_prev - m_t);
        const float bm = bcs - m_t;
        {
            float kv0[8], kv1[8];
#pragma unroll
            for (int i = 0; i < 8; ++i) {
                float aq0 = cbq[0], aq1 = cbq[1], ak0 = cbk[0], ak1 = cbk[1];
#pragma unroll
                for (int j = 0; j < 4; ++j) { aq0 += cwq[j][0] * bflo(rq[i + j]); aq1 += cwq[j][1] * bfhi(rq[i + j]); ak0 += cwk[j][0] * bflo(rk[i + j]); ak1 += cwk[j][1] * bfhi(rk[i + j]); }
                const float q0 = aq0 * __builtin_amdgcn_rcpf(1.f + __expf(-aq0)), q1 = aq1 * __builtin_amdgcn_rcpf(1.f + __expf(-aq1));
                const float k0 = ak0 * __builtin_amdgcn_rcpf(1.f + __expf(-ak0)) * 0.08838834764831845f, k1 = ak1 * __builtin_amdgcn_rcpf(1.f + __expf(-ak1)) * 0.08838834764831845f;
                *(unsigned*)(q_s + (t0 + i) * 136 + ch) = pk2(q0, q1);
                *(unsigned*)(k_s + (t0 + i) * 136 + ch) = pk2(k0, k1);
                const float wpi = __shfl(wp, t0 + i);
                kv0[i] = k0 * wpi; kv1[i] = k1 * wpi;
            }
            u32x4 o0, o1;
            o0.x = pk2(kv0[0], kv0[1]); o0.y = pk2(kv0[2], kv0[3]); o0.z = pk2(kv0[4], kv0[5]); o0.w = pk2(kv0[6], kv0[7]);
            o1.x = pk2(kv1[0], kv1[1]); o1.y = pk2(kv1[2], kv1[3]); o1.z = pk2(kv1[4], kv1[5]); o1.w = pk2(kv1[6], kv1[7]);
            *(u32x4*)(wkT_s + ch * 72 + t0) = o0; *(u32x4*)(wkT_s + (ch + 1) * 72 + t0) = o1;
            u32x4 v0, v1;
            v0.x = (rv[0] & 0xffffu) | (rv[1] << 16); v0.y = (rv[2] & 0xffffu) | (rv[3] << 16); v0.z = (rv[4] & 0xffffu) | (rv[5] << 16); v0.w = (rv[6] & 0xffffu) | (rv[7] << 16);
            v1.x = (rv[0] >> 16) | (rv[1] & 0xffff0000u); v1.y = (rv[2] >> 16) | (rv[3] & 0xffff0000u); v1.z = (rv[4] >> 16) | (rv[5] & 0xffff0000u); v1.w = (rv[6] >> 16) | (rv[7] & 0xffff0000u);
            *(u32x4*)(vT_s + ch * 72 + t0) = v0; *(u32x4*)(vT_s + (ch + 1) * 72 + t0) = v1;
        }
        if (c + 1 < c0 + 16) {
            const size_t tn = tokc + 64;
#pragma unroll
            for (int i = 0; i < 11; ++i) { const size_t o = PIX(tn + t0 - 3 + i, hh * 128 + ch); rq[i] = __builtin_nontemporal_load((const unsigned*)(P + o)); rk[i] = __builtin_nontemporal_load((const unsigned*)(P + o + PBLK8)); }
#pragma unroll
            for (int i = 0; i < 8; ++i) rv[i] = __builtin_nontemporal_load((const unsigned*)(P + PIX(tn + t0 + i, 1024 + hh * 128 + ch)));
            gi_n = gates[(tn + lane) * 8 + hh]; gf_n = gates[(tn + lane) * 8 + 4 + hh];
        }
        __syncthreads();
        {
            const u32x4 qa = *(const u32x4*)(q_s + et * 136 + ec), qb = *(const u32x4*)(q_s + et * 136 + ec + 8);
            u16* qd = Q2 + (tq + et) * 128 + ec; *(u32x4*)qd = qa; *(u32x4*)(qd + 8) = qb;
            if (w == 0) { AUX[(tq + lane) * 4 + 0] = iw * Pc; AUX[(tq + lane) * 4 + 1] = expf(-m_t); }
        }
        {
            const int ti = w >> 1;
#pragma unroll
            for (int sj = 0; sj < 2; ++sj) {
                const int si = 2 * (w & 1) + sj;
                f32x4 acc = {0.f, 0.f, 0.f, 0.f};
                if (si <= ti) {
#pragma unroll
                    for (int ks = 0; ks < 4; ++ks) {
                        const bf16x8 a = *(const bf16x8*)(q_s + (16 * ti + i16) * 136 + 32 * ks + 8 * g4);
                        const bf16x8 bb = *(const bf16x8*)(k_s + (16 * si + i16) * 136 + 32 * ks + 8 * g4);
                        acc = mfma16(a, bb, acc);
                    }
                }
                const int s = 16 * si + i16; const float igb_s = __shfl(igb, s);
#pragma unroll
                for (int r = 0; r < 4; ++r) {
                    const int t = 16 * ti + 4 * g4 + r; const float bm_t = __shfl(bm, t);
                    const float val = (s <= t) ? acc[r] * __expf(bm_t + igb_s) : 0.f;
                    S_s[t * 72 + s] = (u16)(pk2(val, 0.f) & 0xffffu);
                }
            }
        }
        f32x4 accO[4], accO8 = {0.f, 0.f, 0.f, 0.f};
#pragma unroll
        for (int ti = 0; ti < 4; ++ti) {
            f32x4 acc = {0.f, 0.f, 0.f, 0.f};
#pragma unroll
            for (int ks = 0; ks < 4; ++ks) {
                const bf16x8 a = *(const bf16x8*)(q_s + (16 * ti + i16) * 136 + 32 * ks + 8 * g4);
                const bf16x8 bb = *(const bf16x8*)(CT_s + (16 * w + i16) * 136 + 32 * ks + 8 * g4);
                acc = mfma16(a, bb, acc);
            }
#pragma unroll
            for (int r = 0; r < 4; ++r) acc[r] *= __shfl(iw, 16 * ti + 4 * g4 + r);
            accO[ti] = acc;
        }
        if (w < 4) {
            f32x4 acc = {0.f, 0.f, 0.f, 0.f};
#pragma unroll
            for (int ks = 0; ks < 4; ++ks) {
                const bf16x8 a = *(const bf16x8*)(q_s + (16 * w + i16) * 136 + 32 * ks + 8 * g4);
                const bf16x8 bb = *(const bf16x8*)(CT_s + (128 + i16) * 136 + 32 * ks + 8 * g4);
                acc = mfma16(a, bb, acc);
            }
#pragma unroll
            for (int r = 0; r < 4; ++r) acc[r] *= __shfl(iw, 16 * w + 4 * g4 + r);
            accO8 = acc;
        }
        __syncthreads();
#pragma unroll
        for (int ti = 0; ti < 4; ++ti)
#pragma unroll
            for (int ks = 0; ks < 2; ++ks) {
                const bf16x8 a = *(const bf16x8*)(S_s + (16 * ti + i16) * 72 + 32 * ks + 8 * g4);
                const bf16x8 bb = *(const bf16x8*)(vT_s + (16 * w + i16) * 72 + 32 * ks + 8 * g4);
                accO[ti] = mfma16(a, bb, accO[ti]);
            }
        if (w < 4) {
#pragma unroll
            for (int ks = 0; ks < 2; ++ks) {
                const bf16x8 a = *(const bf16x8*)(S_s + (16 * w + i16) * 72 + 32 * ks + 8 * g4);
                const bf16x8 bb = *(const bf16x8*)(vT_s + (128 + i16) * 72 + 32 * ks + 8 * g4);
                accO8 = mfma16(a, bb, accO8);
            }
        }
#pragma unroll
        for (int ti = 0; ti < 4; ++ti)
#pragma unroll
            for (int r = 0; r < 4; ++r) out_s[(16 * ti + 4 * g4 + r) * 132 + 16 * w + i16] = accO[ti][r];
        if (w < 4 && i16 == 0) {
#pragma unroll
            for (int r = 0; r < 4; ++r) den_s[16 * w + 4 * g4 + r] = accO8[r];
        }
        __syncthreads();
        {
            float nv[16];
#pragma unroll
            for (int j = 0; j < 16; ++j) nv[j] = out_s[et * 132 + ec + j];
            u32x4 s0, s1;
            s0.x = pk2(nv[0], nv[1]); s0.y = pk2(nv[2], nv[3]); s0.z = pk2(nv[4], nv[5]); s0.w = pk2(nv[6], nv[7]);
            s1.x = pk2(nv[8], nv[9]); s1.y = pk2(nv[10], nv[11]); s1.z = pk2(nv[12], nv[13]); s1.w = pk2(nv[14], nv[15]);
            u16* dst = NDn + (tq + et) * 128 + ec;
            *(u32x4*)dst = s0; *(u32x4*)(dst + 8) = s1;
            if ((tid & 7) == 0) AUX[(tq + et) * 4 + 2] = den_s[et];
        }
#pragma unroll
        for (int ki = 0; ki < 8; ++ki) {
            f32x4 acc = Cacc[ki] * s_old;
#pragma unroll
            for (int ks = 0; ks < 2; ++ks) {
                const bf16x8 a = *(const bf16x8*)(wkT_s + (16 * ki + i16) * 72 + 32 * ks + 8 * g4);
                const bf16x8 bb = *(const bf16x8*)(vT_s + (16 * w + i16) * 72 + 32 * ks + 8 * g4);
                acc = mfma16(a, bb, acc);
            }
            Cacc[ki] = acc;
            u32x2 pkd; pkd.x = pk2(acc[0], acc[1]); pkd.y = pk2(acc[2], acc[3]);
            *(u32x2*)(CT_s + (16 * w + i16) * 136 + 16 * ki + 4 * g4) = pkd;
        }
        {
            f32x4 acc = Cacc8 * s_old;
#pragma unroll
            for (int ks = 0; ks < 2; ++ks) {
                const bf16x8 a = *(const bf16x8*)(wkT_s + (16 * w + i16) * 72 + 32 * ks + 8 * g4);
                const bf16x8 bb = *(const bf16x8*)(vT_s + (128 + i16) * 72 + 32 * ks + 8 * g4);
                acc = mfma16(a, bb, acc);
            }
            Cacc8 = acc;
            u32x2 pkd; pkd.x = pk2(acc[0], acc[1]); pkd.y = pk2(acc[2], acc[3]);
            *(u32x2*)(CT_s + (128 + i16) * 136 + 16 * w + 4 * g4) = pkd;
        }
        m_prev = m_new; Pc *= s_old;
        __syncthreads();
    }
    {
        float* E = (float*)(p.ws + WS_E) + (size_t)(item * 4 + grp) * 144 * 128;
#pragma unroll
        for (int ki = 0; ki < 8; ++ki) *(f32x4*)(E + (16 * w + i16) * 128 + 16 * ki + 4 * g4) = Cacc[ki];
        *(f32x4*)(E + (128 + i16) * 128 + 16 * w + 4 * g4) = Cacc8;
        if (tid == 0) ((float*)(p.ws + WS_DG))[item * 4 + grp] = Pc;
    }
}

__device__ __forceinline__ void mlstm_pass2(const Params& p, const int item, const int grp) {
    extern __shared__ __attribute__((aligned(16))) unsigned char lds[];
    const int tid = opaque_tid(), lane = tid & 63, w = tid >> 6, i16 = lane & 15, g4 = lane >> 4;
    const int b = item >> 2, hh = item & 3;
    u16* q_s = (u16*)(lds + 0); float* o2_s = (float*)(lds + 17408); float* den2_s = (float*)(lds + 51200); u16* CT_s = (u16*)(lds + 83200);
    const u16* P = (const u16*)(p.ws + WS_P); u16* Hm = (u16*)(p.ws + WS_HMIX);
    const u16* NDn = (const u16*)(p.ws + WS_NDNUM); const u16* Q2 = (const u16*)(p.ws + WS_Q2); const float* AUX = (const float*)(p.ws + WS_AUX);
    const size_t tokb = (size_t)b * 4096;
    const int et = tid >> 3, ec = (tid & 7) * 16;
    if (grp > 0) {
        float cf[3] = {0.f, 0.f, 0.f}; float run = 1.f;
#pragma unroll
        for (int gp = 2; gp >= 0; --gp) if (gp < grp) { cf[gp] = run; run *= __hip_atomic_load((float*)(p.ws + WS_DG) + item * 4 + gp, __ATOMIC_RELAXED, __HIP_MEMORY_SCOPE_AGENT); }
        const float* E = (const float*)(p.ws + WS_E) + (size_t)(item * 4) * 144 * 128;
        for (int i4 = tid; i4 < 144 * 128 / 4; i4 += 512) {
            const int i = i4 * 4;
            f32x4 sacc = {0.f, 0.f, 0.f, 0.f};
#pragma unroll
            for (int gp = 0; gp < 3; ++gp) if (gp < grp) sacc += cf[gp] * *(const f32x4*)(E + (size_t)gp * 144 * 128 + i);
            u32x2 w; w.x = pk2(sacc[0], sacc[1]); w.y = pk2(sacc[2], sacc[3]);
            *(u32x2*)(CT_s + (i >> 7) * 136 + (i & 127)) = w;
        }
    }
    __syncthreads();
    float gml[16];
#pragma unroll
    for (int j = 0; j < 16; ++j) gml[j] = p.g_ml[hh * 128 + ec + j];
    u32x4 qa_n, qb_n, nd_n[2], ov_n[2], zv_n[2]; f32x4 ax_n;
    {
        const int c = grp * 16;
        const size_t tokc = tokb + (size_t)c * 64, tq = (size_t)item * 4096 + (size_t)c * 64;
        const u16* qsrc = Q2 + (tq + et) * 128 + ec; qa_n = *(const u32x4*)qsrc; qb_n = *(const u32x4*)(qsrc + 8);
        ax_n = *(const f32x4*)(AUX + (tq + lane) * 4);
        const u16* ns = NDn + (tq + et) * 128 + ec; nd_n[0] = *(const u32x4*)ns; nd_n[1] = *(const u32x4*)(ns + 8);
        const u16* po = P + PIX(tokc + et, 1536 + hh * 128 + ec); ov_n[0] = *(const u32x4*)po; ov_n[1] = *(const u32x4*)(po + 8);
        zv_n[0] = *(const u32x4*)(po + PBLK8); zv_n[1] = *(const u32x4*)(po + PBLK8 + 8);
    }
    for (int cl = 0; cl < 16; ++cl) {
        const int c = grp * 16 + cl;
        const size_t tokc = tokb + (size_t)c * 64;
        *(u32x4*)(q_s + et * 136 + ec) = qa_n; *(u32x4*)(q_s + et * 136 + ec + 8) = qb_n;
        const f32x4 ax = ax_n;
        u32x4 nd[2], ov[2], zv[2];
        nd[0] = nd_n[0]; nd[1] = nd_n[1]; ov[0] = ov_n[0]; ov[1] = ov_n[1]; zv[0] = zv_n[0]; zv[1] = zv_n[1];
        __syncthreads();
        if (cl + 1 < 16) {
            const size_t tokn = tokc + 64, tqn = (size_t)item * 4096 + (size_t)(c + 1) * 64;
            const u16* qsrc = Q2 + (tqn + et) * 128 + ec; qa_n = *(const u32x4*)qsrc; qb_n = *(const u32x4*)(qsrc + 8);
            ax_n = *(const f32x4*)(AUX + (tqn + lane) * 4);
            const u16* ns = NDn + (tqn + et) * 128 + ec; nd_n[0] = *(const u32x4*)ns; nd_n[1] = *(const u32x4*)(ns + 8);
            const u16* po = P + PIX(tokn + et, 1536 + hh * 128 + ec); ov_n[0] = *(const u32x4*)po; ov_n[1] = *(const u32x4*)(po + 8);
            zv_n[0] = *(const u32x4*)(po + PBLK8); zv_n[1] = *(const u32x4*)(po + PBLK8 + 8);
        }
        asm volatile("" ::: "memory");
        if (grp > 0) {
#pragma unroll
            for (int ti = 0; ti < 4; ++ti) {
                f32x4 acc = {0.f, 0.f, 0.f, 0.f};
#pragma unroll
                for (int ks = 0; ks < 4; ++ks) {
                    const bf16x8 a = *(const bf16x8*)(q_s + (16 * ti + i16) * 136 + 32 * ks + 8 * g4);
                    const bf16x8 bb = *(const bf16x8*)(CT_s + (16 * w + i16) * 136 + 32 * ks + 8 * g4);
                    acc = mfma16(a, bb, acc);
                }
#pragma unroll
                for (int r = 0; r < 4; ++r) o2_s[(16 * ti + 4 * g4 + r) * 132 + 16 * w + i16] = acc[r] * __shfl(ax.x, 16 * ti + 4 * g4 + r);
            }
            if (w < 4) {
                f32x4 acc = {0.f, 0.f, 0.f, 0.f};
#pragma unroll
                for (int ks = 0; ks < 4; ++ks) {
                    const bf16x8 a = *(const bf16x8*)(q_s + (16 * w + i16) * 136 + 32 * ks + 8 * g4);
                    const bf16x8 bb = *(const bf16x8*)(CT_s + (128 + i16) * 136 + 32 * ks + 8 * g4);
                    acc = mfma16(a, bb, acc);
                }
#pragma unroll
                for (int r = 0; r < 4; ++r) { const float v = acc[r] * __shfl(ax.x, 16 * w + 4 * g4 + r); if (i16 == 0) den2_s[16 * w + 4 * g4 + r] = v; }
            }
        }
        __syncthreads();
        {
            const float den = __shfl(ax.z, et) + (grp > 0 ? den2_s[et] : 0.f);
            const float inv = 1.f / fmaxf(fabsf(den), __shfl(ax.y, et));
            float ho[16]; float ss = 0.f;
#pragma unroll
            for (int j = 0; j < 16; ++j) {
                const unsigned wn = nd[j >> 3][(j >> 1) & 3]; float num = (j & 1) ? bfhi(wn) : bflo(wn);
                if (grp > 0) num += o2_s[et * 132 + ec + j];
                const unsigned wv = ov[j >> 3][(j >> 1) & 3]; const float o = (j & 1) ? bfhi(wv) : bflo(wv);
                ho[j] = num * inv * __builtin_amdgcn_rcpf(1.f + __expf(-o)); ss += ho[j] * ho[j];
            }
            ss += __shfl_xor(ss, 1); ss += __shfl_xor(ss, 2); ss += __shfl_xor(ss, 4);
            const float rr = rsqrtf(ss * (1.f / 128.f) + 1e-6f);
            float ob[16];
#pragma unroll
            for (int j = 0; j < 16; ++j) {
                const unsigned wv = zv[j >> 3][(j >> 1) & 3]; const float z = (j & 1) ? bfhi(wv) : bflo(wv);
                ob[j] = ho[j] * rr * gml[j] * (z * __builtin_amdgcn_rcpf(1.f + __expf(-z)));
            }
            u32x4 s0, s1;
            s0.x = pk2(ob[0], ob[1]); s0.y = pk2(ob[2], ob[3]); s0.z = pk2(ob[4], ob[5]); s0.w = pk2(ob[6], ob[7]);
            s1.x = pk2(ob[8], ob[9]); s1.y = pk2(ob[10], ob[11]); s1.z = pk2(ob[12], ob[13]); s1.w = pk2(ob[14], ob[15]);
            u16* dst = Hm + (tokc + et) * 1024 + hh * 128 + ec;
            *(u32x4*)dst = s0; *(u32x4*)(dst + 8) = s1;
        }
        __syncthreads();
    }
}

__device__ __forceinline__ void sb_unit(const Params& p, const int unit, u16* vT, const int lane) {
    const u16* P = (const u16*)(p.ws + WS_P); u16* Hm = (u16*)(p.ws + WS_HMIX);
    const int qt = unit & 127, hd = (unit >> 7) & 7, b = unit >> 10;
    const int r = lane & 31, h = lane >> 5;
    const size_t tokb = (size_t)b * 4096;
    bf16x8 qf[4];
    { const u16* qrow = P + PIX(tokb + qt * 32 + r, 2560 + hd * 64 + 8 * h);
#pragma unroll
      for (int ks = 0; ks < 4; ++ks) qf[ks] = *(const bf16x8*)(qrow + 16 * ks); }
    u32x4 Tw[2];
#pragma unroll
    for (int st = 0; st < 2; ++st) {
        unsigned tw[4];
#pragma unroll
        for (int e = 0; e < 8; e += 2) {
            const int j0 = 16 * st + 8 * (e >> 2) + 4 * h + (e & 3), j1 = j0 + 1;
            tw[e >> 1] = ((j0 > r) ? 0x3C00u : 0u) | ((j1 > r) ? 0x3C000000u : 0u);
        }
        Tw[st].x = tw[0]; Tw[st].y = tw[1]; Tw[st].z = tw[2]; Tw[st].w = tw[3];
    }
    f32x16 O0, O1;
#pragma unroll
    for (int i = 0; i < 16; ++i) { O0[i] = 0.f; O1[i] = 0.f; }
    float R2 = 0.f;
    const float SC = 0.125f * 1.4426950408889634f;
    const size_t tok = tokb + qt * 32 + r;
    u32x2 zz8[8];
#pragma unroll
    for (int i = 0; i < 8; ++i) zz8[i] = *(const u32x2*)(P + PIX(tok, 4096 + hd * 64 + 32 * (i >> 2) + 8 * (i & 3) + 4 * h));
    asm volatile("" ::: "memory");
    bf16x8 kfn[4]; u32x4 vvn[4];
    { const u16* krow = P + PIX(tokb + qt * 32 + r, 3072 + hd * 64 + 8 * h);
#pragma unroll
      for (int ks = 0; ks < 4; ++ks) kfn[ks] = *(const bf16x8*)(krow + 16 * ks);
      const u16* vrow = P + PIX(tokb + qt * 32 + (lane >> 1), 3584 + hd * 64 + (lane & 1) * 32);
#pragma unroll
      for (int i = 0; i < 4; ++i) vvn[i] = *(const u32x4*)(vrow + 8 * i); }
    bool have = true;
    for (int kb = qt; kb >= 0; --kb) {
        if (!have) {
            const u16* krow = P + PIX(tokb + kb * 32 + r, 3072 + hd * 64 + 8 * h);
#pragma unroll
            for (int ks = 0; ks < 4; ++ks) kfn[ks] = *(const bf16x8*)(krow + 16 * ks);
            const u16* vrow = P + PIX(tokb + kb * 32 + (lane >> 1), 3584 + hd * 64 + (lane & 1) * 32);
#pragma unroll
            for (int i = 0; i < 4; ++i) vvn[i] = *(const u32x4*)(vrow + 8 * i);
        }
        bf16x8 kf[4]; u32x4 vv[4];
#pragma unroll
        for (int i = 0; i < 4; ++i) { kf[i] = kfn[i]; vv[i] = vvn[i]; }
        asm volatile("" ::: "memory");
        have = (kb > 0) && __any(R2 > -30.f);
        if (have) {
            const int s1 = (kb - 1) * 32;
            const u16* krow = P + PIX(tokb + s1 + r, 3072 + hd * 64 + 8 * h);
#pragma unroll
            for (int ks = 0; ks < 4; ++ks) kfn[ks] = *(const bf16x8*)(krow + 16 * ks);
            const u16* vrow = P + PIX(tokb + s1 + (lane >> 1), 3584 + hd * 64 + (lane & 1) * 32);
#pragma unroll
            for (int i = 0; i < 4; ++i) vvn[i] = *(const u32x4*)(vrow + 8 * i);
        }
        asm volatile("" ::: "memory");
        f32x16 Z;
#pragma unroll
        for (int i = 0; i < 16; ++i) Z[i] = 0.f;
#pragma unroll
        for (int ks = 0; ks < 4; ++ks) Z = mfma32(kf[ks], qf[ks], Z);
        float lbv[16], lkv[16];
#pragma unroll
        for (int reg = 0; reg < 16; ++reg) {
            const float u = Z[reg] * SC;
            const float sp = __builtin_amdgcn_logf(1.f + __builtin_amdgcn_exp2f(-fabsf(u)));
            lbv[reg] = fminf(u, 0.f) - sp;
            lkv[reg] = lbv[reg] - u;
        }
        if (kb == qt) {
#pragma unroll
            for (int reg = 0; reg < 16; ++reg) {
                const int sl = (reg & 3) + 8 * (reg >> 2) + 4 * h;
                const bool valid = sl < r;
                lbv[reg] = valid ? lbv[reg] : -1e30f;
                lkv[reg] = valid ? lkv[reg] : 0.f;
            }
        }
        u32x4 lw[2];
#pragma unroll
        for (int st = 0; st < 2; ++st) {
            lw[st].x = pkh2(lkv[8 * st + 0], lkv[8 * st + 1]); lw[st].y = pkh2(lkv[8 * st + 2], lkv[8 * st + 3]);
            lw[st].z = pkh2(lkv[8 * st + 4], lkv[8 * st + 5]); lw[st].w = pkh2(lkv[8 * st + 6], lkv[8 * st + 7]);
        }
        f32x16 aft;
#pragma unroll
        for (int i = 0; i < 16; ++i) aft[i] = 0.f;
        aft = __builtin_amdgcn_mfma_f32_32x32x16_f16(__builtin_bit_cast(f16x8, Tw[0]), __builtin_bit_cast(f16x8, lw[0]), aft, 0, 0, 0);
        aft = __builtin_amdgcn_mfma_f32_32x32x16_f16(__builtin_bit_cast(f16x8, Tw[1]), __builtin_bit_cast(f16x8, lw[1]), aft, 0, 0, 0);
        const float tot = __shfl(aft[0] + lkv[0], r);
        bf16x8 pf[2];
#pragma unroll
        for (int st = 0; st < 2; ++st) {
            u32x4 pw;
            pw.x = pk2(__builtin_amdgcn_exp2f(lbv[8 * st + 0] + R2 + aft[8 * st + 0]), __builtin_amdgcn_exp2f(lbv[8 * st + 1] + R2 + aft[8 * st + 1]));
            pw.y = pk2(__builtin_amdgcn_exp2f(lbv[8 * st + 2] + R2 + aft[8 * st + 2]), __builtin_amdgcn_exp2f(lbv[8 * st + 3] + R2 + aft[8 * st + 3]));
            pw.z = pk2(__builtin_amdgcn_exp2f(lbv[8 * st + 4] + R2 + aft[8 * st + 4]), __builtin_amdgcn_exp2f(lbv[8 * st + 5] + R2 + aft[8 * st + 5]));
            pw.w = pk2(__builtin_amdgcn_exp2f(lbv[8 * st + 6] + R2 + aft[8 * st + 6]), __builtin_amdgcn_exp2f(lbv[8 * st + 7] + R2 + aft[8 * st + 7]));
            pf[st] = __builtin_bit_cast(bf16x8, pw);
        }
        {
            const int sv = lane >> 1, db = (lane & 1) * 32;
#pragma unroll
            for (int i = 0; i < 4; ++i)
#pragma unroll
                for (int wq = 0; wq < 4; ++wq) {
                    const unsigned x = vv[i][wq]; const int d = db + 8 * i + 2 * wq;
                    vT[d * 40 + sv] = (u16)(x & 0xffffu); vT[(d + 1) * 40 + sv] = (u16)(x >> 16);
                }
        }
        asm volatile("s_waitcnt lgkmcnt(0)" ::: "memory");
#pragma unroll
        for (int st = 0; st < 2; ++st) {
            const u32x2 a0 = *(const u32x2*)(vT + r * 40 + 16 * st + 4 * h), a1 = *(const u32x2*)(vT + r * 40 + 16 * st + 8 + 4 * h);
            const u32x2 b0 = *(const u32x2*)(vT + (32 + r) * 40 + 16 * st + 4 * h), b1 = *(const u32x2*)(vT + (32 + r) * 40 + 16 * st + 8 + 4 * h);
            u32x4 fa, fb; fa.x = a0.x; fa.y = a0.y; fa.z = a1.x; fa.w = a1.y; fb.x = b0.x; fb.y = b0.y; fb.z = b1.x; fb.w = b1.y;
            O0 = mfma32(__builtin_bit_cast(bf16x8, fa), pf[st], O0);
            O1 = mfma32(__builtin_bit_cast(bf16x8, fb), pf[st], O1);
        }
        asm volatile("s_waitcnt lgkmcnt(0)" ::: "memory");
        R2 += tot;
        if (!__any(R2 > -64.f)) break;
    }
#pragma unroll
    for (int dt = 0; dt < 2; ++dt)
#pragma unroll
        for (int q4 = 0; q4 < 4; ++q4) {
            const int d0 = 32 * dt + 8 * q4 + 4 * h;
            const u32x2 zz = zz8[4 * dt + q4];
            float o[4];
#pragma unroll
            for (int e = 0; e < 4; ++e) {
                const float ov = dt ? O1[4 * q4 + e] : O0[4 * q4 + e];
                const unsigned wv = (e < 2) ? zz.x : zz.y; const float z = (e & 1) ? bfhi(wv) : bflo(wv);
                o[e] = ov * (z * __builtin_amdgcn_rcpf(1.f + __expf(-z)));
            }
            u32x2 st; st.x = pk2(o[0], o[1]); st.y = pk2(o[2], o[3]);
            *(u32x2*)(Hm + tok * 1024 + 512 + hd * 64 + d0) = st;
        }
}

__device__ __forceinline__ void phase2a(const Params& p) {
    for (int u = blockIdx.x; u < 256; u += gridDim.x) { mlstm_pass1(p, u >> 2, u & 3); __syncthreads(); }
}
__device__ __forceinline__ void phase2b(const Params& p) {
    extern __shared__ __attribute__((aligned(16))) unsigned char lds[];
    for (int u = blockIdx.x; u < 256; u += gridDim.x) { mlstm_pass2(p, u >> 2, u & 3); __syncthreads(); }
    const int tid2 = opaque_tid(), lane = tid2 & 63, wave = tid2 >> 6;
    u16* vT = (u16*)(lds + wave * 5120);
    for (int u = blockIdx.x * 8 + wave; u < 16384; u += gridDim.x * 8) sb_unit(p, u, vT, lane);
}

__device__ __forceinline__ void phase4(const Params& p) {
    const int tid = opaque_tid(), lane = tid & 63, wave = tid >> 6;
    const float* modp = (const float*)(p.ws + WS_MOD);
    const u16* Y = (const u16*)(p.ws + WS_Y);
    for (int tb = blockIdx.x * 8 + wave; tb < 2048; tb += gridDim.x * 8) {
        const int tok0 = tb * 32, b = tok0 >> 12;
        f32x4 gg[4];
#pragma unroll
        for (int j = 0; j < 4; ++j) { const int k = lane * 4 + 256 * j; gg[j] = *(const f32x4*)(modp + b * 3072 + 2048 + k) * *(const f32x4*)(p.g_post + k); }
        u32x2 yn[4]; f32x4 xn[4];
#pragma unroll
        for (int j = 0; j < 4; ++j) { yn[j] = *(const u32x2*)(Y + (size_t)tok0 * 1024 + lane * 4 + 256 * j); xn[j] = __builtin_nontemporal_load((const f32x4*)(p.x + (size_t)tok0 * 1024 + lane * 4 + 256 * j)); }
        for (int t = 0; t < 32; ++t) {
            const size_t tok = (size_t)tok0 + t;
            f32x4 y[4], xv[4]; float ss = 0.f;
#pragma unroll
            for (int j = 0; j < 4; ++j) { const u32x2 w = yn[j]; xv[j] = xn[j];
                y[j] = (f32x4){bflo(w.x), bfhi(w.x), bflo(w.y), bfhi(w.y)}; ss += (y[j].x * y[j].x + y[j].y * y[j].y) + (y[j].z * y[j].z + y[j].w * y[j].w); }
            if (t + 1 < 32) {
#pragma unroll
                for (int j = 0; j < 4; ++j) { yn[j] = *(const u32x2*)(Y + (tok + 1) * 1024 + lane * 4 + 256 * j); xn[j] = __builtin_nontemporal_load((const f32x4*)(p.x + (tok + 1) * 1024 + lane * 4 + 256 * j)); }
            }
            ss = wave_sum(ss); const float r = rsqrtf(ss * (1.f / 1024.f) + 1e-6f);
#pragma unroll
            for (int j = 0; j < 4; ++j) __builtin_nontemporal_store(xv[j] + gg[j] * (y[j] * r), (f32x4*)(p.out + tok * 1024 + lane * 4 + 256 * j));
        }
    }
}

DEVI unsigned bar_ld(unsigned* q) { return __hip_atomic_load(q, __ATOMIC_RELAXED, __HIP_MEMORY_SCOPE_AGENT); }
DEVI unsigned bar_add(unsigned* q, unsigned v) { return __hip_atomic_fetch_add(q, v, __ATOMIC_RELAXED, __HIP_MEMORY_SCOPE_AGENT); }
DEVI unsigned xcc_id() { return (unsigned)__builtin_amdgcn_s_getreg((3 << 11) | 20) & 0xFu; }
DEVI void grid_sync0(const Params& p, cg::grid_group& g) {
    asm volatile("s_waitcnt vmcnt(0) lgkmcnt(0)" ::: "memory");
    g.sync();
    if (threadIdx.x == 0) { __builtin_amdgcn_fence(__ATOMIC_ACQUIRE, "agent"); asm volatile("s_waitcnt vmcnt(0)" ::: "memory"); }
    __syncthreads();
}
DEVI void grid_sync(const Params& p, const int idx, const unsigned xcc, const unsigned nloc, const unsigned nxcc) {
    asm volatile("s_waitcnt vmcnt(0) lgkmcnt(0)" ::: "memory");
    __syncthreads();
    if (threadIdx.x == 0) {
        unsigned* bar = (unsigned*)(p.ws + WS_BAR);
        unsigned* xsub = bar + 1024 + (16 * idx + xcc) * 64; unsigned* top = bar + 9216 + 64 * idx;
        const unsigned old = bar_add(xsub, 1u);
        if (old == nloc - 1u) {
            __builtin_amdgcn_fence(__ATOMIC_RELEASE, "agent");
            asm volatile("s_waitcnt vmcnt(0)" ::: "memory");
            bar_add(top, 1u);
        }
        while (bar_ld(top) < nxcc) __builtin_amdgcn_s_sleep(1);
        __builtin_amdgcn_fence(__ATOMIC_ACQUIRE, "agent");
        asm volatile("s_waitcnt vmcnt(0)" ::: "memory");
    }
    __syncthreads();
}
__global__ void __launch_bounds__(512) hymba_fwd(Params p) {
    cg::grid_group grid = cg::this_grid();
    const unsigned xcc = xcc_id();
    if (threadIdx.x == 0) bar_add((unsigned*)(p.ws + WS_BAR) + 64 * xcc, 1u);
    phase0(p);
    if (gridDim.x == 0x7fffffffu) grid_sync0(p, grid);
    if (threadIdx.x == 0) {
        unsigned* bar = (unsigned*)(p.ws + WS_BAR);
        for (;;) { unsigned tot = 0; for (int j = 0; j < 16; ++j) tot += bar_ld(bar + 64 * j); if (tot >= gridDim.x) break; __builtin_amdgcn_s_sleep(1); }
    }
    __syncthreads();
    unsigned nloc, nxcc = 0;
    { unsigned* bar = (unsigned*)(p.ws + WS_BAR); nloc = bar_ld(bar + 64 * xcc);
      for (int j = 0; j < 16; ++j) nxcc += (bar_ld(bar + 64 * j) != 0u) ? 1u : 0u; }
    grid_sync(p, 0, xcc, nloc, nxcc);
    phase1a(p);
    grid_sync(p, 1, xcc, nloc, nxcc);
    gemm_phase<true>((const u16*)(p.ws + WS_H), (const u16*)(p.ws + WS_WTIN), (u16*)(p.ws + WS_P), 18, NP);
    grid_sync(p, 2, xcc, nloc, nxcc);
    phase2a(p);
    grid_sync(p, 5, xcc, nloc, nxcc);
    phase2b(p);
    grid_sync(p, 3, xcc, nloc, nxcc);
    gemm_phase<false>((const u16*)(p.ws + WS_HMIX), (const u16*)(p.ws + WS_WTOUT), (u16*)(p.ws + WS_Y), 4, 1024);
    grid_sync(p, 4, xcc, nloc, nxcc);
    phase4(p);
}

extern "C" void kernel_launch(void* const* d_in, const int* in_sizes, int n_in, void* d_out, int out_size, void* d_ws, size_t ws_size, hipStream_t stream) {
    static int grid_blocks = 0;
    if (!grid_blocks) {
        if (n_in != 13 || out_size != NTOK * DM || ws_size < WS_END) { fprintf(stderr, "kernel_launch: unexpected shapes (n_in %d out %d ws %zu)\n", n_in, out_size, ws_size); grid_blocks = -1; return; }
        int dev = 0, cus = 0, per_cu = 0;
        hipGetDevice(&dev);
        hipDeviceGetAttribute(&cus, hipDeviceAttributeMultiprocessorCount, dev);
        if (hipFuncSetAttribute((const void*)hymba_fwd, hipFuncAttributeMaxDynamicSharedMemorySize, LDS_BYTES) != hipSuccess) fprintf(stderr, "kernel_launch: hipFuncSetAttribute failed\n");
        if (hipOccupancyMaxActiveBlocksPerMultiprocessor(&per_cu, (const void*)hymba_fwd, 512, LDS_BYTES) != hipSuccess || per_cu < 1) { fprintf(stderr, "kernel_launch: occupancy query says %d\n", per_cu); per_cu = 1; }
        (void)hipGetLastError();
        grid_blocks = cus * 1;
    }
    if (grid_blocks < 0) return;
    Params p{};
    p.x = (const float*)d_in[0]; p.c = (const float*)d_in[1]; p.w_ada = (const float*)d_in[2]; p.b_ada = (const float*)d_in[3]; p.g_pre = (const float*)d_in[4];
    p.w_in = (const float*)d_in[5]; p.b_ig = (const float*)d_in[6]; p.b_fg = (const float*)d_in[7]; p.conv_w = (const float*)d_in[8]; p.conv_b = (const float*)d_in[9];
    p.g_ml = (const float*)d_in[10]; p.w_out = (const float*)d_in[11]; p.g_post = (const float*)d_in[12];
    p.out = (float*)d_out; p.ws = (unsigned char*)d_ws;
    if (hipMemsetAsync((unsigned char*)d_ws + WS_BAR, 0, 40960, stream) != hipSuccess) fprintf(stderr, "kernel_launch: memset of the barrier words failed\n");
    void* args[] = {&p};
    hipError_t e = hipLaunchCooperativeKernel((const void*)hymba_fwd, dim3(grid_blocks), dim3(512), args, LDS_BYTES, stream);
    if (e != hipSuccess) fprintf(stderr, "cooperative launch failed: %s (grid %d)\n", hipGetErrorString(e), grid_blocks);
}
```
